# Optimizing an MI355X kernel written in HIP

```python
import math
import jax, jax.numpy as jnp
from jax import lax
import numpy as np

D_MODEL = 1024
BATCH = 2
SEQ = 8192
DEPTH = 2
DEC_BATCH = 32
DEC_SEQ = 8
PAST_LEN = 16384
PAGE_SIZE = 128

D_PLE = 256
RET_HEADS = 4
RET_DK = 128
RET_DV = 256
RET_CHUNK = 128
ATT_GROUPS = ((128, 1), (512, 4), (2048, 16))
N_GROUPS = 3
HPG = 4
ATT_HEAD_DIM = 128
ATT_HEADS = N_GROUPS * HPG
Q_BLOCK = 128
D_FF = 4 * D_MODEL
EPS = 1e-6

RET_QK_W = RET_HEADS * RET_DK
RET_V_W = RET_HEADS * RET_DV
ATT_W = ATT_HEADS * ATT_HEAD_DIM
ATT_OUT_W = HPG * ATT_HEAD_DIM
D_IN = 2 * RET_QK_W + 2 * RET_V_W + 3 * ATT_W + 2 * D_MODEL

kernel_name = 'hybrid_retention_dilated_attn_decode_step'


def _split_points():
    sizes = (RET_QK_W, RET_QK_W, RET_V_W, RET_V_W, ATT_W, ATT_W, ATT_W, D_MODEL, D_MODEL)
    pts, acc = [], 0
    for s in sizes[:-1]:
        acc += s
        pts.append(acc)
    return pts


def _ret_log_gamma():
    return jnp.log1p(-jnp.exp(jnp.linspace(math.log(1.0 / 32), math.log(1.0 / 512), RET_HEADS))).astype(jnp.float32)


def _alibi_slopes():
    return (2.0 ** (-8.0 * (jnp.arange(ATT_HEADS, dtype=jnp.float32) + 1.0) / ATT_HEADS)).astype(jnp.float32)


def rmsnorm(x, g):
    xf = x.astype(jnp.float32)
    y = xf * lax.rsqrt(jnp.mean(xf * xf, axis=-1, keepdims=True) + EPS) * g.astype(jnp.float32)
    return y.astype(x.dtype)


def head_layernorm(o):
    of = o.astype(jnp.float32)
    mu = jnp.mean(of, axis=-1, keepdims=True)
    var = jnp.mean((of - mu) ** 2, axis=-1, keepdims=True)
    return ((of - mu) * lax.rsqrt(var + EPS)).astype(o.dtype)


def retention(q, k, v, state0):
    B, T, H, DK = q.shape
    DV = v.shape[-1]
    dt = v.dtype
    C = math.gcd(T, RET_CHUNK)
    NC = T // C
    lg = _ret_log_gamma()
    pos = jnp.arange(C, dtype=jnp.float32)
    diff = pos[:, None] - pos[None, :]
    intra = jnp.where(diff[None] >= 0, jnp.exp(lg[:, None, None] * jnp.maximum(diff, 0.0)[None]), 0.0)
    xi = jnp.exp(lg[:, None] * (pos[None] + 1.0)).T
    zeta = jnp.exp(lg[:, None] * (C - 1.0 - pos)[None]).T
    chunk_decay = jnp.exp(lg * C).astype(dt)
    qc = q.reshape(B, NC, C, H, DK)
    kc = (k * (DK ** -0.5)).reshape(B, NC, C, H, DK)
    vc = v.reshape(B, NC, C, H, DV)
    scores = jnp.einsum('bnihd,bnjhd->bnhij', qc, kc) * intra.astype(dt)[None, None]
    o_intra = jnp.einsum('bnhij,bnjhv->bnihv', scores, vc)
    u = jnp.einsum('bnjhd,bnjhv->bnhdv', kc, vc * zeta.astype(dt)[None, None, :, :, None])

    def step(R, u_c):
        return chunk_decay[None, :, None, None] * R + u_c, R

    R_final, R_prev = lax.scan(step, state0.astype(dt), jnp.moveaxis(u, 1, 0))
    R_prev = jnp.moveaxis(R_prev, 0, 1)
    o_cross = jnp.einsum('bnihd,bnhdv->bnihv', qc * xi.astype(dt)[None, None, :, :, None], R_prev)
    return (o_intra + o_cross).reshape(B, T, H, DV), R_final


def dilated_group_attention(q, k, v, q_start, window, dil, slopes):
    B, Tq, H, Dh = q.shape
    n_taps = window // dil + 1
    QB = math.gcd(Tq, Q_BLOCK)
    nb = Tq // QB
    taps = jnp.arange(n_taps, dtype=jnp.int32) * dil
    alibi = -slopes[:, None] * taps.astype(jnp.float32)[None]
    qb = jnp.moveaxis(q.reshape(B, nb, QB, H, Dh), 1, 0)
    starts = q_start + jnp.arange(nb, dtype=jnp.int32) * QB
    scale = Dh ** -0.5

    def block(args):
        qblk, s0 = args
        qi = s0 + jnp.arange(QB, dtype=jnp.int32)
        idx = qi[:, None] - taps[None, :]
        valid = idx >= 0
        idx = jnp.maximum(idx, 0)
        kg = jnp.take(k, idx, axis=1)
        vg = jnp.take(v, idx, axis=1)
        s = jnp.einsum('bqhd,bqnhd->bhqn', qblk, kg).astype(jnp.float32) * scale + alibi[None, :, None, :]
        s = jnp.where(valid[None, None], s, -jnp.inf)
        m = jnp.max(s, axis=-1, keepdims=True)
        e = jnp.exp(s - m)
        den = jnp.sum(e, axis=-1, keepdims=True)
        o = jnp.einsum('bhqn,bqnhd->bqhd', (e / den).astype(v.dtype), vg)
        lse = (m + jnp.log(den))[..., 0]
        return o, lse

    o, lse = lax.map(block, (qb, starts))
    o = jnp.moveaxis(o, 0, 1).reshape(B, Tq, H, Dh)
    lse = jnp.transpose(lse, (1, 0, 3, 2)).reshape(B, Tq, H)
    return o, lse


def layer(x, p_l, ret_state0, win_bufs, lw):
    (norm_mix, w_in, w_ret_br, w_att_br, w_out, norm_ffn, w_up, w_down, w_ple, w_ple_gate) = lw
    B, T, _ = x.shape
    dt = x.dtype
    h = rmsnorm(x, norm_mix)
    z = h @ w_in
    rq, rk, rv, rg, aq, ak, av, ga, gb = jnp.split(z, _split_points(), axis=-1)
    o_ret, ret_state = retention(rq.reshape(B, T, RET_HEADS, RET_DK), rk.reshape(B, T, RET_HEADS, RET_DK),
                                 rv.reshape(B, T, RET_HEADS, RET_DV), ret_state0)
    o_ret = head_layernorm(o_ret).reshape(B, T, RET_V_W) * jax.nn.silu(rg)
    br_ret = o_ret @ w_ret_br
    aq = aq.reshape(B, T, N_GROUPS, HPG, ATT_HEAD_DIM)
    ak = ak.reshape(B, T, N_GROUPS, HPG, ATT_HEAD_DIM)
    av = av.reshape(B, T, N_GROUPS, HPG, ATT_HEAD_DIM)
    slopes = _alibi_slopes()
    outs, lses, new_bufs = [], [], []
    for g, (W, dil) in enumerate(ATT_GROUPS):
        kg, vg = ak[:, :, g], av[:, :, g]
        if win_bufs is None:
            k_all, v_all, q_start = kg, vg, 0
        else:
            kb, vb = win_bufs[g]
            k_all = jnp.concatenate([kb.astype(dt), kg], axis=1)
            v_all = jnp.concatenate([vb.astype(dt), vg], axis=1)
            q_start = kb.shape[1]
        o_g, lse_g = dilated_group_attention(aq[:, :, g], k_all, v_all, q_start, W, dil,
                                             slopes[g * HPG:(g + 1) * HPG])
        outs.append(o_g)
        lses.append(lse_g)
        L = min(W, k_all.shape[1])
        new_bufs.append((k_all[:, -L:], v_all[:, -L:]))
    wts = jax.nn.softmax(jnp.stack(lses, axis=0), axis=0)
    o_att = jnp.einsum('gbth,gbthd->bthd', wts, jnp.stack(outs, axis=0).astype(jnp.float32)).astype(dt)
    br_att = o_att.reshape(B, T, ATT_OUT_W) @ w_att_br
    x = x + (jax.nn.sigmoid(ga) * br_ret + jax.nn.sigmoid(gb) * br_att) @ w_out
    u = jax.nn.relu(rmsnorm(x, norm_ffn) @ w_up)
    x = x + (u * u) @ w_down
    x = x + (p_l @ w_ple) * jax.nn.sigmoid(x @ w_ple_gate)
    return x, ret_state, new_bufs


def setup_inputs(seed: int = 0) -> dict:
    key = jax.random.key(seed)
    ks = jax.random.split(key, 24)
    f32 = jnp.float32
    nrm = lambda k, s, sc=1.0: jax.random.normal(k, s, f32) * sc
    d = {}
    d['x_prompt'] = nrm(ks[0], (BATCH, SEQ, D_MODEL))
    d['x_sample'] = nrm(ks[1], (DEC_BATCH, DEC_SEQ, D_MODEL))
    for g, (W, dil) in enumerate(ATT_GROUPS):
        L = min(W, PAST_LEN)
        d['cache_win_k%d' % g] = nrm(ks[2 + 2 * g], (DEPTH, DEC_BATCH, L, HPG, ATT_HEAD_DIM))
        d['cache_win_v%d' % g] = nrm(ks[3 + 2 * g], (DEPTH, DEC_BATCH, L, HPG, ATT_HEAD_DIM))
    d['state_ret'] = nrm(ks[8], (DEPTH, DEC_BATCH, RET_HEADS, RET_DK, RET_DV))
    d['p_prompt'] = nrm(ks[9], (DEPTH, BATCH, SEQ, D_PLE))
    d['p_sample'] = nrm(ks[10], (DEPTH, DEC_BATCH, DEC_SEQ, D_PLE))
    d['norm_mix'] = 1.0 + nrm(ks[11], (DEPTH, D_MODEL), 0.02)
    d['w_in'] = nrm(ks[12], (DEPTH, D_MODEL, D_IN), D_MODEL ** -0.5)
    d['w_ret_br'] = nrm(ks[13], (DEPTH, RET_V_W, D_MODEL), RET_V_W ** -0.5)
    d['w_att_br'] = nrm(ks[14], (DEPTH, ATT_OUT_W, D_MODEL), ATT_OUT_W ** -0.5)
    d['w_out'] = nrm(ks[15], (DEPTH, D_MODEL, D_MODEL), D_MODEL ** -0.5)
    d['norm_ffn'] = 1.0 + nrm(ks[16], (DEPTH, D_MODEL), 0.02)
    d['w_up'] = nrm(ks[17], (DEPTH, D_MODEL, D_FF), D_MODEL ** -0.5)
    d['w_down'] = nrm(ks[18], (DEPTH, D_FF, D_MODEL), D_FF ** -0.5)
    d['w_ple'] = nrm(ks[19], (DEPTH, D_PLE, D_MODEL), D_PLE ** -0.5)
    d['w_ple_gate'] = nrm(ks[20], (DEPTH, D_MODEL, D_MODEL), D_MODEL ** -0.5)
    d['norm_final'] = 1.0 + nrm(ks[21], (D_MODEL,), 0.02)
    return d


def reference(x_prompt, x_sample, cache_win_k0, cache_win_v0, cache_win_k1, cache_win_v1, cache_win_k2, cache_win_v2,
              state_ret, p_prompt, p_sample, norm_mix, w_in, w_ret_br, w_att_br, w_out, norm_ffn, w_up, w_down,
              w_ple, w_ple_gate, norm_final):
    xp, xs = x_prompt, x_sample
    cache_k = (cache_win_k0, cache_win_k1, cache_win_k2)
    cache_v = (cache_win_v0, cache_win_v1, cache_win_v2)
    pk = [[] for _ in range(N_GROUPS)]
    pv = [[] for _ in range(N_GROUPS)]
    sk = [[] for _ in range(N_GROUPS)]
    sv = [[] for _ in range(N_GROUPS)]
    pr, sr = [], []
    for i in range(DEPTH):
        lw = (norm_mix[i], w_in[i], w_ret_br[i], w_att_br[i], w_out[i], norm_ffn[i], w_up[i], w_down[i],
              w_ple[i], w_ple_gate[i])
        zero_state = jnp.zeros((xp.shape[0], RET_HEADS, RET_DK, RET_DV), xp.dtype)
        xp, rp, bp = layer(xp, p_prompt[i], zero_state, None, lw)
        bufs = [(cache_k[g][i], cache_v[g][i]) for g in range(N_GROUPS)]
        xs, rs, bs = layer(xs, p_sample[i], state_ret[i], bufs, lw)
        pr.append(rp)
        sr.append(rs)
        for g in range(N_GROUPS):
            pk[g].append(bp[g][0]); pv[g].append(bp[g][1])
            sk[g].append(bs[g][0]); sv[g].append(bs[g][1])
    y_prompt = rmsnorm(xp, norm_final)
    y_sample = rmsnorm(xs, norm_final)
    prompt_win_k0, prompt_win_v0 = jnp.stack(pk[0]), jnp.stack(pv[0])
    prompt_win_k1, prompt_win_v1 = jnp.stack(pk[1]), jnp.stack(pv[1])
    prompt_win_k2, prompt_win_v2 = jnp.stack(pk[2]), jnp.stack(pv[2])
    sample_win_k0, sample_win_v0 = jnp.stack(sk[0]), jnp.stack(sv[0])
    sample_win_k1, sample_win_v1 = jnp.stack(sk[1]), jnp.stack(sv[1])
    sample_win_k2, sample_win_v2 = jnp.stack(sk[2]), jnp.stack(sv[2])
    prompt_ret = jnp.stack(pr)
    sample_ret = jnp.stack(sr)
    return (y_prompt, y_sample, prompt_win_k0, prompt_win_v0, prompt_win_k1, prompt_win_v1, prompt_win_k2, prompt_win_v2,
            prompt_ret, sample_win_k0, sample_win_v0, sample_win_k1, sample_win_v1, sample_win_k2, sample_win_v2,
            sample_ret)
```

```cpp
#include <hip/hip_runtime.h>
#include <hip/hip_cooperative_groups.h>
#include <cstdio>
#include <cstdint>
#include <cmath>
namespace cg = cooperative_groups;
namespace pg8 {
#define PG8_LAS __attribute__((address_space(3)))
typedef unsigned short bf16_t;
typedef short bf16x8 __attribute__((ext_vector_type(8)));
typedef float f32x4 __attribute__((ext_vector_type(4)));
typedef unsigned u32x4 __attribute__((ext_vector_type(4)));
constexpr int BM = 256, BK = 64, HALF = 128, HTB = HALF * BK * 2  , STAGE_BYTES = 8 * HTB, NXCD = 8, WGM = 8;

__host__ __device__ __forceinline__ int lds_byte(int r, int c) { const int st = (r >> 4) * 2 + (c >> 5), rr = r & 15, cc = c & 31, ob = rr * 64 + cc * 2; return st * 1024 + (ob ^ (((ob >> 9) & 1) << 5)); }
__host__ __device__ __forceinline__ void stage_rc(int b, int& R, int& C) { const int st = b / 1024, sb = b % 1024, swz = sb ^ (((sb >> 9) & 1) << 5); R = (st >> 1) * 16 + swz / 64; C = (st & 1) * 32 + (swz % 64) / 2; }
__host__ __device__ __forceinline__ int perm32(int rho) { const int n = rho >> 4, i = rho & 15; return 8 * (i >> 2) + 4 * n + (i & 3); }

struct Unit { int pm, pn; };
struct Gemm { const bf16_t* A; const bf16_t* Bt; int M, N, K; };

struct StaticOrder {
    int nM, nN, nwg, G, c;
    __host__ __device__ void init(int M, int N, int G_, int c_) { nM = M / BM; nN = N / BM; nwg = nM * nN; G = G_; c = c_; }
    __host__ __device__ bool next(int i, Unit& u) const {
        const long L = (long)i * G + c; if (L >= nwg) return false;
        int wgid = (int)L; { const int q = nwg / NXCD, r = nwg % NXCD, xcd = wgid % NXCD, off = wgid / NXCD; wgid = (xcd < r ? xcd * (q + 1) : r * (q + 1) + (xcd - r) * q) + off; }
        const int nig = WGM * nN, gid = wgid / nig, fm = gid * WGM, gsz = (nM - fm) < WGM ? (nM - fm) : WGM;
        u.pm = fm + ((wgid % nig) % gsz); u.pn = (wgid % nig) / gsz; return true;
    }
    __device__ __forceinline__ void a_ready(const Unit&) const {}
    __device__ __forceinline__ void done(const Unit&) const {}
};

__device__ __forceinline__ unsigned cvt_pk_bf16(float lo, float hi) { unsigned r; asm("v_cvt_pk_bf16_f32 %0, %1, %2" : "=v"(r) : "v"(lo), "v"(hi)); return r; }

typedef unsigned u32x2 __attribute__((ext_vector_type(2)));
__device__ __forceinline__ float bf2f(unsigned h) { return __uint_as_float(h << 16); }
__device__ __forceinline__ float sigmoidf_(float x) { return 1.0f / (1.0f + __expf(-x)); }
__device__ __forceinline__ f32x4 bf4_to_f32(u32x2 w) { f32x4 r; r[0] = bf2f(w.x & 0xffffu); r[1] = bf2f(w.x >> 16); r[2] = bf2f(w.y & 0xffffu); r[3] = bf2f(w.y >> 16); return r; }
__device__ __forceinline__ u32x2 f32_to_bf4(f32x4 v) { u32x2 w; w.x = cvt_pk_bf16(v[0], v[1]); w.y = cvt_pk_bf16(v[2], v[3]); return w; }
enum { E_Z = 0, E_UP = 1, E_RET = 2, E_ATT = 3, E_RES = 4, E_PLE = 5, E_GATE = 6 };
template <int MODE> struct Epi {
    static constexpr bool PERM = (MODE == E_Z || MODE == E_UP), AFTER_DRAIN = false;
    bf16_t* ob; int ldob; const bf16_t* xrb; bf16_t* t; const float* ssp_in; float* ssp_out; const bf16_t* gate; const float* xr;
    __device__ __forceinline__ float elem(int row, int col, const f32x4 a) const {
        const size_t off = (size_t)row * 1024 + col; float ssq = 0.f;
        if constexpr (MODE == E_RET || MODE == E_ATT) {
            const u32x2 gw = *(const u32x2*)(gate + (size_t)row * 9728 + col);
            f32x4 gv; gv[0] = sigmoidf_(bf2f(gw.x & 0xffffu)); gv[1] = sigmoidf_(bf2f(gw.x >> 16)); gv[2] = sigmoidf_(bf2f(gw.y & 0xffffu)); gv[3] = sigmoidf_(bf2f(gw.y >> 16));
            if constexpr (MODE == E_RET) { *(u32x2*)(t + off) = f32_to_bf4(gv * a); }
            else { const f32x4 tv = bf4_to_f32(*(const u32x2*)(t + off)); const f32x4 o = tv + gv * a; u32x2 w; w.x = cvt_pk_bf16(o[0], o[1]); w.y = cvt_pk_bf16(o[2], o[3]); *(u32x2*)(ob + off) = w; }
        } else if constexpr (MODE == E_PLE) {
            *(u32x2*)(t + off) = f32_to_bf4(a);
        } else if constexpr (MODE == E_RES || MODE == E_GATE) {
            f32x4 x = xr ? *(const f32x4*)(xr + off) : bf4_to_f32(*(const u32x2*)(xrb + off));
            if constexpr (MODE == E_GATE) { const f32x4 tv = bf4_to_f32(*(const u32x2*)(t + off)); f32x4 sg; sg[0] = sigmoidf_(a[0]); sg[1] = sigmoidf_(a[1]); sg[2] = sigmoidf_(a[2]); sg[3] = sigmoidf_(a[3]); x = x + tv * sg; }
            else x = x + a;
            u32x2 w; w.x = cvt_pk_bf16(x[0], x[1]); w.y = cvt_pk_bf16(x[2], x[3]); *(u32x2*)(ob + off) = w;
            ssq = (x[0] * x[0] + x[1] * x[1]) + (x[2] * x[2] + x[3] * x[3]);
        }
        return ssq;
    }
    __device__ __forceinline__ void operator()(const f32x4 (&acc)[2][2][4][2], const Unit& u, int wr, int wc, int fr, int fq) const {
        const int row0 = u.pm * BM + wr * 64 + fr;
        if constexpr (PERM) {
            const int col0 = u.pn * BM + wc * 32 + 8 * fq;
            f32x4 sp[2][4];
#pragma unroll
            for (int ai = 0; ai < 2; ++ai)
#pragma unroll
                for (int m = 0; m < 4; ++m) sp[ai][m] = *(const f32x4*)(ssp_in + (size_t)(row0 + ai * HALF + m * 16) * 16 + 4 * fq);
#pragma unroll
            for (int ai = 0; ai < 2; ++ai)
#pragma unroll
                for (int m = 0; m < 4; ++m) {
                    const int row = row0 + ai * HALF + m * 16;
                    float ss = (sp[ai][m][0] + sp[ai][m][1]) + (sp[ai][m][2] + sp[ai][m][3]);
                    ss += __shfl_xor(ss, 16); ss += __shfl_xor(ss, 32);
                    const float rstd = 1.0f / sqrtf(ss * (1.0f / 1024.0f) + 1e-6f);
                    bf16_t* rowp = ob + (size_t)row * ldob + col0;
#pragma unroll
                    for (int bj = 0; bj < 2; ++bj) {
                        f32x4 v0 = acc[ai][bj][m][0] * rstd, v1 = acc[ai][bj][m][1] * rstd;
                        if constexpr (MODE == E_UP) {
#pragma unroll
                            for (int e = 0; e < 4; ++e) { float a = fmaxf(v0[e], 0.f), b = fmaxf(v1[e], 0.f); v0[e] = a * a; v1[e] = b * b; }
                        }
                        u32x4 w; w.x = cvt_pk_bf16(v0[0], v0[1]); w.y = cvt_pk_bf16(v0[2], v0[3]); w.z = cvt_pk_bf16(v1[0], v1[1]); w.w = cvt_pk_bf16(v1[2], v1[3]);
                        *(u32x4*)(rowp + bj * HALF) = w;
                    }
                }
        } else {
            const int col0 = u.pn * BM + wc * 32 + 4 * fq;
            constexpr int MB = (MODE == E_GATE) ? 1 : 2;
#pragma unroll
            for (int aim = 0; aim < 8 / MB; ++aim) {
                const int ai = aim / (4 / MB), m0 = (aim % (4 / MB)) * MB;
                f32x4 xv[4][2][2]; u32x2 xw[4][2][2]; u32x2 tv[4][2][2]; u32x2 gw[4][2][2];
#pragma unroll
                for (int m = m0; m < m0 + MB; ++m)
#pragma unroll
                    for (int bj = 0; bj < 2; ++bj)
#pragma unroll
                        for (int n = 0; n < 2; ++n) {
                            const int row = row0 + ai * HALF + m * 16, col = col0 + bj * HALF + n * 16; const size_t off = (size_t)row * 1024 + col;
                            if constexpr (MODE == E_RES || MODE == E_GATE) { if (xr) xv[m][bj][n] = *(const f32x4*)(xr + off); else xw[m][bj][n] = *(const u32x2*)(xrb + off); }
                            if constexpr (MODE == E_ATT || MODE == E_GATE) tv[m][bj][n] = *(const u32x2*)(t + off);
                            if constexpr (MODE == E_RET || MODE == E_ATT) gw[m][bj][n] = *(const u32x2*)(gate + (size_t)row * 9728 + col);
                        }
#pragma unroll
                for (int m = m0; m < m0 + MB; ++m) {
                    const int row = row0 + ai * HALF + m * 16;
                    float ssq = 0.f;
#pragma unroll
                    for (int bj = 0; bj < 2; ++bj)
#pragma unroll
                        for (int n = 0; n < 2; ++n) {
                            const int col = col0 + bj * HALF + n * 16; const size_t off = (size_t)row * 1024 + col;
                            const f32x4 a = acc[ai][bj][m][n];
                            if constexpr (MODE == E_RET || MODE == E_ATT) {
                                const u32x2 g2 = gw[m][bj][n];
                                f32x4 gv; gv[0] = sigmoidf_(bf2f(g2.x & 0xffffu)); gv[1] = sigmoidf_(bf2f(g2.x >> 16)); gv[2] = sigmoidf_(bf2f(g2.y & 0xffffu)); gv[3] = sigmoidf_(bf2f(g2.y >> 16));
                                if constexpr (MODE == E_RET) { *(u32x2*)(t + off) = f32_to_bf4(gv * a); }
                                else { const f32x4 o = bf4_to_f32(tv[m][bj][n]) + gv * a; u32x2 w; w.x = cvt_pk_bf16(o[0], o[1]); w.y = cvt_pk_bf16(o[2], o[3]); *(u32x2*)(ob + off) = w; }
                            } else if constexpr (MODE == E_PLE) {
                                *(u32x2*)(t + off) = f32_to_bf4(a);
                            } else {
                                f32x4 x = xr ? xv[m][bj][n] : bf4_to_f32(xw[m][bj][n]);
                                if constexpr (MODE == E_GATE) { f32x4 sg; sg[0] = sigmoidf_(a[0]); sg[1] = sigmoidf_(a[1]); sg[2] = sigmoidf_(a[2]); sg[3] = sigmoidf_(a[3]); x = x + bf4_to_f32(tv[m][bj][n]) * sg; }
                                else x = x + a;
                                u32x2 w; w.x = cvt_pk_bf16(x[0], x[1]); w.y = cvt_pk_bf16(x[2], x[3]); *(u32x2*)(ob + off) = w;
                                ssq += (x[0] * x[0] + x[1] * x[1]) + (x[2] * x[2] + x[3] * x[3]);
                            }
                        }
                    if constexpr (MODE == E_RES || MODE == E_GATE) {
                        ssq += __shfl_xor(ssq, 16); ssq += __shfl_xor(ssq, 32);
                        if (fq == 0) ssp_out[(size_t)row * 16 + u.pn * 4 + wc] = ssq;
                    }
                }
            }
        }
    }
};
template <class Epi, class Sched, bool ALIGN_EPI = false, bool SP2 = false>
__device__ __forceinline__ void gemm_phase(PG8_LAS unsigned char* lds, const Gemm g, const Sched& S, const Epi& E) {
    int tid_ = threadIdx.x; asm volatile("" : "+v"(tid_));
    const int tid = tid_, wid = __builtin_amdgcn_readfirstlane(tid >> 6), lane = tid & 63, wr = wid >> 2, wc = wid & 3, fr = lane & 15, fq = lane >> 4;
    const int K = g.K, nt = K / BK;
    unsigned voffA[2], voffB[2];
#pragma unroll
    for (int i = 0; i < 2; ++i) { int R, C; stage_rc(tid * 16 + i * 8192, R, C); const int Rb = Epi::PERM ? ((R & ~31) + perm32(R & 31)) : R;
        voffA[i] = (unsigned)(R * K + C) * 2u; voffB[i] = (unsigned)(Rb * K + C) * 2u; }
    const size_t kstep = (size_t)(BK * 2);
    const size_t hstep = (size_t)HALF * K * 2;
    const size_t tstep = 2 * hstep;
    const unsigned ldsw = (unsigned)wid * 1024u;
    const int aoff = lds_byte(wr * 64 + fr, fq * 8), boff = lds_byte(wc * 32 + fr, fq * 8);
#define PG8_SA(b, h) (((b) * 2 + (h)) * HTB)
#define PG8_SB(b, h) ((4 + (b) * 2 + (h)) * HTB)
#define PG8_STAGE(bufoff, gbase, voff) do { _Pragma("unroll") for (int _i = 0; _i < 2; ++_i) \
        __builtin_amdgcn_global_load_lds((const unsigned*)((const char*)(gbase) + (voff)[_i]), (PG8_LAS unsigned*)(lds + (bufoff) + ldsw + _i * 8192), 16, 0, 0); } while (0)
#define PG8_LDA(dst, b, h) do { _Pragma("unroll") for (int m = 0; m < 4; ++m) _Pragma("unroll") for (int k = 0; k < 2; ++k) dst[m][k] = *(const PG8_LAS bf16x8*)(lds + PG8_SA(b, h) + aoff + m * 2048 + k * 1024); } while (0)
#define PG8_LDB(dst, b, h) do { _Pragma("unroll") for (int n = 0; n < 2; ++n) _Pragma("unroll") for (int k = 0; k < 2; ++k) dst[n][k] = *(const PG8_LAS bf16x8*)(lds + PG8_SB(b, h) + boff + n * 2048 + k * 1024); } while (0)
#define PG8_MMA(ai, bj, At, Bt) do { __builtin_amdgcn_s_setprio(1); _Pragma("unroll") for (int m = 0; m < 4; ++m) _Pragma("unroll") for (int n = 0; n < 2; ++n) _Pragma("unroll") for (int k = 0; k < 2; ++k) \
        acc[ai][bj][m][n] = __builtin_amdgcn_mfma_f32_16x16x32_bf16(Bt[n][k], At[m][k], acc[ai][bj][m][n], 0, 0, 0); __builtin_amdgcn_s_setprio(0); } while (0)
#define PG8_WAIT_V(n) asm volatile("s_waitcnt vmcnt(" #n ")" ::: "memory")
#define PG8_WAIT_L(n) asm volatile("s_waitcnt lgkmcnt(" #n ")" ::: "memory")
#define PG8_BAR __builtin_amdgcn_s_barrier()
#define PG8_SCHED __builtin_amdgcn_sched_barrier(0)
    Unit cur, nxt; int ui = 0;
    if (!S.next(0, cur)) return;
    f32x4 acc[2][2][4][2];
#pragma unroll
    for (int a = 0; a < 2; ++a)
#pragma unroll
        for (int b = 0; b < 2; ++b)
#pragma unroll
            for (int m = 0; m < 4; ++m)
#pragma unroll
                for (int n = 0; n < 2; ++n) acc[a][b][m][n] = (f32x4){0.f, 0.f, 0.f, 0.f};
    bf16x8 At[4][2], B0[2][2], B1[2][2];
    const char* cA = (const char*)g.A + (size_t)cur.pm * tstep; const char* cB = (const char*)g.Bt + (size_t)cur.pn * tstep;
    S.a_ready(cur);
    if constexpr (SP2) {
        PG8_STAGE(PG8_SB(0, 0), cB, voffB); PG8_STAGE(PG8_SB(0, 1), cB + hstep, voffB); PG8_STAGE(PG8_SA(0, 0), cA, voffA); PG8_STAGE(PG8_SA(0, 1), cA + hstep, voffA);
        if (wr == 1) PG8_BAR;
        PG8_WAIT_V(2); PG8_BAR;
        PG8_STAGE(PG8_SB(1, 0), cB + kstep, voffB); PG8_STAGE(PG8_SA(1, 0), cA + kstep, voffA); PG8_STAGE(PG8_SB(1, 1), cB + hstep + kstep, voffB);
        PG8_WAIT_V(6); PG8_BAR;
    } else {
        PG8_STAGE(PG8_SB(0, 0), cB, voffB); PG8_STAGE(PG8_SA(0, 0), cA, voffA); PG8_STAGE(PG8_SB(0, 1), cB + hstep, voffB); PG8_STAGE(PG8_SA(0, 1), cA + hstep, voffA);
        if (wr == 1) PG8_BAR;
        PG8_WAIT_V(4); PG8_BAR;
        PG8_STAGE(PG8_SB(1, 0), cB + kstep, voffB); PG8_STAGE(PG8_SA(1, 0), cA + kstep, voffA); PG8_STAGE(PG8_SB(1, 1), cB + hstep + kstep, voffB);
        PG8_WAIT_V(6); PG8_BAR;
    }
    for (;;) {
        const bool has_next = S.next(ui + 1, nxt);
        const char* nA = has_next ? (const char*)g.A + (size_t)nxt.pm * tstep : cA; const char* nB = has_next ? (const char*)g.Bt + (size_t)nxt.pn * tstep : cB;
        for (int t = 0; t < nt; t += 2) {
            const bool last = (t == nt - 2);
            const char* a1 = cA + (size_t)(t + 1) * kstep;
            const char* a2 = last ? nA : cA + (size_t)(t + 2) * kstep; const char* b2 = last ? nB : cB + (size_t)(t + 2) * kstep;
            const char* a3 = a2 + kstep; const char* b3 = b2 + kstep;
            if (last && has_next) S.a_ready(nxt);
            if constexpr (SP2) {
            PG8_LDB(B0, 0, 0); PG8_LDB(B1, 0, 1); PG8_SCHED; PG8_LDA(At, 0, 0); PG8_STAGE(PG8_SA(1, 1), a1 + hstep, voffA);
            PG8_WAIT_V(8); PG8_WAIT_L(0); PG8_BAR; PG8_MMA(0, 0, At, B0); PG8_MMA(0, 1, At, B1); PG8_BAR; PG8_SCHED;
            PG8_LDA(At, 0, 1); PG8_STAGE(PG8_SB(0, 0), b2, voffB); PG8_STAGE(PG8_SB(0, 1), b2 + hstep, voffB); PG8_STAGE(PG8_SA(0, 0), a2, voffA);
            PG8_WAIT_V(8); PG8_WAIT_L(0); PG8_BAR; PG8_MMA(1, 0, At, B0); PG8_MMA(1, 1, At, B1); PG8_BAR; PG8_SCHED;
            PG8_LDB(B0, 1, 0); PG8_LDB(B1, 1, 1); PG8_SCHED; PG8_LDA(At, 1, 0); PG8_STAGE(PG8_SA(0, 1), a2 + hstep, voffA);
            PG8_WAIT_V(8); PG8_WAIT_L(0); PG8_BAR; PG8_MMA(0, 0, At, B0); PG8_MMA(0, 1, At, B1); PG8_BAR; PG8_SCHED;
            PG8_LDA(At, 1, 1); PG8_STAGE(PG8_SB(1, 0), b3, voffB); PG8_STAGE(PG8_SB(1, 1), b3 + hstep, voffB); PG8_STAGE(PG8_SA(1, 0), a3, voffA);
            PG8_WAIT_V(8); PG8_WAIT_L(0); PG8_BAR; PG8_MMA(1, 0, At, B0); PG8_MMA(1, 1, At, B1); PG8_BAR; PG8_SCHED;
            } else {
            PG8_LDB(B0, 0, 0); PG8_SCHED; PG8_LDA(At, 0, 0); PG8_STAGE(PG8_SA(1, 1), a1 + hstep, voffA);
            PG8_WAIT_L(8); PG8_BAR; PG8_WAIT_L(0); PG8_MMA(0, 0, At, B0); PG8_BAR; PG8_SCHED;
            PG8_LDB(B1, 0, 1); PG8_STAGE(PG8_SB(0, 0), b2, voffB);
            PG8_BAR; PG8_WAIT_L(0); PG8_MMA(0, 1, At, B1); PG8_BAR;
            PG8_LDA(At, 0, 1); PG8_STAGE(PG8_SA(0, 0), a2, voffA);
            PG8_BAR; PG8_WAIT_L(0); PG8_MMA(1, 0, At, B0); PG8_BAR; PG8_SCHED;
            PG8_STAGE(PG8_SB(0, 1), b2 + hstep, voffB);
            PG8_WAIT_V(6); PG8_BAR; PG8_MMA(1, 1, At, B1); PG8_BAR;
            PG8_LDB(B0, 1, 0); PG8_SCHED; PG8_LDA(At, 1, 0); PG8_STAGE(PG8_SA(0, 1), a2 + hstep, voffA);
            PG8_WAIT_L(8); PG8_BAR; PG8_WAIT_L(0); PG8_MMA(0, 0, At, B0); PG8_BAR; PG8_SCHED;
            PG8_LDB(B1, 1, 1); PG8_STAGE(PG8_SB(1, 0), b3, voffB);
            PG8_BAR; PG8_WAIT_L(0); PG8_MMA(0, 1, At, B1); PG8_BAR;
            PG8_LDA(At, 1, 1); PG8_STAGE(PG8_SA(1, 0), a3, voffA);
            PG8_BAR; PG8_WAIT_L(0); PG8_MMA(1, 0, At, B0); PG8_BAR; PG8_SCHED;
            PG8_STAGE(PG8_SB(1, 1), b3 + hstep, voffB);
            PG8_WAIT_V(6); PG8_BAR; PG8_MMA(1, 1, At, B1); PG8_BAR;
            }
        }
        if constexpr (ALIGN_EPI) { if (wr == 0) PG8_BAR; }
        if constexpr (!Epi::AFTER_DRAIN) { E(acc, cur, wr, wc, fr, fq); S.done(cur); }
        if (!has_next) break;
#pragma unroll
        for (int a = 0; a < 2; ++a)
#pragma unroll
            for (int b = 0; b < 2; ++b)
#pragma unroll
                for (int m = 0; m < 4; ++m)
#pragma unroll
                    for (int n = 0; n < 2; ++n) acc[a][b][m][n] = (f32x4){0.f, 0.f, 0.f, 0.f};
        cur = nxt; cA = nA; cB = nB; ++ui;
        if constexpr (ALIGN_EPI) { if (wr == 1) PG8_BAR; }
    }
    PG8_WAIT_V(0);
    if constexpr (!ALIGN_EPI) { if (wr == 0) PG8_BAR; }
    PG8_BAR;
    if constexpr (Epi::AFTER_DRAIN) { E.fused(acc, cur, wr, wc, fr, fq, lds, wid, lane); S.done(cur); }
#undef PG8_SA
#undef PG8_SB
#undef PG8_STAGE
#undef PG8_LDA
#undef PG8_LDB
#undef PG8_MMA
#undef PG8_WAIT_V
#undef PG8_WAIT_L
#undef PG8_BAR
#undef PG8_SCHED
}
}

#define LAS __attribute__((address_space(3)))
typedef unsigned short bf16_t;
typedef short bf16x8 __attribute__((ext_vector_type(8)));
typedef short v4i16_t __attribute__((ext_vector_type(4)));
typedef float f32x4 __attribute__((ext_vector_type(4)));
typedef float f32x2 __attribute__((ext_vector_type(2)));
typedef unsigned u32x4 __attribute__((ext_vector_type(4)));
typedef unsigned u32x2 __attribute__((ext_vector_type(2)));

constexpr int MP = 16384, MS = 256, MT = MP + MS;
constexpr int DM = 1024, DIN = 9728, DFF = 4096, DPLE = 256, SEQ = 8192;
constexpr int Z_RQ = 0, Z_RK = 512, Z_RV = 1024, Z_RG = 2048, Z_AQ = 3072, Z_AK = 4608, Z_AV = 6144, Z_GA = 7680, Z_GB = 8704;
constexpr int LDS_BYTES = 147456;
constexpr float QK_SCALE = 0.08838834764831845f;

constexpr size_t WT_IN = 0, WT_RET = WT_IN + (size_t)DIN * DM * 2, WT_ATT = WT_RET + (size_t)DM * DM * 2, WT_OUT = WT_ATT + (size_t)DM * 512 * 2,
                 WT_UP = WT_OUT + (size_t)DM * DM * 2, WT_DOWN = WT_UP + (size_t)DFF * DM * 2, WT_PLE = WT_DOWN + (size_t)DFF * DM * 2,
                 WT_GATE = WT_PLE + (size_t)DM * DPLE * 2, WT_LAYER = WT_GATE + (size_t)DM * DM * 2;
constexpr size_t WS_WT = 0;
constexpr size_t WS_XF = WS_WT + 2 * WT_LAYER;
constexpr size_t WS_XBA = WS_XF + (size_t)MT * DM * 4;
constexpr size_t WS_XBB = WS_XBA + (size_t)MT * DM * 2;
constexpr size_t WS_SSP = WS_XBB + (size_t)MT * DM * 2;
constexpr size_t WS_PB = WS_SSP + (size_t)MT * 16 * 4;
constexpr size_t WS_Z = WS_PB + (size_t)2 * MT * DPLE * 2;
constexpr size_t WS_ORET = WS_Z + (size_t)MT * DIN * 2;
constexpr size_t WS_OATT = WS_ORET + (size_t)MT * DM * 2;
constexpr size_t WS_MERGED = WS_OATT + (size_t)MT * 512 * 2;
constexpr size_t WS_T = WS_MERGED + (size_t)MT * DM * 2;
constexpr size_t WS_OG = WS_T + (size_t)MT * DM * 4;
constexpr size_t WS_LSE = WS_OG + (size_t)3 * MT * 512 * 4;
constexpr size_t WS_U = WS_LSE + (size_t)3 * MT * 4 * 4;
constexpr size_t WS_RP = WS_U + (size_t)512 * 32768 * 4;
constexpr size_t WS_CTL = WS_RP + (size_t)512 * 32768 * 2;
constexpr size_t WS_END = WS_CTL + 16384;

constexpr size_t O_Y = 0;
constexpr size_t O_PWK0 = (size_t)MT * DM, O_PWV0 = O_PWK0 + 262144, O_PWK1 = O_PWV0 + 262144, O_PWV1 = O_PWK1 + 1048576, O_PWK2 = O_PWV1 + 1048576, O_PWV2 = O_PWK2 + 4194304;
constexpr size_t O_PRET = O_PWV2 + 4194304;
constexpr size_t O_SWK0 = O_PRET + 524288, O_SWV0 = O_SWK0 + 4194304, O_SWK1 = O_SWV0 + 4194304, O_SWV1 = O_SWK1 + 16777216, O_SWK2 = O_SWV1 + 16777216, O_SWV2 = O_SWK2 + 67108864;
constexpr size_t O_SRET = O_SWV2 + 67108864;
constexpr size_t O_END = O_SRET + 8388608;

struct Args { const float* in[22]; float* out; unsigned char* ws; };

__device__ __forceinline__ unsigned f2bf(float f) { unsigned u = __builtin_bit_cast(unsigned, f); return (u + 0x7fffu + ((u >> 16) & 1u)) >> 16; }
__device__ __forceinline__ unsigned pk2(float lo, float hi) { return f2bf(lo) | (f2bf(hi) << 16); }
__device__ __forceinline__ float bflo(unsigned w) { return __uint_as_float(w << 16); }
__device__ __forceinline__ float bfhi(unsigned w) { return __uint_as_float(w & 0xffff0000u); }
__device__ __forceinline__ float wave_sum(float v) {
#pragma unroll
    for (int o = 1; o < 64; o <<= 1) v += __shfl_xor(v, o);
    return v;
}
__device__ __forceinline__ float ret_lg(int h) { const float A = -3.4657359028f, B = -6.2383246250f; return log1pf(-expf(A + (B - A) * (float)h * (1.0f / 3.0f))); }
__device__ __forceinline__ v4i16_t tr4(LAS const unsigned char* p) { return __builtin_amdgcn_ds_read_tr16_b64_v4i16((LAS v4i16_t*)p); }
__device__ __forceinline__ bf16x8 cat8(v4i16_t a, v4i16_t b) { return __builtin_shufflevector(a, b, 0, 1, 2, 3, 4, 5, 6, 7); }
#define MFMA16(a, b, c) __builtin_amdgcn_mfma_f32_16x16x32_bf16((a), (b), (c), 0, 0, 0)

__device__ __forceinline__ void p0_transpose_item(const float* __restrict__ W, int K, int N, bf16_t* __restrict__ WT, const float* __restrict__ gain, bool is_in, LAS float* scr, int item, int lane) {
    const int nblk = N / 64, kb = item / nblk, nb = item % nblk, k0 = 64 * kb, n0 = 64 * nb;
    const int kr = lane >> 4, nc = 4 * (lane & 15);
#pragma unroll 8
    for (int i = 0; i < 16; ++i) { const int kk = 4 * i + kr; f32x4 v = *(const f32x4*)(W + (size_t)(k0 + kk) * N + n0 + nc); if (gain) v = v * gain[k0 + kk];
        LAS float* d = scr + kk * 65 + nc; d[0] = v[0]; d[1] = v[1]; d[2] = v[2]; d[3] = v[3]; }
    asm volatile("s_waitcnt lgkmcnt(0)" ::: "memory");
    const int c = lane & 7;
#pragma unroll
    for (int j = 0; j < 8; ++j) { const int n = (lane >> 3) + 8 * j; const LAS float* s = scr + (8 * c) * 65 + n; const int ng = n0 + n;
        const float sc = (is_in && ((ng >= Z_RK && ng < Z_RV) || (ng >= Z_AQ && ng < Z_AK))) ? QK_SCALE : 1.0f;
        u32x4 o; o.x = pk2(s[0 * 65] * sc, s[1 * 65] * sc); o.y = pk2(s[2 * 65] * sc, s[3 * 65] * sc); o.z = pk2(s[4 * 65] * sc, s[5 * 65] * sc); o.w = pk2(s[6 * 65] * sc, s[7 * 65] * sc);
        *(u32x4*)(WT + (size_t)ng * K + k0 + 8 * c) = o; }
    asm volatile("s_waitcnt lgkmcnt(0)" ::: "memory");
}

__device__ __forceinline__ void p0_prologue(const Args& a, LAS unsigned char* lds, int tid) {
    const int lane = tid & 63, wave = tid >> 6;
    const int gw = blockIdx.x * 8 + wave, NGW = gridDim.x * 8;
    LAS float* scr = (LAS float*)(lds + wave * 16640);
    constexpr int I_IN = 16 * 152, I_RET = 16 * 16, I_ATT = 8 * 16, I_OUT = 16 * 16, I_UP = 16 * 64, I_DOWN = 64 * 16, I_PLE = 4 * 16, I_GATE = 16 * 16;
    constexpr int I_LAYER = I_IN + I_RET + I_ATT + I_OUT + I_UP + I_DOWN + I_PLE + I_GATE;
    for (int it = gw; it < 2 * I_LAYER; it += NGW) {
        const int l = it / I_LAYER; int r = it % I_LAYER;
        unsigned char* wl = a.ws + WS_WT + (size_t)l * WT_LAYER;
        if (r < I_IN) { p0_transpose_item(a.in[12] + (size_t)l * DM * DIN, DM, DIN, (bf16_t*)(wl + WT_IN), a.in[11] + l * DM, true, scr, r, lane); continue; } r -= I_IN;
        if (r < I_RET) { p0_transpose_item(a.in[13] + (size_t)l * DM * DM, DM, DM, (bf16_t*)(wl + WT_RET), nullptr, false, scr, r, lane); continue; } r -= I_RET;
        if (r < I_ATT) { p0_transpose_item(a.in[14] + (size_t)l * 512 * DM, 512, DM, (bf16_t*)(wl + WT_ATT), nullptr, false, scr, r, lane); continue; } r -= I_ATT;
        if (r < I_OUT) { p0_transpose_item(a.in[15] + (size_t)l * DM * DM, DM, DM, (bf16_t*)(wl + WT_OUT), nullptr, false, scr, r, lane); continue; } r -= I_OUT;
        if (r < I_UP) { p0_transpose_item(a.in[17] + (size_t)l * DM * DFF, DM, DFF, (bf16_t*)(wl + WT_UP), a.in[16] + l * DM, false, scr, r, lane); continue; } r -= I_UP;
        if (r < I_DOWN) { p0_transpose_item(a.in[18] + (size_t)l * DFF * DM, DFF, DM, (bf16_t*)(wl + WT_DOWN), nullptr, false, scr, r, lane); continue; } r -= I_DOWN;
        if (r < I_PLE) { p0_transpose_item(a.in[19] + (size_t)l * DPLE * DM, DPLE, DM, (bf16_t*)(wl + WT_PLE), nullptr, false, scr, r, lane); continue; } r -= I_PLE;
        p0_transpose_item(a.in[20] + (size_t)l * DM * DM, DM, DM, (bf16_t*)(wl + WT_GATE), nullptr, false, scr, r, lane);
    }
    bf16_t* xb = (bf16_t*)(a.ws + WS_XBA); float* ssp = (float*)(a.ws + WS_SSP);
    for (int m = gw; m < MT; m += NGW) {
        const float* src = (m < MP) ? a.in[0] + (size_t)m * DM : a.in[1] + (size_t)(m - MP) * DM;
        f32x4 v[4]; float s = 0.f;
#pragma unroll
        for (int j = 0; j < 4; ++j) { v[j] = *(const f32x4*)(src + 4 * lane + 256 * j); s += (v[j][0] * v[j][0] + v[j][1] * v[j][1]) + (v[j][2] * v[j][2] + v[j][3] * v[j][3]); }
        s = wave_sum(s);
#pragma unroll
        for (int j = 0; j < 4; ++j) { u32x2 w; w.x = pk2(v[j][0], v[j][1]); w.y = pk2(v[j][2], v[j][3]); *(u32x2*)(xb + (size_t)m * DM + 4 * lane + 256 * j) = w; }
        if (lane < 16) ssp[(size_t)m * 16 + lane] = (lane == 0) ? s : 0.f;
    }
    bf16_t* pb = (bf16_t*)(a.ws + WS_PB);
    for (int q = gw; q < 2 * MT; q += NGW) {
        const int l = q / MT, m = q % MT;
        const float* src = (m < MP) ? a.in[9] + ((size_t)l * MP + m) * DPLE : a.in[10] + ((size_t)l * MS + (m - MP)) * DPLE;
        const f32x4 v = *(const f32x4*)(src + 4 * lane);
        u32x2 w; w.x = pk2(v[0], v[1]); w.y = pk2(v[2], v[3]); *(u32x2*)(pb + (size_t)q * DPLE + 4 * lane) = w;
    }
}

constexpr size_t CC_TOTAL = 2 * 64 * 128 * (size_t)(120 + 504 + 2040);
__device__ __forceinline__ void cache_copy_range(const Args& a, size_t q0, size_t q1, int tid) {
    size_t base = 0;
#pragma unroll 1
    for (int kvg = 0; kvg < 6; ++kvg) {
        const int g = kvg >> 1, W = 128 << (2 * g);
        const size_t per = (size_t)(W - 8) * 128, n = 64 * per, full = (size_t)W * 128;
        const size_t lo = q0 > base ? q0 : base, hi = q1 < base + n ? q1 : base + n;
        if (lo < hi) {
            const f32x4* src = (const f32x4*)a.in[2 + kvg];
            const size_t ooff = (kvg == 0) ? O_SWK0 : (kvg == 1) ? O_SWV0 : (kvg == 2) ? O_SWK1 : (kvg == 3) ? O_SWV1 : (kvg == 4) ? O_SWK2 : O_SWV2;
            f32x4* dst = (f32x4*)(a.out + ooff);
            size_t p = lo - base; const size_t pe = hi - base;
#pragma unroll 1
            while (p < pe) {
                const size_t lb = p / per, rem = p - lb * per;
                const size_t c0 = per - rem, c1 = pe - p, cnt = c0 < c1 ? c0 : c1;
                const f32x4* s = src + lb * full + 1024 + rem; f32x4* d = dst + lb * full + rem;
#pragma unroll 1
                for (size_t i = tid; i < cnt; i += 512 * 16) {
                    f32x4 v[16];
#pragma unroll
                    for (int k = 0; k < 16; ++k) if (i + k * 512 < cnt) v[k] = __builtin_nontemporal_load(s + i + k * 512);
#pragma unroll
                    for (int k = 0; k < 16; ++k) if (i + k * 512 < cnt) __builtin_nontemporal_store(v[k], d + i + k * 512);
                }
                p += cnt;
            }
        }
        base += n;
    }
}
__device__ __forceinline__ void cache_copy_tail(const Args& a, int nwg, int f0, int f1, int tid) {
    const int G = gridDim.x, fi = nwg % G, c = blockIdx.x;
    if (c < fi) return;
    const size_t R0 = CC_TOTAL * (size_t)f0 / 1000, R1 = CC_TOTAL * (size_t)f1 / 1000, nidle = (size_t)(G - fi), idx = (size_t)(c - fi);
    cache_copy_range(a, R0 + (R1 - R0) * idx / nidle, R0 + (R1 - R0) * (idx + 1) / nidle, tid);
}

constexpr int KVS = 272;
constexpr int AT_VOFF = 256 * KVS;
__device__ __forceinline__ void attn_prompt_item(LAS unsigned char* lds, const bf16_t* __restrict__ z, bf16_t* __restrict__ og, float* __restrict__ lse, int item, int tid) {
    const int wid = __builtin_amdgcn_readfirstlane(tid >> 6), lane = tid & 63, fr = lane & 15, quad = lane >> 4;
    const int blk = item & 63; int rest = item >> 6; const int j = rest & 3; rest >>= 2; const int g = rest % 3, b = rest / 3;
    const int dsh = 2 * g, dil = 1 << dsh, r = blk >> (6 - dsh), qb = blk & ((64 >> dsh) - 1), hh = g * 4 + j;
    const float slope_d = exp2f(-8.0f * (float)(hh + 1) / 12.0f) * (float)dil;
    const bf16_t* zb = z + (size_t)b * SEQ * DIN;
#pragma unroll
    for (int it = 0; it < 8; ++it) {
        const int idx = tid + it * 512, kk = idx >> 4, ch = idx & 15, sp = 128 * qb - 128 + kk;
        u32x4 kv = {0u, 0u, 0u, 0u}, vv = {0u, 0u, 0u, 0u};
        if (sp >= 0) { const bf16_t* zr = zb + (size_t)(sp * dil + r) * DIN + hh * 128 + ch * 8; kv = *(const u32x4*)(zr + Z_AK); vv = *(const u32x4*)(zr + Z_AV); }
        *(LAS u32x4*)(lds + kk * KVS + ch * 16) = kv; *(LAS u32x4*)(lds + AT_VOFF + kk * KVS + ch * 16) = vv;
    }
    const int sq = 128 * qb + 16 * wid + fr;
    const size_t qrow = (size_t)b * SEQ + (size_t)(sq * dil + r);
    bf16x8 qf[4];
#pragma unroll
    for (int ks = 0; ks < 4; ++ks) qf[ks] = *(const bf16x8*)(z + qrow * DIN + Z_AQ + hh * 128 + ks * 32 + quad * 8);
    __syncthreads();
    f32x4 sc[9];
#pragma unroll
    for (int kt = 0; kt < 9; ++kt) {
        f32x4 acc = {0.f, 0.f, 0.f, 0.f};
#pragma unroll
        for (int ks = 0; ks < 4; ++ks) { const bf16x8 ka = *(LAS const bf16x8*)(lds + (16 * (wid + kt) + fr) * KVS + ks * 64 + quad * 16); acc = MFMA16(ka, qf[ks], acc); }
        sc[kt] = acc;
    }
    float mx = -INFINITY;
#pragma unroll
    for (int kt = 0; kt < 9; ++kt)
#pragma unroll
        for (int e = 0; e < 4; ++e) {
            const int dist = 128 - 16 * kt + fr - 4 * quad - e, keyrel = 16 * (wid + kt) + 4 * quad + e;
            const bool valid = (dist >= 0) && (dist <= 128) && (qb > 0 || keyrel >= 128);
            const float s = valid ? sc[kt][e] - slope_d * (float)dist : -INFINITY;
            sc[kt][e] = s; mx = fmaxf(mx, s);
        }
    mx = fmaxf(mx, __shfl_xor(mx, 16)); mx = fmaxf(mx, __shfl_xor(mx, 32));
    float den = 0.f;
#pragma unroll
    for (int kt = 0; kt < 9; ++kt)
#pragma unroll
        for (int e = 0; e < 4; ++e) { const float p = __expf(sc[kt][e] - mx); sc[kt][e] = p; den += p; }
    den += __shfl_xor(den, 16); den += __shfl_xor(den, 32);
    const float inv = 1.0f / den;
    f32x4 o[8];
#pragma unroll
    for (int dt = 0; dt < 8; ++dt) o[dt] = (f32x4){0.f, 0.f, 0.f, 0.f};
#pragma unroll
    for (int kp = 0; kp < 5; ++kp) {
        const int TA = wid + 2 * kp, TB = (2 * kp + 1 < 9) ? TA + 1 : TA;
        u32x4 pw; pw.x = pk2(sc[2 * kp][0] * inv, sc[2 * kp][1] * inv); pw.y = pk2(sc[2 * kp][2] * inv, sc[2 * kp][3] * inv);
        if (2 * kp + 1 < 9) { pw.z = pk2(sc[(2 * kp + 1) % 9][0] * inv, sc[(2 * kp + 1) % 9][1] * inv); pw.w = pk2(sc[(2 * kp + 1) % 9][2] * inv, sc[(2 * kp + 1) % 9][3] * inv); } else { pw.z = 0u; pw.w = 0u; }
        const bf16x8 p8 = __builtin_bit_cast(bf16x8, pw);
        LAS const unsigned char* bA = lds + AT_VOFF + (16 * TA + 4 * quad + (fr >> 2)) * KVS + (fr & 3) * 8;
        LAS const unsigned char* bB = lds + AT_VOFF + (16 * TB + 4 * quad + (fr >> 2)) * KVS + (fr & 3) * 8;
#pragma unroll
        for (int dt = 0; dt < 8; ++dt) { const v4i16_t va = tr4(bA + dt * 32), vb = tr4(bB + dt * 32); o[dt] = MFMA16(cat8(va, vb), p8, o[dt]); }
    }
    bf16_t* orow = og + ((size_t)g * MT + qrow) * 512 + j * 128 + 4 * quad;
#pragma unroll
    for (int dt = 0; dt < 8; ++dt) { u32x2 w; w.x = pk2(o[dt][0], o[dt][1]); w.y = pk2(o[dt][2], o[dt][3]); *(u32x2*)(orow + 16 * dt) = w; }
    if (quad == 0) lse[((size_t)g * MT + qrow) * 4 + j] = mx + __logf(den);
    __syncthreads();
}

constexpr int RVS = 528;
constexpr int RU_VOFF = 128 * KVS;
__device__ __forceinline__ void ret_u_item(LAS unsigned char* lds, const bf16_t* __restrict__ z, bf16_t* __restrict__ U, int item, int tid) {
    const int wid = __builtin_amdgcn_readfirstlane(tid >> 6), lane = tid & 63, fr = lane & 15, quad = lane >> 4;
    const int c = item & 63, bh = item >> 6, h = bh & 3, b = bh >> 2;
    const float lg = ret_lg(h);
    const bf16_t* z0 = z + ((size_t)b * SEQ + 128 * c) * DIN;
#pragma unroll
    for (int it = 0; it < 4; ++it) {
        const int idx = tid + it * 512, jj = idx >> 4, ch = idx & 15;
        const u32x4 kv = *(const u32x4*)(z0 + (size_t)jj * DIN + Z_RK + h * 128 + ch * 8);
        const float zeta = __expf(lg * (float)(127 - jj));
        u32x4 o; o.x = pk2(bflo(kv.x) * zeta, bfhi(kv.x) * zeta); o.y = pk2(bflo(kv.y) * zeta, bfhi(kv.y) * zeta); o.z = pk2(bflo(kv.z) * zeta, bfhi(kv.z) * zeta); o.w = pk2(bflo(kv.w) * zeta, bfhi(kv.w) * zeta);
        *(LAS u32x4*)(lds + jj * KVS + ch * 16) = o;
    }
#pragma unroll
    for (int it = 0; it < 8; ++it) {
        const int idx = tid + it * 512, jj = idx >> 5, ch = idx & 31;
        *(LAS u32x4*)(lds + RU_VOFF + jj * RVS + ch * 16) = *(const u32x4*)(z0 + (size_t)jj * DIN + Z_RV + h * 256 + ch * 8);
    }
    __syncthreads();
    f32x4 acc[2][8];
#pragma unroll
    for (int a = 0; a < 2; ++a)
#pragma unroll
        for (int d = 0; d < 8; ++d) acc[a][d] = (f32x4){0.f, 0.f, 0.f, 0.f};
#pragma unroll
    for (int ks = 0; ks < 4; ++ks) {
        const int jrow = 32 * ks + 8 * quad + (fr >> 2);
        bf16x8 A[2];
#pragma unroll
        for (int a = 0; a < 2; ++a) { LAS const unsigned char* p = lds + RU_VOFF + jrow * RVS + (16 * (2 * wid + a) + 4 * (fr & 3)) * 2; A[a] = cat8(tr4(p), tr4(p + 4 * RVS)); }
#pragma unroll
        for (int d = 0; d < 8; ++d) { LAS const unsigned char* p = lds + jrow * KVS + (16 * d + 4 * (fr & 3)) * 2; const bf16x8 B = cat8(tr4(p), tr4(p + 4 * KVS));
            acc[0][d] = MFMA16(B, A[0], acc[0][d]); acc[1][d] = MFMA16(B, A[1], acc[1][d]); }
    }
    bf16_t* Uo = U + (size_t)item * 32768;
#pragma unroll
    for (int a = 0; a < 2; ++a)
#pragma unroll
        for (int d = 0; d < 8; ++d) { u32x2 w; w.x = pk2(acc[a][d][0], acc[a][d][1]); w.y = pk2(acc[a][d][2], acc[a][d][3]); *(u32x2*)(Uo + (16 * (2 * wid + a) + fr) * 128 + 16 * d + 4 * quad) = w; }
    __syncthreads();
}

__device__ __forceinline__ void ret_sample_item(LAS unsigned char* lds, const bf16_t* __restrict__ z, const float* __restrict__ S0, float* __restrict__ Sout, bf16_t* __restrict__ oret, int item, int tid) {
    const int h = item & 3, b = item >> 2;
    const int lane = tid & 63, wave = tid >> 6;
    const float lg = ret_lg(h);
    LAS float* qs = (LAS float*)lds;
    LAS float* ksm = qs + 1024;
    LAS float* Pm = ksm + 1024;
    LAS float* red = Pm + 64;
    LAS float* ob = red + 4096;
    const bf16_t* z0 = z + (size_t)(MP + b * 8) * DIN;
    for (int idx = tid; idx < 1024; idx += 512) { const int i = idx >> 7, d = idx & 127; qs[idx] = __uint_as_float((unsigned)z0[(size_t)i * DIN + Z_RQ + h * 128 + d] << 16); ksm[idx] = __uint_as_float((unsigned)z0[(size_t)i * DIN + Z_RK + h * 128 + d] << 16); }
    const int v = tid & 255, half = tid >> 8;
    float vv[8], vz[8];
#pragma unroll
    for (int jj = 0; jj < 8; ++jj) { vv[jj] = __uint_as_float((unsigned)z0[(size_t)jj * DIN + Z_RV + h * 256 + v] << 16); vz[jj] = vv[jj] * __expf(lg * (float)(7 - jj)); }
    __syncthreads();
    if (tid < 64) { const int i = tid >> 3, jj = tid & 7; float s = 0.f; for (int d = 0; d < 128; ++d) s += qs[i * 128 + d] * ksm[jj * 128 + d]; Pm[tid] = (jj <= i) ? s * __expf(lg * (float)(i - jj)) : 0.f; }
    const float cd = __expf(lg * 8.0f);
    float cr[8];
#pragma unroll
    for (int i = 0; i < 8; ++i) cr[i] = 0.f;
    const float* Sp = S0 + (size_t)item * 32768 + v; float* So = Sout + (size_t)item * 32768 + v;
#pragma unroll 16
    for (int dd = 0; dd < 64; ++dd) {
        const int d = half * 64 + dd;
        const float s = Sp[(size_t)d * 256];
        float nw = cd * s;
#pragma unroll
        for (int i = 0; i < 8; ++i) { cr[i] += qs[i * 128 + d] * s; nw += ksm[i * 128 + d] * vz[i]; }
        So[(size_t)d * 256] = nw;
    }
#pragma unroll
    for (int i = 0; i < 8; ++i) red[(half * 8 + i) * 256 + v] = cr[i];
    __syncthreads();
#pragma unroll
    for (int ii = 0; ii < 4; ++ii) {
        const int i = half * 4 + ii;
        float o = (red[i * 256 + v] + red[(8 + i) * 256 + v]) * __expf(lg * (float)(i + 1));
#pragma unroll
        for (int jj = 0; jj < 8; ++jj) o += Pm[i * 8 + jj] * vv[jj];
        ob[i * 256 + v] = o;
    }
    __syncthreads();
    {
        const int i = wave; float x[4]; float s = 0.f;
#pragma unroll
        for (int e = 0; e < 4; ++e) { x[e] = ob[i * 256 + 4 * lane + e]; s += x[e]; }
        const float mu = wave_sum(s) * (1.0f / 256.0f); float q = 0.f;
#pragma unroll
        for (int e = 0; e < 4; ++e) { x[e] -= mu; q += x[e] * x[e]; }
        const float rstd = 1.0f / sqrtf(wave_sum(q) * (1.0f / 256.0f) + 1e-6f);
        const u32x2 gw = *(const u32x2*)(z0 + (size_t)i * DIN + Z_RG + h * 256 + 4 * lane);
        float gq[4] = {bflo(gw.x), bfhi(gw.x), bflo(gw.y), bfhi(gw.y)};
#pragma unroll
        for (int e = 0; e < 4; ++e) x[e] = x[e] * rstd * gq[e] / (1.0f + __expf(-gq[e]));
        u32x2 w; w.x = pk2(x[0], x[1]); w.y = pk2(x[2], x[3]);
        *(u32x2*)(oret + (size_t)(MP + b * 8 + i) * DM + h * 256 + 4 * lane) = w;
    }
    __syncthreads();
}

__device__ __forceinline__ void attn_sample_item(LAS unsigned char* lds, const bf16_t* __restrict__ z, const float* __restrict__ ck, const float* __restrict__ cv, int l, bf16_t* __restrict__ og, float* __restrict__ lse, int item, int tid) {
    const int j = item & 3; int rest = item >> 2; const int g = rest % 3, b = rest / 3;
    const int lane = tid & 63, i = tid >> 6, dsh = 2 * g, dil = 1 << dsh, W = 128 << dsh, hh = g * 4 + j;
    const float slope_d = exp2f(-8.0f * (float)(hh + 1) / 12.0f) * (float)dil;
    LAS float* sc = (LAS float*)lds + i * 136;
    const size_t zrow = (size_t)MP + b * 8 + i;
    const bf16_t* zq = z + zrow * DIN + Z_AQ + hh * 128;
    const int c16 = lane & 15, rr = lane >> 4;
    float q[8];
    { const u32x2 a0 = *(const u32x2*)(zq + 4 * c16), a1 = *(const u32x2*)(zq + 64 + 4 * c16);
      q[0] = bflo(a0.x); q[1] = bfhi(a0.x); q[2] = bflo(a0.y); q[3] = bfhi(a0.y); q[4] = bflo(a1.x); q[5] = bfhi(a1.x); q[6] = bflo(a1.y); q[7] = bfhi(a1.y); }
    const float* ckb = ck + ((size_t)(l * 32 + b) * W) * 512 + j * 128 + 4 * c16;
    const float* cvb = cv + ((size_t)(l * 32 + b) * W) * 512 + j * 128 + 4 * c16;
    const bf16_t* znew = z + (size_t)(MP + b * 8) * DIN + hh * 128 + 4 * c16;
    const size_t rstride = (size_t)dil * 512 * 4;
    const float* kp0 = ckb + (size_t)(i + rr * dil) * 512;
#pragma unroll 1
    for (int bt = 0; bt < 2; ++bt) {
        f32x4 k0[15], k1[15];
#pragma unroll
        for (int t = 0; t < 15; ++t) { const float* p = kp0 + (size_t)(bt * 15 + t) * rstride; k0[t] = __builtin_nontemporal_load((const f32x4*)p); k1[t] = __builtin_nontemporal_load((const f32x4*)(p + 64)); }
#pragma unroll
        for (int t = 0; t < 15; ++t) {
            float s = (q[0] * k0[t][0] + q[1] * k0[t][1]) + (q[2] * k0[t][2] + q[3] * k0[t][3]) + (q[4] * k1[t][0] + q[5] * k1[t][1]) + (q[6] * k1[t][2] + q[7] * k1[t][3]);
            s += __shfl_xor(s, 1); s += __shfl_xor(s, 2); s += __shfl_xor(s, 4); s += __shfl_xor(s, 8);
            const int u = 4 * (bt * 15 + t) + rr;
            if (c16 == 0) sc[u] = s - slope_d * (float)(128 - u);
        }
    }
#pragma unroll
    for (int it = 30; it < 33; ++it) {
        const int u = 4 * it + rr; float s = 0.f;
        if (u <= 128) {
            const int index = i + u * dil;
            float k[8];
            if (index < W) { const f32x4 a0 = *(const f32x4*)(ckb + (size_t)index * 512), a1 = *(const f32x4*)(ckb + (size_t)index * 512 + 64);
                k[0] = a0[0]; k[1] = a0[1]; k[2] = a0[2]; k[3] = a0[3]; k[4] = a1[0]; k[5] = a1[1]; k[6] = a1[2]; k[7] = a1[3]; }
            else { const bf16_t* zk = znew + (size_t)(index - W) * DIN + Z_AK; const u32x2 a0 = *(const u32x2*)zk, a1 = *(const u32x2*)(zk + 64);
                k[0] = bflo(a0.x); k[1] = bfhi(a0.x); k[2] = bflo(a0.y); k[3] = bfhi(a0.y); k[4] = bflo(a1.x); k[5] = bfhi(a1.x); k[6] = bflo(a1.y); k[7] = bfhi(a1.y); }
#pragma unroll
            for (int e = 0; e < 8; ++e) s += q[e] * k[e];
        }
        s += __shfl_xor(s, 1); s += __shfl_xor(s, 2); s += __shfl_xor(s, 4); s += __shfl_xor(s, 8);
        if (c16 == 0 && u <= 128) sc[u] = s - slope_d * (float)(128 - u);
    }
    asm volatile("s_waitcnt lgkmcnt(0)" ::: "memory");
    __syncthreads();
    float s0 = sc[lane], s1 = sc[lane + 64], s2 = (lane == 0) ? sc[128] : -INFINITY;
    float mx = fmaxf(fmaxf(s0, s1), s2);
#pragma unroll
    for (int o = 1; o < 64; o <<= 1) mx = fmaxf(mx, __shfl_xor(mx, o));
    s0 = __expf(s0 - mx); s1 = __expf(s1 - mx); s2 = __expf(s2 - mx);
    const float den = wave_sum(s0 + s1 + s2), inv = 1.0f / den;
    __syncthreads();
    sc[lane] = s0 * inv; sc[lane + 64] = s1 * inv; if (lane == 0) sc[128] = s2 * inv;
    if (lane >= 1 && lane < 4) sc[128 + lane] = 0.f;
    asm volatile("s_waitcnt lgkmcnt(0)" ::: "memory");
    __syncthreads();
    float o[8];
#pragma unroll
    for (int e = 0; e < 8; ++e) o[e] = 0.f;
    const float* vp0 = cvb + (size_t)(i + rr * dil) * 512;
#pragma unroll 1
    for (int bt = 0; bt < 2; ++bt) {
        f32x4 v0[15], v1[15];
#pragma unroll
        for (int t = 0; t < 15; ++t) { const float* p = vp0 + (size_t)(bt * 15 + t) * rstride; v0[t] = __builtin_nontemporal_load((const f32x4*)p); v1[t] = __builtin_nontemporal_load((const f32x4*)(p + 64)); }
#pragma unroll
        for (int t = 0; t < 15; ++t) { const float p = sc[4 * (bt * 15 + t) + rr];
#pragma unroll
            for (int e = 0; e < 4; ++e) { o[e] += p * v0[t][e]; o[4 + e] += p * v1[t][e]; } }
    }
#pragma unroll
    for (int it = 30; it < 33; ++it) {
        const int u = 4 * it + rr;
        if (u <= 128) {
            const int index = i + u * dil; const float p = sc[u];
            float v[8];
            if (index < W) { const f32x4 a0 = *(const f32x4*)(cvb + (size_t)index * 512), a1 = *(const f32x4*)(cvb + (size_t)index * 512 + 64);
                v[0] = a0[0]; v[1] = a0[1]; v[2] = a0[2]; v[3] = a0[3]; v[4] = a1[0]; v[5] = a1[1]; v[6] = a1[2]; v[7] = a1[3]; }
            else { const bf16_t* zv = znew + (size_t)(index - W) * DIN + Z_AV; const u32x2 a0 = *(const u32x2*)zv, a1 = *(const u32x2*)(zv + 64);
                v[0] = bflo(a0.x); v[1] = bfhi(a0.x); v[2] = bflo(a0.y); v[3] = bfhi(a0.y); v[4] = bflo(a1.x); v[5] = bfhi(a1.x); v[6] = bflo(a1.y); v[7] = bfhi(a1.y); }
#pragma unroll
            for (int e = 0; e < 8; ++e) o[e] += p * v[e];
        }
    }
#pragma unroll
    for (int e = 0; e < 8; ++e) { o[e] += __shfl_xor(o[e], 16); o[e] += __shfl_xor(o[e], 32); }
    if (rr == 0) {
        bf16_t* op = og + ((size_t)g * MT + zrow) * 512 + j * 128 + 4 * c16;
        u32x2 w0, w1; w0.x = pk2(o[0], o[1]); w0.y = pk2(o[2], o[3]); w1.x = pk2(o[4], o[5]); w1.y = pk2(o[6], o[7]);
        *(u32x2*)op = w0; *(u32x2*)(op + 64) = w1;
    }
    if (lane == 0) lse[((size_t)g * MT + zrow) * 4 + j] = mx + __logf(den);
    __syncthreads();
}

__device__ __forceinline__ void win_copy(const Args& a, const bf16_t* __restrict__ z, int l, int tid) {
    const int lane = tid & 63, gw = blockIdx.x * 8 + (tid >> 6), NGW = gridDim.x * 8;
    for (int idx = gw; idx < 12288; idx += NGW) {
        const int kv = idx / 6144; int rem = idx % 6144;
        size_t zrow; int g; float* dst;
        if (rem < 5376) {
            int W, bw;
            if (rem < 256) { g = 0; W = 128; bw = rem; } else if (rem < 1280) { g = 1; W = 512; bw = rem - 256; } else { g = 2; W = 2048; bw = rem - 1280; }
            const int b = bw / W, w = bw % W;
            zrow = (size_t)b * SEQ + (SEQ - W) + w;
            const size_t ooff = (g == 0) ? (kv ? O_PWV0 : O_PWK0) : (g == 1) ? (kv ? O_PWV1 : O_PWK1) : (kv ? O_PWV2 : O_PWK2);
            dst = a.out + ooff + (((size_t)l * 2 + b) * W + w) * 512;
        } else {
            rem -= 5376; g = rem >> 8; const int b = (rem & 255) >> 3, i = rem & 7, W = 128 << (2 * g);
            zrow = (size_t)MP + b * 8 + i;
            const size_t ooff = (g == 0) ? (kv ? O_SWV0 : O_SWK0) : (g == 1) ? (kv ? O_SWV1 : O_SWK1) : (kv ? O_SWV2 : O_SWK2);
            dst = a.out + ooff + (((size_t)l * 32 + b) * W + (W - 8) + i) * 512;
        }
        const u32x4 w4 = *(const u32x4*)(z + zrow * DIN + (kv ? Z_AV : Z_AK) + g * 512 + 8 * lane);
        *(f32x4*)(dst + 8 * lane) = (f32x4){bflo(w4.x), bfhi(w4.x), bflo(w4.y), bfhi(w4.y)};
        *(f32x4*)(dst + 8 * lane + 4) = (f32x4){bflo(w4.z), bfhi(w4.z), bflo(w4.w), bfhi(w4.w)};
    }
}

__device__ __forceinline__ void p3_scan_combine(const Args& a, int l, int tid) {
    const bf16_t* U = (const bf16_t*)(a.ws + WS_U); bf16_t* Rp = (bf16_t*)(a.ws + WS_RP);
    const int gt = blockIdx.x * 512 + tid, GT = gridDim.x * 512;
    for (int e = gt; e < 131072; e += GT) {
        const int vd = e & 32767, bh0 = e >> 15, bh1 = bh0 + 4, h = bh0 & 3;
        const float cd = __expf(ret_lg(h) * 128.0f);
        float R0 = 0.f, R1 = 0.f;
        const bf16_t* up0 = U + (size_t)bh0 * 64 * 32768 + vd; bf16_t* rp0 = Rp + (size_t)bh0 * 64 * 32768 + vd;
        const bf16_t* up1 = U + (size_t)bh1 * 64 * 32768 + vd; bf16_t* rp1 = Rp + (size_t)bh1 * 64 * 32768 + vd;
#pragma unroll 1
        for (int c0 = 0; c0 < 64; c0 += 16) {
            float u0[16], u1[16];
#pragma unroll
            for (int k = 0; k < 16; ++k) { u0[k] = __uint_as_float((unsigned)up0[(size_t)(c0 + k) * 32768] << 16); u1[k] = __uint_as_float((unsigned)up1[(size_t)(c0 + k) * 32768] << 16); }
#pragma unroll
            for (int k = 0; k < 16; ++k) { rp0[(size_t)(c0 + k) * 32768] = (bf16_t)f2bf(R0); R0 = cd * R0 + u0[k]; rp1[(size_t)(c0 + k) * 32768] = (bf16_t)f2bf(R1); R1 = cd * R1 + u1[k]; }
        }
        const int v = vd >> 7, d = vd & 127;
        a.out[O_PRET + ((size_t)l * 8 + bh0) * 32768 + d * 256 + v] = R0;
        a.out[O_PRET + ((size_t)l * 8 + bh1) * 32768 + d * 256 + v] = R1;
    }
    const bf16_t* og = (const bf16_t*)(a.ws + WS_OG); const float* lse = (const float*)(a.ws + WS_LSE); bf16_t* oatt = (bf16_t*)(a.ws + WS_OATT);
    const int lane = tid & 63, gw = blockIdx.x * 8 + (tid >> 6), NGW = gridDim.x * 8;
    for (int row0 = gw; row0 < MT; row0 += 2 * NGW) {
        const int j = lane >> 4;
        u32x4 q[2][3]; float ls[2][3];
#pragma unroll
        for (int rr = 0; rr < 2; ++rr) { const int row = (row0 + rr * NGW < MT) ? row0 + rr * NGW : row0;
#pragma unroll
            for (int g = 0; g < 3; ++g) { ls[rr][g] = lse[((size_t)g * MT + row) * 4 + j]; q[rr][g] = *(const u32x4*)(og + ((size_t)g * MT + row) * 512 + 8 * lane); } }
#pragma unroll
        for (int rr = 0; rr < 2; ++rr) {
            const int row = row0 + rr * NGW; if (row >= MT) break;
            const float mx = fmaxf(ls[rr][0], fmaxf(ls[rr][1], ls[rr][2]));
            float w0 = __expf(ls[rr][0] - mx), w1 = __expf(ls[rr][1] - mx), w2 = __expf(ls[rr][2] - mx);
            const float inv = 1.0f / (w0 + w1 + w2); w0 *= inv; w1 *= inv; w2 *= inv;
            const u32x4 q0 = q[rr][0], q1 = q[rr][1], q2 = q[rr][2];
            const f32x4 a0 = {bflo(q0.x), bfhi(q0.x), bflo(q0.y), bfhi(q0.y)}, a1 = {bflo(q0.z), bfhi(q0.z), bflo(q0.w), bfhi(q0.w)};
            const f32x4 b0 = {bflo(q1.x), bfhi(q1.x), bflo(q1.y), bfhi(q1.y)}, b1 = {bflo(q1.z), bfhi(q1.z), bflo(q1.w), bfhi(q1.w)};
            const f32x4 c0_ = {bflo(q2.x), bfhi(q2.x), bflo(q2.y), bfhi(q2.y)}, c1_ = {bflo(q2.z), bfhi(q2.z), bflo(q2.w), bfhi(q2.w)};
            const f32x4 r0 = a0 * w0 + b0 * w1 + c0_ * w2, r1 = a1 * w0 + b1 * w1 + c1_ * w2;
            u32x4 w; w.x = pk2(r0[0], r0[1]); w.y = pk2(r0[2], r0[3]); w.z = pk2(r1[0], r1[1]); w.w = pk2(r1[2], r1[3]);
            *(u32x4*)(oatt + (size_t)row * 512 + 8 * lane) = w;
        }
    }
}

constexpr int RO_VOFF = 128 * KVS, RO_ROFF = RO_VOFF + 128 * RVS;
__device__ __forceinline__ void ret_out_item(LAS unsigned char* lds, const bf16_t* __restrict__ z, const bf16_t* __restrict__ Rp, bf16_t* __restrict__ oret, int item, int tid) {
    const int wid = __builtin_amdgcn_readfirstlane(tid >> 6), lane = tid & 63, fr = lane & 15, quad = lane >> 4;
    const int c = item & 63, bh = item >> 6, h = bh & 3, b = bh >> 2;
    const float lg = ret_lg(h);
    const size_t zrow0 = (size_t)b * SEQ + 128 * c;
    const bf16_t* z0 = z + zrow0 * DIN;
    const bf16_t* R0 = Rp + (size_t)item * 32768;
#pragma unroll
    for (int it = 0; it < 4; ++it) {
        const int idx = tid + it * 512, jj = idx >> 4, ch = idx & 15;
        *(LAS u32x4*)(lds + jj * KVS + ch * 16) = *(const u32x4*)(z0 + (size_t)jj * DIN + Z_RK + h * 128 + ch * 8);
        *(LAS u32x4*)(lds + RO_ROFF + jj * KVS + ch * 16) = *(const u32x4*)(R0 + (size_t)jj * 128 + ch * 8);
    }
#pragma unroll
    for (int it = 0; it < 8; ++it) {
        const int idx = tid + it * 512, jj = idx >> 5, ch = idx & 31;
        *(LAS u32x4*)(lds + RO_VOFF + jj * RVS + ch * 16) = *(const u32x4*)(z0 + (size_t)jj * DIN + Z_RV + h * 256 + ch * 8);
    }
    const int iq = 16 * wid + fr;
    bf16x8 qf[4];
#pragma unroll
    for (int ks = 0; ks < 4; ++ks) qf[ks] = *(const bf16x8*)(z0 + (size_t)iq * DIN + Z_RQ + h * 128 + ks * 32 + quad * 8);
    __syncthreads();
    f32x4 o[16];
#pragma unroll
    for (int vt = 0; vt < 16; ++vt) o[vt] = (f32x4){0.f, 0.f, 0.f, 0.f};
#pragma unroll
    for (int vt = 0; vt < 8; ++vt)
#pragma unroll
        for (int ks = 0; ks < 4; ++ks) { const bf16x8 ra = *(LAS const bf16x8*)(lds + RO_ROFF + (16 * vt + fr) * KVS + ks * 64 + quad * 16); o[vt] = MFMA16(ra, qf[ks], o[vt]); }
    __syncthreads();
#pragma unroll
    for (int it = 0; it < 4; ++it) {
        const int idx = tid + it * 512, jj = idx >> 4, ch = idx & 15;
        *(LAS u32x4*)(lds + RO_ROFF + jj * KVS + ch * 16) = *(const u32x4*)(R0 + (size_t)(128 + jj) * 128 + ch * 8);
    }
    __syncthreads();
#pragma unroll
    for (int vt = 0; vt < 8; ++vt)
#pragma unroll
        for (int ks = 0; ks < 4; ++ks) { const bf16x8 ra = *(LAS const bf16x8*)(lds + RO_ROFF + (16 * vt + fr) * KVS + ks * 64 + quad * 16); o[8 + vt] = MFMA16(ra, qf[ks], o[8 + vt]); }
    const float xi = __expf(lg * (float)(iq + 1));
#pragma unroll
    for (int vt = 0; vt < 16; ++vt) o[vt] = o[vt] * xi;
#pragma unroll
    for (int kp = 0; kp < 4; ++kp) {
        if (2 * kp <= wid) {
            const bool hasB = (2 * kp + 1 <= wid);
            const int TA = 2 * kp, TB = hasB ? TA + 1 : TA;
            f32x4 sa = {0.f, 0.f, 0.f, 0.f}, sb = {0.f, 0.f, 0.f, 0.f};
#pragma unroll
            for (int ks = 0; ks < 4; ++ks) {
                const bf16x8 ka = *(LAS const bf16x8*)(lds + (16 * TA + fr) * KVS + ks * 64 + quad * 16); sa = MFMA16(ka, qf[ks], sa);
                const bf16x8 kb = *(LAS const bf16x8*)(lds + (16 * TB + fr) * KVS + ks * 64 + quad * 16); sb = MFMA16(kb, qf[ks], sb);
            }
#pragma unroll
            for (int e = 0; e < 4; ++e) {
                const int da = iq - (16 * TA + 4 * quad + e), db = iq - (16 * TB + 4 * quad + e);
                sa[e] = (da >= 0) ? sa[e] * __expf(lg * (float)da) : 0.f;
                sb[e] = (hasB && db >= 0) ? sb[e] * __expf(lg * (float)db) : 0.f;
            }
            u32x4 pw; pw.x = pk2(sa[0], sa[1]); pw.y = pk2(sa[2], sa[3]); pw.z = pk2(sb[0], sb[1]); pw.w = pk2(sb[2], sb[3]);
            const bf16x8 p8 = __builtin_bit_cast(bf16x8, pw);
            LAS const unsigned char* bA = lds + RO_VOFF + (16 * TA + 4 * quad + (fr >> 2)) * RVS + (fr & 3) * 8;
            LAS const unsigned char* bB = lds + RO_VOFF + (16 * TB + 4 * quad + (fr >> 2)) * RVS + (fr & 3) * 8;
#pragma unroll
            for (int vt = 0; vt < 16; ++vt) { const v4i16_t va = tr4(bA + vt * 32), vb = tr4(bB + vt * 32); o[vt] = MFMA16(cat8(va, vb), p8, o[vt]); }
        }
    }
    float s = 0.f;
#pragma unroll
    for (int vt = 0; vt < 16; ++vt) s += (o[vt][0] + o[vt][1]) + (o[vt][2] + o[vt][3]);
    s += __shfl_xor(s, 16); s += __shfl_xor(s, 32);
    const float mu = s * (1.0f / 256.0f); float qv = 0.f;
#pragma unroll
    for (int vt = 0; vt < 16; ++vt) { o[vt] = o[vt] - mu; qv += (o[vt][0] * o[vt][0] + o[vt][1] * o[vt][1]) + (o[vt][2] * o[vt][2] + o[vt][3] * o[vt][3]); }
    qv += __shfl_xor(qv, 16); qv += __shfl_xor(qv, 32);
    const float rstd = 1.0f / sqrtf(qv * (1.0f / 256.0f) + 1e-6f);
    const bf16_t* rgp = z0 + (size_t)iq * DIN + Z_RG + h * 256 + 4 * quad;
    bf16_t* op = oret + (zrow0 + iq) * DM + h * 256 + 4 * quad;
#pragma unroll
    for (int vt = 0; vt < 16; ++vt) {
        const u32x2 gw = *(const u32x2*)(rgp + 16 * vt);
        const float g0 = bflo(gw.x), g1 = bfhi(gw.x), g2 = bflo(gw.y), g3 = bfhi(gw.y);
        const float x0 = o[vt][0] * rstd * g0 / (1.0f + __expf(-g0)), x1 = o[vt][1] * rstd * g1 / (1.0f + __expf(-g1)), x2 = o[vt][2] * rstd * g2 / (1.0f + __expf(-g2)), x3 = o[vt][3] * rstd * g3 / (1.0f + __expf(-g3));
        u32x2 w; w.x = pk2(x0, x1); w.y = pk2(x2, x3);
        *(u32x2*)(op + 16 * vt) = w;
    }
    __syncthreads();
}

#define XB_TMO      128
#define XB_XCNT(j)  (256  + 64 * (j))
#define XB_XSUB(j)  (1280 + 64 * (j))
#define XB_XGEN(j)  (2304 + 64 * (j))
#define XB_TOP      3328
#define XB_TOPGEN   3392
#define XCD_BAR_WORDS 3456
#define XB_SPIN_CAP (1u << 18)

__device__ __forceinline__ unsigned xb_ld(unsigned* p)              { return __hip_atomic_load(p, __ATOMIC_RELAXED, __HIP_MEMORY_SCOPE_AGENT); }
__device__ __forceinline__ unsigned xb_add(unsigned* p, unsigned v) { return __hip_atomic_fetch_add(p, v, __ATOMIC_RELAXED, __HIP_MEMORY_SCOPE_AGENT); }
__device__ __forceinline__ unsigned xb_xcc_id() { return (unsigned)__builtin_amdgcn_s_getreg((3 << 11) | 20) & 0xFu; }
#define XB_SPIN(cond, bar) do { unsigned _sp = 0; while (cond) { __builtin_amdgcn_s_sleep(1); \
    if ((++_sp & 255u) == 0u) { if (xb_ld(&(bar)[XB_TMO])) break; if (_sp > XB_SPIN_CAP) { atomicAdd(&(bar)[XB_TMO], 1u); break; } } } } while (0)

struct XcdBarrier {
    unsigned* bar; unsigned x;
    volatile LAS unsigned* st;
};

__device__ __forceinline__ XcdBarrier xcd_barrier_post(unsigned* bar, volatile LAS unsigned* st) {
    XcdBarrier b; b.bar = bar; b.x = xb_xcc_id(); b.st = st;
    if (threadIdx.x == 0) (void)xb_add(&bar[XB_XCNT(b.x)], 1u);
    return b;
}
__device__ __forceinline__ void xcd_barrier_complete(unsigned* bar, unsigned x, unsigned& nloc, unsigned& nx) {
    const unsigned G = gridDim.x * gridDim.y * gridDim.z;
    unsigned sum, cnt, mine, sp = 0u;
    for (;;) {
        sum = 0u; cnt = 0u; mine = 0u;
#pragma unroll
        for (unsigned j = 0; j < 16; ++j) { const unsigned c = xb_ld(&bar[XB_XCNT(j)]); sum += c; cnt += (c > 0u) ? 1u : 0u; mine = (j == x) ? c : mine; }
        if (sum == G) break;
        __builtin_amdgcn_s_sleep(1);
        if ((++sp & 255u) == 0u) { if (xb_ld(&bar[XB_TMO])) break; if (sp > XB_SPIN_CAP) { atomicAdd(&bar[XB_TMO], 1u); break; } }
    }
    nloc = mine > 0u ? mine : 1u; nx = cnt > 0u ? cnt : 1u;
}

__device__ __forceinline__ void xcd_barrier(const XcdBarrier& b) {
    asm volatile("s_waitcnt vmcnt(0)" ::: "memory");
    __syncthreads();
    if (threadIdx.x == 0) {
        unsigned* bar = b.bar;
        __builtin_amdgcn_s_waitcnt(0);
        unsigned nloc = b.st[0], nx = b.st[1];
        if (nloc == 0u) { xcd_barrier_complete(bar, b.x, nloc, nx); b.st[0] = nloc; b.st[1] = nx; }
        const unsigned old = xb_add(&bar[XB_XSUB(b.x)], 1u);
        const unsigned gen = old / nloc;
        if (old + 1u == (gen + 1u) * nloc) {
            __builtin_amdgcn_fence(__ATOMIC_RELEASE, "agent");
            asm volatile("s_waitcnt vmcnt(0)" ::: "memory");
            const unsigned og = xb_add(&bar[XB_TOP], 1u);
            const unsigned tg = og / nx;
            if (og + 1u == (tg + 1u) * nx) xb_add(&bar[XB_TOPGEN], 1u);
            else XB_SPIN(xb_ld(&bar[XB_TOPGEN]) == tg, bar);
            __builtin_amdgcn_fence(__ATOMIC_ACQUIRE, "agent");
            xb_add(&bar[XB_XGEN(b.x)], 1u);
            asm volatile("s_waitcnt vmcnt(0)" ::: "memory");
        } else {
            XB_SPIN(xb_ld(&bar[XB_XGEN(b.x)]) == gen, bar);
            __builtin_amdgcn_fence(__ATOMIC_ACQUIRE, "agent");
            asm volatile("s_waitcnt vmcnt(0)" ::: "memory");
        }
    }
    __syncthreads();
}

template <int MODE>
__device__ __forceinline__ void skinny_phase(LAS unsigned char* lds, const bf16_t* __restrict__ A, const bf16_t* __restrict__ Wt, int K, const pg8::Epi<MODE>& E, int tid_in) {
    int tid = tid_in; asm volatile("" : "+v"(tid));
    const int wid = __builtin_amdgcn_readfirstlane(tid >> 6), lane = tid & 63, fr = lane & 15, quad = lane >> 4;
    LAS f32x4* red = (LAS f32x4*)lds;
    LAS float* ssq_l = (LAS float*)(lds + 32768);
#pragma unroll 1
    for (int slab = blockIdx.x; slab < 256; slab += gridDim.x) {
        const int rt = slab & 15, cs = slab >> 4;
        const bf16_t* arow = A + (size_t)(MP + 16 * rt + fr) * K + 8 * quad;
        const bf16_t* wrow = Wt + (size_t)(64 * cs + fr) * K + 8 * quad;
        f32x4 acc[4];
#pragma unroll
        for (int ct = 0; ct < 4; ++ct) acc[ct] = (f32x4){0.f, 0.f, 0.f, 0.f};
        const int nks = K >> 5;
#pragma unroll 4
        for (int ks = wid; ks < nks; ks += 8) {
            const bf16x8 b = *(const bf16x8*)(arow + 32 * ks);
#pragma unroll
            for (int ct = 0; ct < 4; ++ct) { const bf16x8 w = *(const bf16x8*)(wrow + (size_t)(16 * ct) * K + 32 * ks); acc[ct] = MFMA16(w, b, acc[ct]); }
        }
#pragma unroll
        for (int ct = 0; ct < 4; ++ct) red[(wid * 4 + ct) * 64 + lane] = acc[ct];
        __syncthreads();
        if (wid < 4) {
            f32x4 s = red[wid * 64 + lane];
#pragma unroll
            for (int w = 1; w < 8; ++w) s = s + red[(w * 4 + wid) * 64 + lane];
            float ssq = E.elem(MP + 16 * rt + fr, 64 * cs + 16 * wid + 4 * quad, s);
            if constexpr (MODE == pg8::E_RES || MODE == pg8::E_GATE) { ssq += __shfl_xor(ssq, 16); ssq += __shfl_xor(ssq, 32); if (quad == 0) ssq_l[wid * 16 + fr] = ssq; }
        }
        __syncthreads();
        if constexpr (MODE == pg8::E_RES || MODE == pg8::E_GATE) { if (tid < 16) E.ssp_out[(size_t)(MP + 16 * rt + tid) * 16 + cs] = (ssq_l[tid] + ssq_l[16 + tid]) + (ssq_l[32 + tid] + ssq_l[48 + tid]); }
        __syncthreads();
    }
}

#define GEMM_PHASE(MODE, Aptr, Bptr, Mm, Nn, Kk, EPI) do { int kk_ = (Kk); asm volatile("" : "+s"(kk_)); pg8::Gemm g_{(const pg8::bf16_t*)(Aptr), (const pg8::bf16_t*)(Bptr), (Mm), (Nn), kk_}; pg8::StaticOrder S_; S_.init((Mm), (Nn), (int)gridDim.x, (int)blockIdx.x); \
    pg8::gemm_phase<pg8::Epi<MODE>, pg8::StaticOrder, true, true>((PG8_LAS unsigned char*)lds, g_, S_, (EPI)); } while (0)

__global__ void __launch_bounds__(512, 2) mega_fwd(Args a) {
    extern __shared__ __attribute__((aligned(16))) unsigned char lds_raw[];
    LAS unsigned char* lds = (LAS unsigned char*)lds_raw;
    cg::grid_group grid = cg::this_grid();
    int tid = threadIdx.x;
#define OPQ() asm volatile("" : "+v"(tid))
    unsigned char* ws = a.ws;
    float* ssp = (float*)(ws + WS_SSP); bf16_t* tbuf = (bf16_t*)(ws + WS_T);
    bf16_t* z = (bf16_t*)(ws + WS_Z); bf16_t* ubuf = (bf16_t*)(ws + WS_Z);
    bf16_t* oret = (bf16_t*)(ws + WS_ORET); bf16_t* oatt = (bf16_t*)(ws + WS_OATT); bf16_t* merged = (bf16_t*)(ws + WS_MERGED);
    bf16_t* og = (bf16_t*)(ws + WS_OG); float* lse = (float*)(ws + WS_LSE); bf16_t* U = (bf16_t*)(ws + WS_U); bf16_t* Rp = (bf16_t*)(ws + WS_RP);

#ifndef PHMASK
#define PHMASK 0xFFFFF
#endif
#define PH(n) if constexpr ((PHMASK >> (n)) & 1)
    unsigned* barw = (unsigned*)(ws + WS_CTL);
    volatile LAS unsigned* MISC = (volatile LAS unsigned*)(lds + LDS_BYTES - 64);
    if (tid < 2) MISC[tid] = 0u;
    if (blockIdx.x == 0) for (int i = tid; i < XCD_BAR_WORDS; i += 512) __hip_atomic_store(barw + i, 0u, __ATOMIC_RELAXED, __HIP_MEMORY_SCOPE_AGENT);
    PH(0) p0_prologue(a, lds, tid);
    grid.sync();
    const XcdBarrier xbar = xcd_barrier_post(barw, MISC);
#define GSYNC() xcd_barrier(xbar)

#pragma unroll 1
    for (int l = 0; l < 2; ++l) {
        unsigned char* wl = ws + WS_WT + (size_t)l * WT_LAYER;
        bf16_t* xb_cur = (bf16_t*)(ws + (l == 0 ? WS_XBA : WS_XBB));
        bf16_t* xb_nxt = (bf16_t*)(ws + (l == 0 ? WS_XBB : WS_XBA));
#ifndef REP_G
#define REP_G 1
#endif
#pragma unroll 1
        for (int rg_ = 0; rg_ < REP_G; ++rg_) {
        PH(1) { pg8::Epi<pg8::E_Z> E{z, DIN, nullptr, nullptr, ssp, nullptr, nullptr, nullptr}; GEMM_PHASE(pg8::E_Z, xb_cur, wl + WT_IN, MT, DIN, DM, E); }
        if (rg_ + 1 < REP_G) GSYNC();
        }
        cache_copy_tail(a, 2470, l * 500 + 0, l * 500 + 50, tid);
        GSYNC();
#ifndef REP_MIX
#define REP_MIX 1
#endif
#pragma unroll 1
        for (int rep_ = 0; rep_ < REP_MIX; ++rep_) {
#pragma unroll 1
        for (int stage_ = 0; stage_ < 2; ++stage_) {
        const bool sample_now = ((stage_ == 0) == ((blockIdx.x & 1) != 0));
        if (!sample_now) {
        OPQ();
        PH(2) { const int per_ = (1536 + (int)gridDim.x - 1) / (int)gridDim.x; for (int i_ = 0; i_ < per_; ++i_) { const int it = (int)blockIdx.x * per_ + i_; if (it < 1536) attn_prompt_item(lds, z, og, lse, it, tid); } }
        OPQ();
        PH(3) for (int it = blockIdx.x; it < 512; it += gridDim.x) ret_u_item(lds, z, U, it, tid);
        } else {
        OPQ();
        PH(4) for (int it = blockIdx.x; it < 384; it += gridDim.x) {
            const int g = (it >> 2) % 3;
            attn_sample_item(lds, z, a.in[2 + 2 * g], a.in[3 + 2 * g], l, og, lse, it, tid);
        }
        OPQ();
        PH(5) for (int it = (blockIdx.x + gridDim.x / 2) % gridDim.x; it < 128; it += gridDim.x) ret_sample_item(lds, z, a.in[8] + (size_t)l * 128 * 32768, a.out + O_SRET + (size_t)l * 128 * 32768, oret, it, tid);
        }
        }
        OPQ();
        PH(6) win_copy(a, z, l, tid);
        GSYNC();
        OPQ();
        if (blockIdx.x & 1) cache_copy_tail(a, 0, l * 500 + 190, l * 500 + 310, tid);
        PH(7) p3_scan_combine(a, l, tid);
        if (!(blockIdx.x & 1)) cache_copy_tail(a, 0, l * 500 + 190, l * 500 + 310, tid);
        GSYNC();
        OPQ();
        if (blockIdx.x & 1) cache_copy_tail(a, 0, l * 500 + 310, l * 500 + 500, tid);
        PH(8) for (int it = blockIdx.x; it < 512; it += gridDim.x) ret_out_item(lds, z, Rp, oret, it, tid);
        if (!(blockIdx.x & 1)) cache_copy_tail(a, 0, l * 500 + 310, l * 500 + 500, tid);
        GSYNC();
        }
        PH(9) { pg8::Epi<pg8::E_RET> E{nullptr, DM, nullptr, tbuf, nullptr, nullptr, z + Z_GA, nullptr}; GEMM_PHASE(pg8::E_RET, oret, wl + WT_RET, MP, DM, DM, E); skinny_phase<pg8::E_RET>(lds, oret, (const bf16_t*)(wl + WT_RET), DM, E, tid); }
        PH(10) { pg8::Epi<pg8::E_ATT> E{merged, DM, nullptr, tbuf, nullptr, nullptr, z + Z_GB, nullptr}; GEMM_PHASE(pg8::E_ATT, oatt, wl + WT_ATT, MP, DM, 512, E); skinny_phase<pg8::E_ATT>(lds, oatt, (const bf16_t*)(wl + WT_ATT), 512, E, tid); }
        GSYNC();
        PH(11) { pg8::Epi<pg8::E_RES> E{xb_cur, DM, xb_cur, nullptr, nullptr, ssp, nullptr, (l == 0) ? a.in[0] : (const float*)nullptr}; GEMM_PHASE(pg8::E_RES, merged, wl + WT_OUT, MP, DM, DM, E);
          pg8::Epi<pg8::E_RES> Es{xb_cur, DM, xb_cur, nullptr, nullptr, ssp, nullptr, (l == 0) ? a.in[1] - (size_t)MP * DM : (const float*)nullptr}; skinny_phase<pg8::E_RES>(lds, merged, (const bf16_t*)(wl + WT_OUT), DM, Es, tid); }
        GSYNC();
#pragma unroll 1
        for (int rg_ = 0; rg_ < REP_G; ++rg_) {
        PH(12) { pg8::Epi<pg8::E_UP> E{ubuf, DFF, nullptr, nullptr, ssp, nullptr, nullptr, nullptr}; GEMM_PHASE(pg8::E_UP, xb_cur, wl + WT_UP, MT, DFF, DM, E); }
        if (rg_ + 1 < REP_G) GSYNC();
        }
        cache_copy_tail(a, 1040, l * 500 + 50, l * 500 + 190, tid);
        GSYNC();
        PH(13) { pg8::Epi<pg8::E_RES> E{xb_cur, DM, xb_cur, nullptr, nullptr, ssp, nullptr, nullptr}; GEMM_PHASE(pg8::E_RES, ubuf, wl + WT_DOWN, MP, DM, DFF, E); skinny_phase<pg8::E_RES>(lds, ubuf, (const bf16_t*)(wl + WT_DOWN), DFF, E, tid); }
        GSYNC();
        PH(14) { pg8::Epi<pg8::E_PLE> E{nullptr, DM, nullptr, tbuf, nullptr, nullptr, nullptr, nullptr}; GEMM_PHASE(pg8::E_PLE, ws + WS_PB + (size_t)l * MT * DPLE * 2, wl + WT_PLE, MP, DM, DPLE, E); skinny_phase<pg8::E_PLE>(lds, (const bf16_t*)(ws + WS_PB + (size_t)l * MT * DPLE * 2), (const bf16_t*)(wl + WT_PLE), DPLE, E, tid); }
        PH(15) { pg8::Epi<pg8::E_GATE> E{xb_nxt, DM, xb_cur, tbuf, nullptr, ssp, nullptr, nullptr}; GEMM_PHASE(pg8::E_GATE, xb_cur, wl + WT_GATE, MP, DM, DM, E); skinny_phase<pg8::E_GATE>(lds, xb_cur, (const bf16_t*)(wl + WT_GATE), DM, E, tid); }
        GSYNC();
    }
    {
        const int lane = tid & 63, gw = blockIdx.x * 8 + (tid >> 6), NGW = gridDim.x * 8;
        const float* nf = a.in[21];
        for (int m = gw; m < MT; m += NGW) {
            float sv = (lane < 16) ? ssp[(size_t)m * 16 + lane] : 0.f;
            sv = wave_sum(sv);
            const float rstd = 1.0f / sqrtf(sv * (1.0f / 1024.0f) + 1e-6f);
#pragma unroll
            for (int j = 0; j < 4; ++j) { const u32x2 xw_ = *(const u32x2*)((const bf16_t*)(ws + WS_XBA) + (size_t)m * DM + 4 * lane + 256 * j); const f32x4 v = {bflo(xw_.x), bfhi(xw_.x), bflo(xw_.y), bfhi(xw_.y)}; const f32x4 gn = *(const f32x4*)(nf + 4 * lane + 256 * j); *(f32x4*)(a.out + O_Y + (size_t)m * DM + 4 * lane + 256 * j) = v * rstd * gn; }
        }
    }
}

extern "C" void kernel_launch(void* const* d_in, const int* in_sizes, int n_in, void* d_out, int out_size, void* d_ws, size_t ws_size, hipStream_t stream) {
    static int grid = 0;
    if (grid == 0) {
        if (n_in != 22 || (size_t)out_size != O_END || ws_size < WS_END) { fprintf(stderr, "kernel_launch: unexpected shapes: n_in %d out %d (want %zu) ws %zu (need %zu)\n", n_in, out_size, (size_t)O_END, ws_size, (size_t)WS_END); grid = -1; return; }
        int dev = 0, cus = 0, per_cu = 0;
        if (hipGetDevice(&dev) != hipSuccess || hipDeviceGetAttribute(&cus, hipDeviceAttributeMultiprocessorCount, dev) != hipSuccess) { grid = -1; return; }
        if (hipFuncSetAttribute((const void*)mega_fwd, hipFuncAttributeMaxDynamicSharedMemorySize, LDS_BYTES) != hipSuccess) { fprintf(stderr, "kernel_launch: hipFuncSetAttribute failed\n"); grid = -1; return; }
        if (hipOccupancyMaxActiveBlocksPerMultiprocessor(&per_cu, (const void*)mega_fwd, 512, LDS_BYTES) != hipSuccess || per_cu < 1) { fprintf(stderr, "kernel_launch: occupancy query says %d\n", per_cu); per_cu = 1; }
        (void)hipGetLastError();
        grid = cus * 1;
    }
    if (grid < 0) return;
    Args a{};
    for (int i = 0; i < 22; ++i) a.in[i] = (const float*)d_in[i];
    a.out = (float*)d_out; a.ws = (unsigned char*)d_ws;
    void* args[] = {&a};
    hipError_t e = hipLaunchCooperativeKernel((const void*)mega_fwd, dim3(grid), dim3(512), args, LDS_BYTES, stream);
    if (e != hipSuccess) fprintf(stderr, "cooperative launch failed: %s (grid %d)\n", hipGetErrorString(e), grid);
}
```

```cpp
#include <hip/hip_runtime.h>
#include <hip/hip_cooperative_groups.h>
#include <cstdio>
#include <cstdint>
#include <cmath>
namespace cg = cooperative_groups;
namespace pg8 {
#define PG8_LAS __attribute__((address_space(3)))
typedef unsigned short bf16_t;
typedef short bf16x8 __attribute__((ext_vector_type(8)));
typedef float f32x4 __attribute__((ext_vector_type(4)));
typedef unsigned u32x4 __attribute__((ext_vector_type(4)));
constexpr int BM = 256, BK = 64, HALF = 128, HTB = HALF * BK * 2  , STAGE_BYTES = 8 * HTB, NXCD = 8, WGM = 8;

__host__ __device__ __forceinline__ int lds_byte(int r, int c) { const int st = (r >> 4) * 2 + (c >> 5), rr = r & 15, cc = c & 31, ob = rr * 64 + cc * 2; return st * 1024 + (ob ^ (((ob >> 9) & 1) << 5)); }
__host__ __device__ __forceinline__ void stage_rc(int b, int& R, int& C) { const int st = b / 1024, sb = b % 1024, swz = sb ^ (((sb >> 9) & 1) << 5); R = (st >> 1) * 16 + swz / 64; C = (st & 1) * 32 + (swz % 64) / 2; }
__host__ __device__ __forceinline__ int perm32(int rho) { const int n = rho >> 4, i = rho & 15; return 8 * (i >> 2) + 4 * n + (i & 3); }

struct Unit { int pm, pn; };
struct Gemm { const bf16_t* A; const bf16_t* Bt; int M, N, K; };

struct StaticOrder {
    int nM, nN, nwg, G, c;
    __host__ __device__ void init(int M, int N, int G_, int c_) { nM = M / BM; nN = N / BM; nwg = nM * nN; G = G_; c = c_; }
    __host__ __device__ bool next(int i, Unit& u) const {
        const long L = (long)i * G + c; if (L >= nwg) return false;
        int wgid = (int)L; { const int q = nwg / NXCD, r = nwg % NXCD, xcd = wgid % NXCD, off = wgid / NXCD; wgid = (xcd < r ? xcd * (q + 1) : r * (q + 1) + (xcd - r) * q) + off; }
        const int nig = WGM * nN, gid = wgid / nig, fm = gid * WGM, gsz = (nM - fm) < WGM ? (nM - fm) : WGM;
        u.pm = fm + ((wgid % nig) % gsz); u.pn = (wgid % nig) / gsz; return true;
    }
    __device__ __forceinline__ void a_ready(const Unit&) const {}
    __device__ __forceinline__ void done(const Unit&) const {}
};

__device__ __forceinline__ unsigned cvt_pk_bf16(float lo, float hi) { unsigned r; asm("v_cvt_pk_bf16_f32 %0, %1, %2" : "=v"(r) : "v"(lo), "v"(hi)); return r; }

typedef unsigned u32x2 __attribute__((ext_vector_type(2)));
__device__ __forceinline__ float bf2f(unsigned h) { return __uint_as_float(h << 16); }
__device__ __forceinline__ float sigmoidf_(float x) { return 1.0f / (1.0f + __expf(-x)); }
__device__ __forceinline__ f32x4 bf4_to_f32(u32x2 w) { f32x4 r; r[0] = bf2f(w.x & 0xffffu); r[1] = bf2f(w.x >> 16); r[2] = bf2f(w.y & 0xffffu); r[3] = bf2f(w.y >> 16); return r; }
__device__ __forceinline__ u32x2 f32_to_bf4(f32x4 v) { u32x2 w; w.x = cvt_pk_bf16(v[0], v[1]); w.y = cvt_pk_bf16(v[2], v[3]); return w; }
enum { E_Z = 0, E_UP = 1, E_RET = 2, E_ATT = 3, E_RES = 4, E_PLE = 5, E_GATE = 6 };
template <int MODE> struct Epi {
    static constexpr bool PERM = (MODE == E_Z || MODE == E_UP), AFTER_DRAIN = false;
    bf16_t* ob; int ldob; const bf16_t* xrb; bf16_t* t; const float* ssp_in; float* ssp_out; const bf16_t* gate; const float* xr;
    __device__ __forceinline__ float elem(int row, int col, const f32x4 a) const {
        const size_t off = (size_t)row * 1024 + col; float ssq = 0.f;
        if constexpr (MODE == E_RET || MODE == E_ATT) {
            const u32x2 gw = *(const u32x2*)(gate + (size_t)row * 9728 + col);
            f32x4 gv; gv[0] = sigmoidf_(bf2f(gw.x & 0xffffu)); gv[1] = sigmoidf_(bf2f(gw.x >> 16)); gv[2] = sigmoidf_(bf2f(gw.y & 0xffffu)); gv[3] = sigmoidf_(bf2f(gw.y >> 16));
            if constexpr (MODE == E_RET) { *(u32x2*)(t + off) = f32_to_bf4(gv * a); }
            else { const f32x4 tv = bf4_to_f32(*(const u32x2*)(t + off)); const f32x4 o = tv + gv * a; u32x2 w; w.x = cvt_pk_bf16(o[0], o[1]); w.y = cvt_pk_bf16(o[2], o[3]); *(u32x2*)(ob + off) = w; }
        } else if constexpr (MODE == E_PLE) {
            *(u32x2*)(t + off) = f32_to_bf4(a);
        } else if constexpr (MODE == E_RES || MODE == E_GATE) {
            f32x4 x = xr ? *(const f32x4*)(xr + off) : bf4_to_f32(*(const u32x2*)(xrb + off));
            if constexpr (MODE == E_GATE) { const f32x4 tv = bf4_to_f32(*(const u32x2*)(t + off)); f32x4 sg; sg[0] = sigmoidf_(a[0]); sg[1] = sigmoidf_(a[1]); sg[2] = sigmoidf_(a[2]); sg[3] = sigmoidf_(a[3]); x = x + tv * sg; }
            else x = x + a;
            u32x2 w; w.x = cvt_pk_bf16(x[0], x[1]); w.y = cvt_pk_bf16(x[2], x[3]); *(u32x2*)(ob + off) = w;
            ssq = (x[0] * x[0] + x[1] * x[1]) + (x[2] * x[2] + x[3] * x[3]);
        }
        return ssq;
    }
    __device__ __forceinline__ void operator()(const f32x4 (&acc)[2][2][4][2], const Unit& u, int wr, int wc, int fr, int fq) const {
        const int row0 = u.pm * BM + wr * 64 + fr;
        if constexpr (PERM) {
            const int col0 = u.pn * BM + wc * 32 + 8 * fq;
            f32x4 sp[2][4];
#pragma unroll
            for (int ai = 0; ai < 2; ++ai)
#pragma unroll
                for (int m = 0; m < 4; ++m) sp[ai][m] = *(const f32x4*)(ssp_in + (size_t)(row0 + ai * HALF + m * 16) * 16 + 4 * fq);
#pragma unroll
            for (int ai = 0; ai < 2; ++ai)
#pragma unroll
                for (int m = 0; m < 4; ++m) {
                    const int row = row0 + ai * HALF + m * 16;
                    float ss = (sp[ai][m][0] + sp[ai][m][1]) + (sp[ai][m][2] + sp[ai][m][3]);
                    ss += __shfl_xor(ss, 16); ss += __shfl_xor(ss, 32);
                    const float rstd = 1.0f / sqrtf(ss * (1.0f / 1024.0f) + 1e-6f);
                    bf16_t* rowp = ob + (size_t)row * ldob + col0;
#pragma unroll
                    for (int bj = 0; bj < 2; ++bj) {
                        f32x4 v0 = acc[ai][bj][m][0] * rstd, v1 = acc[ai][bj][m][1] * rstd;
                        if constexpr (MODE == E_UP) {
#pragma unroll
                            for (int e = 0; e < 4; ++e) { float a = fmaxf(v0[e], 0.f), b = fmaxf(v1[e], 0.f); v0[e] = a * a; v1[e] = b * b; }
                        }
                        u32x4 w; w.x = cvt_pk_bf16(v0[0], v0[1]); w.y = cvt_pk_bf16(v0[2], v0[3]); w.z = cvt_pk_bf16(v1[0], v1[1]); w.w = cvt_pk_bf16(v1[2], v1[3]);
                        *(u32x4*)(rowp + bj * HALF) = w;
                    }
                }
        } else {
            const int col0 = u.pn * BM + wc * 32 + 4 * fq;
            constexpr int MB = (MODE == E_GATE) ? 1 : 2;
#pragma unroll
            for (int aim = 0; aim < 8 / MB; ++aim) {
                const int ai = aim / (4 / MB), m0 = (aim % (4 / MB)) * MB;
                f32x4 xv[4][2][2]; u32x2 xw[4][2][2]; u32x2 tv[4][2][2]; u32x2 gw[4][2][2];
#pragma unroll
                for (int m = m0; m < m0 + MB; ++m)
#pragma unroll
                    for (int bj = 0; bj < 2; ++bj)
#pragma unroll
                        for (int n = 0; n < 2; ++n) {
                            const int row = row0 + ai * HALF + m * 16, col = col0 + bj * HALF + n * 16; const size_t off = (size_t)row * 1024 + col;
                            if constexpr (MODE == E_RES || MODE == E_GATE) { if (xr) xv[m][bj][n] = *(const f32x4*)(xr + off); else xw[m][bj][n] = *(const u32x2*)(xrb + off); }
                            if constexpr (MODE == E_ATT || MODE == E_GATE) tv[m][bj][n] = *(const u32x2*)(t + off);
                            if constexpr (MODE == E_RET || MODE == E_ATT) gw[m][bj][n] = *(const u32x2*)(gate + (size_t)row * 9728 + col);
                        }
#pragma unroll
                for (int m = m0; m < m0 + MB; ++m) {
                    const int row = row0 + ai * HALF + m * 16;
                    float ssq = 0.f;
#pragma unroll
                    for (int bj = 0; bj < 2; ++bj)
#pragma unroll
                        for (int n = 0; n < 2; ++n) {
                            const int col = col0 + bj * HALF + n * 16; const size_t off = (size_t)row * 1024 + col;
                            const f32x4 a = acc[ai][bj][m][n];
                            if constexpr (MODE == E_RET || MODE == E_ATT) {
                                const u32x2 g2 = gw[m][bj][n];
                                f32x4 gv; gv[0] = sigmoidf_(bf2f(g2.x & 0xffffu)); gv[1] = sigmoidf_(bf2f(g2.x >> 16)); gv[2] = sigmoidf_(bf2f(g2.y & 0xffffu)); gv[3] = sigmoidf_(bf2f(g2.y >> 16));
                                if constexpr (MODE == E_RET) { *(u32x2*)(t + off) = f32_to_bf4(gv * a); }
                                else { const f32x4 o = bf4_to_f32(tv[m][bj][n]) + gv * a; u32x2 w; w.x = cvt_pk_bf16(o[0], o[1]); w.y = cvt_pk_bf16(o[2], o[3]); *(u32x2*)(ob + off) = w; }
                            } else if constexpr (MODE == E_PLE) {
                                *(u32x2*)(t + off) = f32_to_bf4(a);
                            } else {
                                f32x4 x = xr ? xv[m][bj][n] : bf4_to_f32(xw[m][bj][n]);
                                if constexpr (MODE == E_GATE) { f32x4 sg; sg[0] = sigmoidf_(a[0]); sg[1] = sigmoidf_(a[1]); sg[2] = sigmoidf_(a[2]); sg[3] = sigmoidf_(a[3]); x = x + bf4_to_f32(tv[m][bj][n]) * sg; }
                                else x = x + a;
                                u32x2 w; w.x = cvt_pk_bf16(x[0], x[1]); w.y = cvt_pk_bf16(x[2], x[3]); *(u32x2*)(ob + off) = w;
                                ssq += (x[0] * x[0] + x[1] * x[1]) + (x[2] * x[2] + x[3] * x[3]);
                            }
                        }
                    if constexpr (MODE == E_RES || MODE == E_GATE) {
                        ssq += __shfl_xor(ssq, 16); ssq += __shfl_xor(ssq, 32);
                        if (fq == 0) ssp_out[(size_t)row * 16 + u.pn * 4 + wc] = ssq;
                    }
                }
            }
        }
    }
};
template <class Epi, class Sched, bool ALIGN_EPI = false, bool SP2 = false>
__device__ __forceinline__ void gemm_phase(PG8_LAS unsigned char* lds, const Gemm g, const Sched& S, const Epi& E) {
    int tid_ = threadIdx.x; asm volatile("" : "+v"(tid_));
    const int tid = tid_, wid = __builtin_amdgcn_readfirstlane(tid >> 6), lane = tid & 63, wr = wid >> 2, wc = wid & 3, fr = lane & 15, fq = lane >> 4;
    const int K = g.K, nt = K / BK;
    unsigned voffA[2], voffB[2];
#pragma unroll
    for (int i = 0; i < 2; ++i) { int R, C; stage_rc(tid * 16 + i * 8192, R, C); const int Rb = Epi::PERM ? ((R & ~31) + perm32(R & 31)) : R;
        voffA[i] = (unsigned)(R * K + C) * 2u; voffB[i] = (unsigned)(Rb * K + C) * 2u; }
    const size_t kstep = (size_t)(BK * 2);
    const size_t hstep = (size_t)HALF * K * 2;
    const size_t tstep = 2 * hstep;
    const unsigned ldsw = (unsigned)wid * 1024u;
    const int aoff = lds_byte(wr * 64 + fr, fq * 8), boff = lds_byte(wc * 32 + fr, fq * 8);
#define PG8_SA(b, h) (((b) * 2 + (h)) * HTB)
#define PG8_SB(b, h) ((4 + (b) * 2 + (h)) * HTB)
#define PG8_STAGE(bufoff, gbase, voff) do { _Pragma("unroll") for (int _i = 0; _i < 2; ++_i) \
        __builtin_amdgcn_global_load_lds((const unsigned*)((const char*)(gbase) + (voff)[_i]), (PG8_LAS unsigned*)(lds + (bufoff) + ldsw + _i * 8192), 16, 0, 0); } while (0)
#define PG8_LDA(dst, b, h) do { _Pragma("unroll") for (int m = 0; m < 4; ++m) _Pragma("unroll") for (int k = 0; k < 2; ++k) dst[m][k] = *(const PG8_LAS bf16x8*)(lds + PG8_SA(b, h) + aoff + m * 2048 + k * 1024); } while (0)
#define PG8_LDB(dst, b, h) do { _Pragma("unroll") for (int n = 0; n < 2; ++n) _Pragma("unroll") for (int k = 0; k < 2; ++k) dst[n][k] = *(const PG8_LAS bf16x8*)(lds + PG8_SB(b, h) + boff + n * 2048 + k * 1024); } while (0)
#define PG8_MMA(ai, bj, At, Bt) do { __builtin_amdgcn_s_setprio(1); _Pragma("unroll") for (int m = 0; m < 4; ++m) _Pragma("unroll") for (int n = 0; n < 2; ++n) _Pragma("unroll") for (int k = 0; k < 2; ++k) \
        acc[ai][bj][m][n] = __builtin_amdgcn_mfma_f32_16x16x32_bf16(Bt[n][k], At[m][k], acc[ai][bj][m][n], 0, 0, 0); __builtin_amdgcn_s_setprio(0); } while (0)
#define PG8_WAIT_V(n) asm volatile("s_waitcnt vmcnt(" #n ")" ::: "memory")
#define PG8_WAIT_L(n) asm volatile("s_waitcnt lgkmcnt(" #n ")" ::: "memory")
#define PG8_BAR __builtin_amdgcn_s_barrier()
#define PG8_SCHED __builtin_amdgcn_sched_barrier(0)
    Unit cur, nxt; int ui = 0;
    if (!S.next(0, cur)) return;
    f32x4 acc[2][2][4][2];
#pragma unroll
    for (int a = 0; a < 2; ++a)
#pragma unroll
        for (int b = 0; b < 2; ++b)
#pragma unroll
            for (int m = 0; m < 4; ++m)
#pragma unroll
                for (int n = 0; n < 2; ++n) acc[a][b][m][n] = (f32x4){0.f, 0.f, 0.f, 0.f};
    bf16x8 At[4][2], B0[2][2], B1[2][2];
    const char* cA = (const char*)g.A + (size_t)cur.pm * tstep; const char* cB = (const char*)g.Bt + (size_t)cur.pn * tstep;
    S.a_ready(cur);
    if constexpr (SP2) {
        PG8_STAGE(PG8_SB(0, 0), cB, voffB); PG8_STAGE(PG8_SB(0, 1), cB + hstep, voffB); PG8_STAGE(PG8_SA(0, 0), cA, voffA); PG8_STAGE(PG8_SA(0, 1), cA + hstep, voffA);
        if (wr == 1) PG8_BAR;
        PG8_WAIT_V(2); PG8_BAR;
        PG8_STAGE(PG8_SB(1, 0), cB + kstep, voffB); PG8_STAGE(PG8_SA(1, 0), cA + kstep, voffA); PG8_STAGE(PG8_SB(1, 1), cB + hstep + kstep, voffB);
        PG8_WAIT_V(6); PG8_BAR;
    } else {
        PG8_STAGE(PG8_SB(0, 0), cB, voffB); PG8_STAGE(PG8_SA(0, 0), cA, voffA); PG8_STAGE(PG8_SB(0, 1), cB + hstep, voffB); PG8_STAGE(PG8_SA(0, 1), cA + hstep, voffA);
        if (wr == 1) PG8_BAR;
        PG8_WAIT_V(4); PG8_BAR;
        PG8_STAGE(PG8_SB(1, 0), cB + kstep, voffB); PG8_STAGE(PG8_SA(1, 0), cA + kstep, voffA); PG8_STAGE(PG8_SB(1, 1), cB + hstep + kstep, voffB);
        PG8_WAIT_V(6); PG8_BAR;
    }
    for (;;) {
        const bool has_next = S.next(ui + 1, nxt);
        const char* nA = has_next ? (const char*)g.A + (size_t)nxt.pm * tstep : cA; const char* nB = has_next ? (const char*)g.Bt + (size_t)nxt.pn * tstep : cB;
        for (int t = 0; t < nt; t += 2) {
            const bool last = (t == nt - 2);
            const char* a1 = cA + (size_t)(t + 1) * kstep;
            const char* a2 = last ? nA : cA + (size_t)(t + 2) * kstep; const char* b2 = last ? nB : cB + (size_t)(t + 2) * kstep;
            const char* a3 = a2 + kstep; const char* b3 = b2 + kstep;
            if (last && has_next) S.a_ready(nxt);
            if constexpr (SP2) {
            PG8_LDB(B0, 0, 0); PG8_LDB(B1, 0, 1); PG8_SCHED; PG8_LDA(At, 0, 0); PG8_STAGE(PG8_SA(1, 1), a1 + hstep, voffA);
            PG8_WAIT_V(8); PG8_WAIT_L(0); PG8_BAR; PG8_MMA(0, 0, At, B0); PG8_MMA(0, 1, At, B1); PG8_BAR; PG8_SCHED;
            PG8_LDA(At, 0, 1); PG8_STAGE(PG8_SB(0, 0), b2, voffB); PG8_STAGE(PG8_SB(0, 1), b2 + hstep, voffB); PG8_STAGE(PG8_SA(0, 0), a2, voffA);
            PG8_WAIT_V(8); PG8_WAIT_L(0); PG8_BAR; PG8_MMA(1, 0, At, B0); PG8_MMA(1, 1, At, B1); PG8_BAR; PG8_SCHED;
            PG8_LDB(B0, 1, 0); PG8_LDB(B1, 1, 1); PG8_SCHED; PG8_LDA(At, 1, 0); PG8_STAGE(PG8_SA(0, 1), a2 + hstep, voffA);
            PG8_WAIT_V(8); PG8_WAIT_L(0); PG8_BAR; PG8_MMA(0, 0, At, B0); PG8_MMA(0, 1, At, B1); PG8_BAR; PG8_SCHED;
            PG8_LDA(At, 1, 1); PG8_STAGE(PG8_SB(1, 0), b3, voffB); PG8_STAGE(PG8_SB(1, 1), b3 + hstep, voffB); PG8_STAGE(PG8_SA(1, 0), a3, voffA);
            PG8_WAIT_V(8); PG8_WAIT_L(0); PG8_BAR; PG8_MMA(1, 0, At, B0); PG8_MMA(1, 1, At, B1); PG8_BAR; PG8_SCHED;
            } else {
            PG8_LDB(B0, 0, 0); PG8_SCHED; PG8_LDA(At, 0, 0); PG8_STAGE(PG8_SA(1, 1), a1 + hstep, voffA);
            PG8_WAIT_L(8); PG8_BAR; PG8_WAIT_L(0); PG8_MMA(0, 0, At, B0); PG8_BAR; PG8_SCHED;
            PG8_LDB(B1, 0, 1); PG8_STAGE(PG8_SB(0, 0), b2, voffB);
            PG8_BAR; PG8_WAIT_L(0); PG8_MMA(0, 1, At, B1); PG8_BAR;
            PG8_LDA(At, 0, 1); PG8_STAGE(PG8_SA(0, 0), a2, voffA);
            PG8_BAR; PG8_WAIT_L(0); PG8_MMA(1, 0, At, B0); PG8_BAR; PG8_SCHED;
            PG8_STAGE(PG8_SB(0, 1), b2 + hstep, voffB);
            PG8_WAIT_V(6); PG8_BAR; PG8_MMA(1, 1, At, B1); PG8_BAR;
            PG8_LDB(B0, 1, 0); PG8_SCHED; PG8_LDA(At, 1, 0); PG8_STAGE(PG8_SA(0, 1), a2 + hstep, voffA);
            PG8_WAIT_L(8); PG8_BAR; PG8_WAIT_L(0); PG8_MMA(0, 0, At, B0); PG8_BAR; PG8_SCHED;
            PG8_LDB(B1, 1, 1); PG8_STAGE(PG8_SB(1, 0), b3, voffB);
            PG8_BAR; PG8_WAIT_L(0); PG8_MMA(0, 1, At, B1); PG8_BAR;
            PG8_LDA(At, 1, 1); PG8_STAGE(PG8_SA(1, 0), a3, voffA);
            PG8_BAR; PG8_WAIT_L(0); PG8_MMA(1, 0, At, B0); PG8_BAR; PG8_SCHED;
            PG8_STAGE(PG8_SB(1, 1), b3 + hstep, voffB);
            PG8_WAIT_V(6); PG8_BAR; PG8_MMA(1, 1, At, B1); PG8_BAR;
            }
        }
        if constexpr (ALIGN_EPI) { if (wr == 0) PG8_BAR; }
        if constexpr (!Epi::AFTER_DRAIN) { E(acc, cur, wr, wc, fr, fq); S.done(cur); }
        if (!has_next) break;
#pragma unroll
        for (int a = 0; a < 2; ++a)
#pragma unroll
            for (int b = 0; b < 2; ++b)
#pragma unroll
                for (int m = 0; m < 4; ++m)
#pragma unroll
                    for (int n = 0; n < 2; ++n) acc[a][b][m][n] = (f32x4){0.f, 0.f, 0.f, 0.f};
        cur = nxt; cA = nA; cB = nB; ++ui;
        if constexpr (ALIGN_EPI) { if (wr == 1) PG8_BAR; }
    }
    PG8_WAIT_V(0);
    if constexpr (!ALIGN_EPI) { if (wr == 0) PG8_BAR; }
    PG8_BAR;
    if constexpr (Epi::AFTER_DRAIN) { E.fused(acc, cur, wr, wc, fr, fq, lds, wid, lane); S.done(cur); }
#undef PG8_SA
#undef PG8_SB
#undef PG8_STAGE
#undef PG8_LDA
#undef PG8_LDB
#undef PG8_MMA
#undef PG8_WAIT_V
#undef PG8_WAIT_L
#undef PG8_BAR
#undef PG8_SCHED
}
}

#define LAS __attribute__((address_space(3)))
typedef unsigned short bf16_t;
typedef short bf16x8 __attribute__((ext_vector_type(8)));
typedef short v4i16_t __attribute__((ext_vector_type(4)));
typedef float f32x4 __attribute__((ext_vector_type(4)));
typedef float f32x2 __attribute__((ext_vector_type(2)));
typedef unsigned u32x4 __attribute__((ext_vector_type(4)));
typedef unsigned u32x2 __attribute__((ext_vector_type(2)));

constexpr int MP = 16384, MS = 256, MT = MP + MS;
constexpr int DM = 1024, DIN = 9728, DFF = 4096, DPLE = 256, SEQ = 8192;
constexpr int Z_RQ = 0, Z_RK = 512, Z_RV = 1024, Z_RG = 2048, Z_AQ = 3072, Z_AK = 4608, Z_AV = 6144, Z_GA = 7680, Z_GB = 8704;
constexpr int LDS_BYTES = 147456;
constexpr float QK_SCALE = 0.08838834764831845f;

constexpr size_t WT_IN = 0, WT_RET = WT_IN + (size_t)DIN * DM * 2, WT_ATT = WT_RET + (size_t)DM * DM * 2, WT_OUT = WT_ATT + (size_t)DM * 512 * 2,
                 WT_UP = WT_OUT + (size_t)DM * DM * 2, WT_DOWN = WT_UP + (size_t)DFF * DM * 2, WT_PLE = WT_DOWN + (size_t)DFF * DM * 2,
                 WT_GATE = WT_PLE + (size_t)DM * DPLE * 2, WT_LAYER = WT_GATE + (size_t)DM * DM * 2;
constexpr size_t WS_WT = 0;
constexpr size_t WS_XF = WS_WT + 2 * WT_LAYER;
constexpr size_t WS_XBA = WS_XF + (size_t)MT * DM * 4;
constexpr size_t WS_XBB = WS_XBA + (size_t)MT * DM * 2;
constexpr size_t WS_SSP = WS_XBB + (size_t)MT * DM * 2;
constexpr size_t WS_PB = WS_SSP + (size_t)MT * 16 * 4;
constexpr size_t WS_Z = WS_PB + (size_t)2 * MT * DPLE * 2;
constexpr size_t WS_ORET = WS_Z + (size_t)MT * DIN * 2;
constexpr size_t WS_OATT = WS_ORET + (size_t)MT * DM * 2;
constexpr size_t WS_MERGED = WS_OATT + (size_t)MT * 512 * 2;
constexpr size_t WS_T = WS_MERGED + (size_t)MT * DM * 2;
constexpr size_t WS_OG = WS_T + (size_t)MT * DM * 4;
constexpr size_t WS_LSE = WS_OG + (size_t)3 * MT * 512 * 4;
constexpr size_t WS_U = WS_LSE + (size_t)3 * MT * 4 * 4;
constexpr size_t WS_RP = WS_U + (size_t)512 * 32768 * 4;
constexpr size_t WS_CTL = WS_RP + (size_t)512 * 32768 * 2;
constexpr size_t WS_END = WS_CTL + 16384;

constexpr size_t O_Y = 0;
constexpr size_t O_PWK0 = (size_t)MT * DM, O_PWV0 = O_PWK0 + 262144, O_PWK1 = O_PWV0 + 262144, O_PWV1 = O_PWK1 + 1048576, O_PWK2 = O_PWV1 + 1048576, O_PWV2 = O_PWK2 + 4194304;
constexpr size_t O_PRET = O_PWV2 + 4194304;
constexpr size_t O_SWK0 = O_PRET + 524288, O_SWV0 = O_SWK0 + 4194304, O_SWK1 = O_SWV0 + 4194304, O_SWV1 = O_SWK1 + 16777216, O_SWK2 = O_SWV1 + 16777216, O_SWV2 = O_SWK2 + 67108864;
constexpr size_t O_SRET = O_SWV2 + 67108864;
constexpr size_t O_END = O_SRET + 8388608;

struct Args { const float* in[22]; float* out; unsigned char* ws; };

__device__ __forceinline__ unsigned f2bf(float f) { unsigned u = __builtin_bit_cast(unsigned, f); return (u + 0x7fffu + ((u >> 16) & 1u)) >> 16; }
__device__ __forceinline__ unsigned pk2(float lo, float hi) { return f2bf(lo) | (f2bf(hi) << 16); }
__device__ __forceinline__ float bflo(unsigned w) { return __uint_as_float(w << 16); }
__device__ __forceinline__ float bfhi(unsigned w) { return __uint_as_float(w & 0xffff0000u); }
__device__ __forceinline__ float wave_sum(float v) {
#pragma unroll
    for (int o = 1; o < 64; o <<= 1) v += __shfl_xor(v, o);
    return v;
}
__device__ __forceinline__ float ret_lg(int h) { const float A = -3.4657359028f, B = -6.2383246250f; return log1pf(-expf(A + (B - A) * (float)h * (1.0f / 3.0f))); }
__device__ __forceinline__ v4i16_t tr4(LAS const unsigned char* p) { return __builtin_amdgcn_ds_read_tr16_b64_v4i16((LAS v4i16_t*)p); }
__device__ __forceinline__ bf16x8 cat8(v4i16_t a, v4i16_t b) { return __builtin_shufflevector(a, b, 0, 1, 2, 3, 4, 5, 6, 7); }
#define MFMA16(a, b, c) __builtin_amdgcn_mfma_f32_16x16x32_bf16((a), (b), (c), 0, 0, 0)

__device__ __forceinline__ void p0_transpose_item(const float* __restrict__ W, int K, int N, bf16_t* __restrict__ WT, const float* __restrict__ gain, bool is_in, LAS float* scr, int item, int lane) {
    const int nblk = N / 64, kb = item / nblk, nb = item % nblk, k0 = 64 * kb, n0 = 64 * nb;
    const int kr = lane >> 4, nc = 4 * (lane & 15);
#pragma unroll 8
    for (int i = 0; i < 16; ++i) { const int kk = 4 * i + kr; f32x4 v = *(const f32x4*)(W + (size_t)(k0 + kk) * N + n0 + nc); if (gain) v = v * gain[k0 + kk];
        LAS float* d = scr + kk * 65 + nc; d[0] = v[0]; d[1] = v[1]; d[2] = v[2]; d[3] = v[3]; }
    asm volatile("s_waitcnt lgkmcnt(0)" ::: "memory");
    const int c = lane & 7;
#pragma unroll
    for (int j = 0; j < 8; ++j) { const int n = (lane >> 3) + 8 * j; const LAS float* s = scr + (8 * c) * 65 + n; const int ng = n0 + n;
        const float sc = (is_in && ((ng >= Z_RK && ng < Z_RV) || (ng >= Z_AQ && ng < Z_AK))) ? QK_SCALE : 1.0f;
        u32x4 o; o.x = pk2(s[0 * 65] * sc, s[1 * 65] * sc); o.y = pk2(s[2 * 65] * sc, s[3 * 65] * sc); o.z = pk2(s[4 * 65] * sc, s[5 * 65] * sc); o.w = pk2(s[6 * 65] * sc, s[7 * 65] * sc);
        *(u32x4*)(WT + (size_t)ng * K + k0 + 8 * c) = o; }
    asm volatile("s_waitcnt lgkmcnt(0)" ::: "memory");
}

__device__ __forceinline__ void p0_prologue(const Args& a, LAS unsigned char* lds, int tid) {
    const int lane = tid & 63, wave = tid >> 6;
    const int gw = blockIdx.x * 8 + wave, NGW = gridDim.x * 8;
    LAS float* scr = (LAS float*)(lds + wave * 16640);
    constexpr int I_IN = 16 * 152, I_RET = 16 * 16, I_ATT = 8 * 16, I_OUT = 16 * 16, I_UP = 16 * 64, I_DOWN = 64 * 16, I_PLE = 4 * 16, I_GATE = 16 * 16;
    constexpr int I_LAYER = I_IN + I_RET + I_ATT + I_OUT + I_UP + I_DOWN + I_PLE + I_GATE;
    for (int it = gw; it < 2 * I_LAYER; it += NGW) {
        const int l = it / I_LAYER; int r = it % I_LAYER;
        unsigned char* wl = a.ws + WS_WT + (size_t)l * WT_LAYER;
        if (r < I_IN) { p0_transpose_item(a.in[12] + (size_t)l * DM * DIN, DM, DIN, (bf16_t*)(wl + WT_IN), a.in[11] + l * DM, true, scr, r, lane); continue; } r -= I_IN;
        if (r < I_RET) { p0_transpose_item(a.in[13] + (size_t)l * DM * DM, DM, DM, (bf16_t*)(wl + WT_RET), nullptr, false, scr, r, lane); continue; } r -= I_RET;
        if (r < I_ATT) { p0_transpose_item(a.in[14] + (size_t)l * 512 * DM, 512, DM, (bf16_t*)(wl + WT_ATT), nullptr, false, scr, r, lane); continue; } r -= I_ATT;
        if (r < I_OUT) { p0_transpose_item(a.in[15] + (size_t)l * DM * DM, DM, DM, (bf16_t*)(wl + WT_OUT), nullptr, false, scr, r, lane); continue; } r -= I_OUT;
        if (r < I_UP) { p0_transpose_item(a.in[17] + (size_t)l * DM * DFF, DM, DFF, (bf16_t*)(wl + WT_UP), a.in[16] + l * DM, false, scr, r, lane); continue; } r -= I_UP;
        if (r < I_DOWN) { p0_transpose_item(a.in[18] + (size_t)l * DFF * DM, DFF, DM, (bf16_t*)(wl + WT_DOWN), nullptr, false, scr, r, lane); continue; } r -= I_DOWN;
        if (r < I_PLE) { p0_transpose_item(a.in[19] + (size_t)l * DPLE * DM, DPLE, DM, (bf16_t*)(wl + WT_PLE), nullptr, false, scr, r, lane); continue; } r -= I_PLE;
        p0_transpose_item(a.in[20] + (size_t)l * DM * DM, DM, DM, (bf16_t*)(wl + WT_GATE), nullptr, false, scr, r, lane);
    }
    bf16_t* xb = (bf16_t*)(a.ws + WS_XBA); float* ssp = (float*)(a.ws + WS_SSP);
    for (int m = gw; m < MT; m += NGW) {
        const float* src = (m < MP) ? a.in[0] + (size_t)m * DM : a.in[1] + (size_t)(m - MP) * DM;
        f32x4 v[4]; float s = 0.f;
#pragma unroll
        for (int j = 0; j < 4; ++j) { v[j] = *(const f32x4*)(src + 4 * lane + 256 * j); s += (v[j][0] * v[j][0] + v[j][1] * v[j][1]) + (v[j][2] * v[j][2] + v[j][3] * v[j][3]); }
        s = wave_sum(s);
#pragma unroll
        for (int j = 0; j < 4; ++j) { u32x2 w; w.x = pk2(v[j][0], v[j][1]); w.y = pk2(v[j][2], v[j][3]); *(u32x2*)(xb + (size_t)m * DM + 4 * lane + 256 * j) = w; }
        if (lane < 16) ssp[(size_t)m * 16 + lane] = (lane == 0) ? s : 0.f;
    }
    bf16_t* pb = (bf16_t*)(a.ws + WS_PB);
    for (int q = gw; q < 2 * MT; q += NGW) {
        const int l = q / MT, m = q % MT;
        const float* src = (m < MP) ? a.in[9] + ((size_t)l * MP + m) * DPLE : a.in[10] + ((size_t)l * MS + (m - MP)) * DPLE;
        const f32x4 v = *(const f32x4*)(src + 4 * lane);
        u32x2 w; w.x = pk2(v[0], v[1]); w.y = pk2(v[2], v[3]); *(u32x2*)(pb + (size_t)q * DPLE + 4 * lane) = w;
    }
}

constexpr size_t CC_TOTAL = 2 * 64 * 128 * (size_t)(120 + 504 + 2040);
__device__ __forceinline__ void cache_copy_range(const Args& a, size_t q0, size_t q1, int tid) {
    size_t base = 0;
#pragma unroll 1
    for (int kvg = 0; kvg < 6; ++kvg) {
        const int g = kvg >> 1, W = 128 << (2 * g);
        const size_t per = (size_t)(W - 8) * 128, n = 64 * per, full = (size_t)W * 128;
        const size_t lo = q0 > base ? q0 : base, hi = q1 < base + n ? q1 : base + n;
        if (lo < hi) {
            const f32x4* src = (const f32x4*)a.in[2 + kvg];
            const size_t ooff = (kvg == 0) ? O_SWK0 : (kvg == 1) ? O_SWV0 : (kvg == 2) ? O_SWK1 : (kvg == 3) ? O_SWV1 : (kvg == 4) ? O_SWK2 : O_SWV2;
            f32x4* dst = (f32x4*)(a.out + ooff);
            size_t p = lo - base; const size_t pe = hi - base;
#pragma unroll 1
            while (p < pe) {
                const size_t lb = p / per, rem = p - lb * per;
                const size_t c0 = per - rem, c1 = pe - p, cnt = c0 < c1 ? c0 : c1;
                const f32x4* s = src + lb * full + 1024 + rem; f32x4* d = dst + lb * full + rem;
#pragma unroll 1
                for (size_t i = tid; i < cnt; i += 512 * 16) {
                    f32x4 v[16];
#pragma unroll
                    for (int k = 0; k < 16; ++k) if (i + k * 512 < cnt) v[k] = __builtin_nontemporal_load(s + i + k * 512);
#pragma unroll
                    for (int k = 0; k < 16; ++k) if (i + k * 512 < cnt) __builtin_nontemporal_store(v[k], d + i + k * 512);
                }
                p += cnt;
            }
        }
        base += n;
    }
}
__device__ __forceinline__ void cache_copy_tail(const Args& a, int nwg, int f0, int f1, int tid) {
    const int G = gridDim.x, fi = nwg % G, c = blockIdx.x;
    if (c < fi) return;
    const size_t R0 = CC_TOTAL * (size_t)f0 / 1000, R1 = CC_TOTAL * (size_t)f1 / 1000, nidle = (size_t)(G - fi), idx = (size_t)(c - fi);
    cache_copy_range(a, R0 + (R1 - R0) * idx / nidle, R0 + (R1 - R0) * (idx + 1) / nidle, tid);
}

constexpr int KVS = 272;
constexpr int AT_VOFF = 256 * KVS;
__device__ __forceinline__ void attn_prompt_item(LAS unsigned char* lds, const bf16_t* __restrict__ z, bf16_t* __restrict__ og, float* __restrict__ lse, int item, int tid) {
    const int wid = __builtin_amdgcn_readfirstlane(tid >> 6), lane = tid & 63, fr = lane & 15, quad = lane >> 4;
    const int blk = item & 63; int rest = item >> 6; const int j = rest & 3; rest >>= 2; const int g = rest % 3, b = rest / 3;
    const int dsh = 2 * g, dil = 1 << dsh, r = blk >> (6 - dsh), qb = blk & ((64 >> dsh) - 1), hh = g * 4 + j;
    const float slope_d = exp2f(-8.0f * (float)(hh + 1) / 12.0f) * (float)dil;
    const bf16_t* zb = z + (size_t)b * SEQ * DIN;
#pragma unroll
    for (int it = 0; it < 8; ++it) {
        const int idx = tid + it * 512, kk = idx >> 4, ch = idx & 15, sp = 128 * qb - 128 + kk;
        u32x4 kv = {0u, 0u, 0u, 0u}, vv = {0u, 0u, 0u, 0u};
        if (sp >= 0) { const bf16_t* zr = zb + (size_t)(sp * dil + r) * DIN + hh * 128 + ch * 8; kv = *(const u32x4*)(zr + Z_AK); vv = *(const u32x4*)(zr + Z_AV); }
        *(LAS u32x4*)(lds + kk * KVS + ch * 16) = kv; *(LAS u32x4*)(lds + AT_VOFF + kk * KVS + ch * 16) = vv;
    }
    const int sq = 128 * qb + 16 * wid + fr;
    const size_t qrow = (size_t)b * SEQ + (size_t)(sq * dil + r);
    bf16x8 qf[4];
#pragma unroll
    for (int ks = 0; ks < 4; ++ks) qf[ks] = *(const bf16x8*)(z + qrow * DIN + Z_AQ + hh * 128 + ks * 32 + quad * 8);
    __syncthreads();
    f32x4 sc[9];
#pragma unroll
    for (int kt = 0; kt < 9; ++kt) {
        f32x4 acc = {0.f, 0.f, 0.f, 0.f};
#pragma unroll
        for (int ks = 0; ks < 4; ++ks) { const bf16x8 ka = *(LAS const bf16x8*)(lds + (16 * (wid + kt) + fr) * KVS + ks * 64 + quad * 16); acc = MFMA16(ka, qf[ks], acc); }
        sc[kt] = acc;
    }
    float mx = -INFINITY;
#pragma unroll
    for (int kt = 0; kt < 9; ++kt)
#pragma unroll
        for (int e = 0; e < 4; ++e) {
            const int dist = 128 - 16 * kt + fr - 4 * quad - e, keyrel = 16 * (wid + kt) + 4 * quad + e;
            const bool valid = (dist >= 0) && (dist <= 128) && (qb > 0 || keyrel >= 128);
            const float s = valid ? sc[kt][e] - slope_d * (float)dist : -INFINITY;
            sc[kt][e] = s; mx = fmaxf(mx, s);
        }
    mx = fmaxf(mx, __shfl_xor(mx, 16)); mx = fmaxf(mx, __shfl_xor(mx, 32));
    float den = 0.f;
#pragma unroll
    for (int kt = 0; kt < 9; ++kt)
#pragma unroll
        for (int e = 0; e < 4; ++e) { const float p = __expf(sc[kt][e] - mx); sc[kt][e] = p; den += p; }
    den += __shfl_xor(den, 16); den += __shfl_xor(den, 32);
    const float inv = 1.0f / den;
    f32x4 o[8];
#pragma unroll
    for (int dt = 0; dt < 8; ++dt) o[dt] = (f32x4){0.f, 0.f, 0.f, 0.f};
#pragma unroll
    for (int kp = 0; kp < 5; ++kp) {
        const int TA = wid + 2 * kp, TB = (2 * kp + 1 < 9) ? TA + 1 : TA;
        u32x4 pw; pw.x = pk2(sc[2 * kp][0] * inv, sc[2 * kp][1] * inv); pw.y = pk2(sc[2 * kp][2] * inv, sc[2 * kp][3] * inv);
        if (2 * kp + 1 < 9) { pw.z = pk2(sc[(2 * kp + 1) % 9][0] * inv, sc[(2 * kp + 1) % 9][1] * inv); pw.w = pk2(sc[(2 * kp + 1) % 9][2] * inv, sc[(2 * kp + 1) % 9][3] * inv); } else { pw.z = 0u; pw.w = 0u; }
        const bf16x8 p8 = __builtin_bit_cast(bf16x8, pw);
        LAS const unsigned char* bA = lds + AT_VOFF + (16 * TA + 4 * quad + (fr >> 2)) * KVS + (fr & 3) * 8;
        LAS const unsigned char* bB = lds + AT_VOFF + (16 * TB + 4 * quad + (fr >> 2)) * KVS + (fr & 3) * 8;
#pragma unroll
        for (int dt = 0; dt < 8; ++dt) { const v4i16_t va = tr4(bA + dt * 32), vb = tr4(bB + dt * 32); o[dt] = MFMA16(cat8(va, vb), p8, o[dt]); }
    }
    bf16_t* orow = og + ((size_t)g * MT + qrow) * 512 + j * 128 + 4 * quad;
#pragma unroll
    for (int dt = 0; dt < 8; ++dt) { u32x2 w; w.x = pk2(o[dt][0], o[dt][1]); w.y = pk2(o[dt][2], o[dt][3]); *(u32x2*)(orow + 16 * dt) = w; }
    if (quad == 0) lse[((size_t)g * MT + qrow) * 4 + j] = mx + __logf(den);
    __syncthreads();
}

constexpr int RVS = 528;
constexpr int RU_VOFF = 128 * KVS;
__device__ __forceinline__ void ret_u_item(LAS unsigned char* lds, const bf16_t* __restrict__ z, bf16_t* __restrict__ U, int item, int tid) {
    const int wid = __builtin_amdgcn_readfirstlane(tid >> 6), lane = tid & 63, fr = lane & 15, quad = lane >> 4;
    const int c = item & 63, bh = item >> 6, h = bh & 3, b = bh >> 2;
    const float lg = ret_lg(h);
    const bf16_t* z0 = z + ((size_t)b * SEQ + 128 * c) * DIN;
#pragma unroll
    for (int it = 0; it < 4; ++it) {
        const int idx = tid + it * 512, jj = idx >> 4, ch = idx & 15;
        const u32x4 kv = *(const u32x4*)(z0 + (size_t)jj * DIN + Z_RK + h * 128 + ch * 8);
        const float zeta = __expf(lg * (float)(127 - jj));
        u32x4 o; o.x = pk2(bflo(kv.x) * zeta, bfhi(kv.x) * zeta); o.y = pk2(bflo(kv.y) * zeta, bfhi(kv.y) * zeta); o.z = pk2(bflo(kv.z) * zeta, bfhi(kv.z) * zeta); o.w = pk2(bflo(kv.w) * zeta, bfhi(kv.w) * zeta);
        *(LAS u32x4*)(lds + jj * KVS + ch * 16) = o;
    }
#pragma unroll
    for (int it = 0; it < 8; ++it) {
        const int idx = tid + it * 512, jj = idx >> 5, ch = idx & 31;
        *(LAS u32x4*)(lds + RU_VOFF + jj * RVS + ch * 16) = *(const u32x4*)(z0 + (size_t)jj * DIN + Z_RV + h * 256 + ch * 8);
    }
    __syncthreads();
    f32x4 acc[2][8];
#pragma unroll
    for (int a = 0; a < 2; ++a)
#pragma unroll
        for (int d = 0; d < 8; ++d) acc[a][d] = (f32x4){0.f, 0.f, 0.f, 0.f};
#pragma unroll
    for (int ks = 0; ks < 4; ++ks) {
        const int jrow = 32 * ks + 8 * quad + (fr >> 2);
        bf16x8 A[2];
#pragma unroll
        for (int a = 0; a < 2; ++a) { LAS const unsigned char* p = lds + RU_VOFF + jrow * RVS + (16 * (2 * wid + a) + 4 * (fr & 3)) * 2; A[a] = cat8(tr4(p), tr4(p + 4 * RVS)); }
#pragma unroll
        for (int d = 0; d < 8; ++d) { LAS const unsigned char* p = lds + jrow * KVS + (16 * d + 4 * (fr & 3)) * 2; const bf16x8 B = cat8(tr4(p), tr4(p + 4 * KVS));
            acc[0][d] = MFMA16(B, A[0], acc[0][d]); acc[1][d] = MFMA16(B, A[1], acc[1][d]); }
    }
    bf16_t* Uo = U + (size_t)item * 32768;
#pragma unroll
    for (int a = 0; a < 2; ++a)
#pragma unroll
        for (int d = 0; d < 8; ++d) { u32x2 w; w.x = pk2(acc[a][d][0], acc[a][d][1]); w.y = pk2(acc[a][d][2], acc[a][d][3]); *(u32x2*)(Uo + (16 * (2 * wid + a) + fr) * 128 + 16 * d + 4 * quad) = w; }
    __syncthreads();
}

__device__ __forceinline__ void ret_sample_item(LAS unsigned char* lds, const bf16_t* __restrict__ z, const float* __restrict__ S0, float* __restrict__ Sout, bf16_t* __restrict__ oret, int item, int tid) {
    const int h = item & 3, b = item >> 2;
    const int lane = tid & 63, wave = tid >> 6;
    const float lg = ret_lg(h);
    LAS float* qs = (LAS float*)lds;
    LAS float* ksm = qs + 1024;
    LAS float* Pm = ksm + 1024;
    LAS float* red = Pm + 64;
    LAS float* ob = red + 4096;
    const bf16_t* z0 = z + (size_t)(MP + b * 8) * DIN;
    for (int idx = tid; idx < 1024; idx += 512) { const int i = idx >> 7, d = idx & 127; qs[idx] = __uint_as_float((unsigned)z0[(size_t)i * DIN + Z_RQ + h * 128 + d] << 16); ksm[idx] = __uint_as_float((unsigned)z0[(size_t)i * DIN + Z_RK + h * 128 + d] << 16); }
    const int v = tid & 255, half = tid >> 8;
    float vv[8], vz[8];
#pragma unroll
    for (int jj = 0; jj < 8; ++jj) { vv[jj] = __uint_as_float((unsigned)z0[(size_t)jj * DIN + Z_RV + h * 256 + v] << 16); vz[jj] = vv[jj] * __expf(lg * (float)(7 - jj)); }
    __syncthreads();
    if (tid < 64) { const int i = tid >> 3, jj = tid & 7; float s = 0.f; for (int d = 0; d < 128; ++d) s += qs[i * 128 + d] * ksm[jj * 128 + d]; Pm[tid] = (jj <= i) ? s * __expf(lg * (float)(i - jj)) : 0.f; }
    const float cd = __expf(lg * 8.0f);
    float cr[8];
#pragma unroll
    for (int i = 0; i < 8; ++i) cr[i] = 0.f;
    const float* Sp = S0 + (size_t)item * 32768 + v; float* So = Sout + (size_t)item * 32768 + v;
#pragma unroll 16
    for (int dd = 0; dd < 64; ++dd) {
        const int d = half * 64 + dd;
        const float s = Sp[(size_t)d * 256];
        float nw = cd * s;
#pragma unroll
        for (int i = 0; i < 8; ++i) { cr[i] += qs[i * 128 + d] * s; nw += ksm[i * 128 + d] * vz[i]; }
        So[(size_t)d * 256] = nw;
    }
#pragma unroll
    for (int i = 0; i < 8; ++i) red[(half * 8 + i) * 256 + v] = cr[i];
    __syncthreads();
#pragma unroll
    for (int ii = 0; ii < 4; ++ii) {
        const int i = half * 4 + ii;
        float o = (red[i * 256 + v] + red[(8 + i) * 256 + v]) * __expf(lg * (float)(i + 1));
#pragma unroll
        for (int jj = 0; jj < 8; ++jj) o += Pm[i * 8 + jj] * vv[jj];
        ob[i * 256 + v] = o;
    }
    __syncthreads();
    {
        const int i = wave; float x[4]; float s = 0.f;
#pragma unroll
        for (int e = 0; e < 4; ++e) { x[e] = ob[i * 256 + 4 * lane + e]; s += x[e]; }
        const float mu = wave_sum(s) * (1.0f / 256.0f); float q = 0.f;
#pragma unroll
        for (int e = 0; e < 4; ++e) { x[e] -= mu; q += x[e] * x[e]; }
        const float rstd = 1.0f / sqrtf(wave_sum(q) * (1.0f / 256.0f) + 1e-6f);
        const u32x2 gw = *(const u32x2*)(z0 + (size_t)i * DIN + Z_RG + h * 256 + 4 * lane);
        float gq[4] = {bflo(gw.x), bfhi(gw.x), bflo(gw.y), bfhi(gw.y)};
#pragma unroll
        for (int e = 0; e < 4; ++e) x[e] = x[e] * rstd * gq[e] / (1.0f + __expf(-gq[e]));
        u32x2 w; w.x = pk2(x[0], x[1]); w.y = pk2(x[2], x[3]);
        *(u32x2*)(oret + (size_t)(MP + b * 8 + i) * DM + h * 256 + 4 * lane) = w;
    }
    __syncthreads();
}

__device__ __forceinline__ void attn_sample_item(LAS unsigned char* lds, const bf16_t* __restrict__ z, const float* __restrict__ ck, const float* __restrict__ cv, int l, bf16_t* __restrict__ og, float* __restrict__ lse, int item, int tid) {
    const int j = item & 3; int rest = item >> 2; const int g = rest % 3, b = rest / 3;
    const int lane = tid & 63, i = tid >> 6, dsh = 2 * g, dil = 1 << dsh, W = 128 << dsh, hh = g * 4 + j;
    const float slope_d = exp2f(-8.0f * (float)(hh + 1) / 12.0f) * (float)dil;
    LAS float* sc = (LAS float*)lds + i * 136;
    const size_t zrow = (size_t)MP + b * 8 + i;
    const bf16_t* zq = z + zrow * DIN + Z_AQ + hh * 128;
    const int c16 = lane & 15, rr = lane >> 4;
    float q[8];
    { const u32x2 a0 = *(const u32x2*)(zq + 4 * c16), a1 = *(const u32x2*)(zq + 64 + 4 * c16);
      q[0] = bflo(a0.x); q[1] = bfhi(a0.x); q[2] = bflo(a0.y); q[3] = bfhi(a0.y); q[4] = bflo(a1.x); q[5] = bfhi(a1.x); q[6] = bflo(a1.y); q[7] = bfhi(a1.y); }
    const float* ckb = ck + ((size_t)(l * 32 + b) * W) * 512 + j * 128 + 4 * c16;
    const float* cvb = cv + ((size_t)(l * 32 + b) * W) * 512 + j * 128 + 4 * c16;
    const bf16_t* znew = z + (size_t)(MP + b * 8) * DIN + hh * 128 + 4 * c16;
    const size_t rstride = (size_t)dil * 512 * 4;
    const float* kp0 = ckb + (size_t)(i + rr * dil) * 512;
#pragma unroll 1
    for (int bt = 0; bt < 2; ++bt) {
        f32x4 k0[15], k1[15];
#pragma unroll
        for (int t = 0; t < 15; ++t) { const float* p = kp0 + (size_t)(bt * 15 + t) * rstride; k0[t] = __builtin_nontemporal_load((const f32x4*)p); k1[t] = __builtin_nontemporal_load((const f32x4*)(p + 64)); }
#pragma unroll
        for (int t = 0; t < 15; ++t) {
            float s = (q[0] * k0[t][0] + q[1] * k0[t][1]) + (q[2] * k0[t][2] + q[3] * k0[t][3]) + (q[4] * k1[t][0] + q[5] * k1[t][1]) + (q[6] * k1[t][2] + q[7] * k1[t][3]);
            s += __shfl_xor(s, 1); s += __shfl_xor(s, 2); s += __shfl_xor(s, 4); s += __shfl_xor(s, 8);
            const int u = 4 * (bt * 15 + t) + rr;
            if (c16 == 0) sc[u] = s - slope_d * (float)(128 - u);
        }
    }
#pragma unroll
    for (int it = 30; it < 33; ++it) {
        const int u = 4 * it + rr; float s = 0.f;
        if (u <= 128) {
            const int index = i + u * dil;
            float k[8];
            if (index < W) { const f32x4 a0 = *(const f32x4*)(ckb + (size_t)index * 512), a1 = *(const f32x4*)(ckb + (size_t)index * 512 + 64);
                k[0] = a0[0]; k[1] = a0[1]; k[2] = a0[2]; k[3] = a0[3]; k[4] = a1[0]; k[5] = a1[1]; k[6] = a1[2]; k[7] = a1[3]; }
            else { const bf16_t* zk = znew + (size_t)(index - W) * DIN + Z_AK; const u32x2 a0 = *(const u32x2*)zk, a1 = *(const u32x2*)(zk + 64);
                k[0] = bflo(a0.x); k[1] = bfhi(a0.x); k[2] = bflo(a0.y); k[3] = bfhi(a0.y); k[4] = bflo(a1.x); k[5] = bfhi(a1.x); k[6] = bflo(a1.y); k[7] = bfhi(a1.y); }
#pragma unroll
            for (int e = 0; e < 8; ++e) s += q[e] * k[e];
        }
        s += __shfl_xor(s, 1); s += __shfl_xor(s, 2); s += __shfl_xor(s, 4); s += __shfl_xor(s, 8);
        if (c16 == 0 && u <= 128) sc[u] = s - slope_d * (float)(128 - u);
    }
    asm volatile("s_waitcnt lgkmcnt(0)" ::: "memory");
    __syncthreads();
    float s0 = sc[lane], s1 = sc[lane + 64], s2 = (lane == 0) ? sc[128] : -INFINITY;
    float mx = fmaxf(fmaxf(s0, s1), s2);
#pragma unroll
    for (int o = 1; o < 64; o <<= 1) mx = fmaxf(mx, __shfl_xor(mx, o));
    s0 = __expf(s0 - mx); s1 = __expf(s1 - mx); s2 = __expf(s2 - mx);
    const float den = wave_sum(s0 + s1 + s2), inv = 1.0f / den;
    __syncthreads();
    sc[lane] = s0 * inv; sc[lane + 64] = s1 * inv; if (lane == 0) sc[128] = s2 * inv;
    if (lane >= 1 && lane < 4) sc[128 + lane] = 0.f;
    asm volatile("s_waitcnt lgkmcnt(0)" ::: "memory");
    __syncthreads();
    float o[8];
#pragma unroll
    for (int e = 0; e < 8; ++e) o[e] = 0.f;
    const float* vp0 = cvb + (size_t)(i + rr * dil) * 512;
#pragma unroll 1
    for (int bt = 0; bt < 2; ++bt) {
        f32x4 v0[15], v1[15];
#pragma unroll
        for (int t = 0; t < 15; ++t) { const float* p = vp0 + (size_t)(bt * 15 + t) * rstride; v0[t] = __builtin_nontemporal_load((const f32x4*)p); v1[t] = __builtin_nontemporal_load((const f32x4*)(p + 64)); }
#pragma unroll
        for (int t = 0; t < 15; ++t) { const float p = sc[4 * (bt * 15 + t) + rr];
#pragma unroll
            for (int e = 0; e < 4; ++e) { o[e] += p * v0[t][e]; o[4 + e] += p * v1[t][e]; } }
    }
#pragma unroll
    for (int it = 30; it < 33; ++it) {
        const int u = 4 * it + rr;
        if (u <= 128) {
            const int index = i + u * dil; const float p = sc[u];
            float v[8];
            if (index < W) { const f32x4 a0 = *(const f32x4*)(cvb + (size_t)index * 512), a1 = *(const f32x4*)(cvb + (size_t)index * 512 + 64);
                v[0] = a0[0]; v[1] = a0[1]; v[2] = a0[2]; v[3] = a0[3]; v[4] = a1[0]; v[5] = a1[1]; v[6] = a1[2]; v[7] = a1[3]; }
            else { const bf16_t* zv = znew + (size_t)(index - W) * DIN + Z_AV; const u32x2 a0 = *(const u32x2*)zv, a1 = *(const u32x2*)(zv + 64);
                v[0] = bflo(a0.x); v[1] = bfhi(a0.x); v[2] = bflo(a0.y); v[3] = bfhi(a0.y); v[4] = bflo(a1.x); v[5] = bfhi(a1.x); v[6] = bflo(a1.y); v[7] = bfhi(a1.y); }
#pragma unroll
            for (int e = 0; e < 8; ++e) o[e] += p * v[e];
        }
    }
#pragma unroll
    for (int e = 0; e < 8; ++e) { o[e] += __shfl_xor(o[e], 16); o[e] += __shfl_xor(o[e], 32); }
    if (rr == 0) {
        bf16_t* op = og + ((size_t)g * MT + zrow) * 512 + j * 128 + 4 * c16;
        u32x2 w0, w1; w0.x = pk2(o[0], o[1]); w0.y = pk2(o[2], o[3]); w1.x = pk2(o[4], o[5]); w1.y = pk2(o[6], o[7]);
        *(u32x2*)op = w0; *(u32x2*)(op + 64) = w1;
    }
    if (lane == 0) lse[((size_t)g * MT + zrow) * 4 + j] = mx + __logf(den);
    __syncthreads();
}

__device__ __forceinline__ void win_copy(const Args& a, const bf16_t* __restrict__ z, int l, int tid) {
    const int lane = tid & 63, gw = blockIdx.x * 8 + (tid >> 6), NGW = gridDim.x * 8;
    for (int idx = gw; idx < 12288; idx += NGW) {
        const int kv = idx / 6144; int rem = idx % 6144;
        size_t zrow; int g; float* dst;
        if (rem < 5376) {
            int W, bw;
            if (rem < 256) { g = 0; W = 128; bw = rem; } else if (rem < 1280) { g = 1; W = 512; bw = rem - 256; } else { g = 2; W = 2048; bw = rem - 1280; }
            const int b = bw / W, w = bw % W;
            zrow = (size_t)b * SEQ + (SEQ - W) + w;
            const size_t ooff = (g == 0) ? (kv ? O_PWV0 : O_PWK0) : (g == 1) ? (kv ? O_PWV1 : O_PWK1) : (kv ? O_PWV2 : O_PWK2);
            dst = a.out + ooff + (((size_t)l * 2 + b) * W + w) * 512;
        } else {
            rem -= 5376; g = rem >> 8; const int b = (rem & 255) >> 3, i = rem & 7, W = 128 << (2 * g);
            zrow = (size_t)MP + b * 8 + i;
            const size_t ooff = (g == 0) ? (kv ? O_SWV0 : O_SWK0) : (g == 1) ? (kv ? O_SWV1 : O_SWK1) : (kv ? O_SWV2 : O_SWK2);
            dst = a.out + ooff + (((size_t)l * 32 + b) * W + (W - 8) + i) * 512;
        }
        const u32x4 w4 = *(const u32x4*)(z + zrow * DIN + (kv ? Z_AV : Z_AK) + g * 512 + 8 * lane);
        *(f32x4*)(dst + 8 * lane) = (f32x4){bflo(w4.x), bfhi(w4.x), bflo(w4.y), bfhi(w4.y)};
        *(f32x4*)(dst + 8 * lane + 4) = (f32x4){bflo(w4.z), bfhi(w4.z), bflo(w4.w), bfhi(w4.w)};
    }
}

template <bool DO_SCAN, bool DO_COMBINE>
__device__ __forceinline__ void p3_scan_combine(const Args& a, int l, int tid) {
    const bf16_t* U = (const bf16_t*)(a.ws + WS_U); bf16_t* Rp = (bf16_t*)(a.ws + WS_RP);
    const int gt = blockIdx.x * 512 + tid, GT = gridDim.x * 512;
    if constexpr (DO_SCAN) for (int e = gt; e < 131072; e += GT) {
        const int vd = e & 32767, bh0 = e >> 15, bh1 = bh0 + 4, h = bh0 & 3;
        const float cd = __expf(ret_lg(h) * 128.0f);
        float R0 = 0.f, R1 = 0.f;
        const bf16_t* up0 = U + (size_t)bh0 * 64 * 32768 + vd; bf16_t* rp0 = Rp + (size_t)bh0 * 64 * 32768 + vd;
        const bf16_t* up1 = U + (size_t)bh1 * 64 * 32768 + vd; bf16_t* rp1 = Rp + (size_t)bh1 * 64 * 32768 + vd;
#pragma unroll 1
        for (int c0 = 0; c0 < 64; c0 += 16) {
            float u0[16], u1[16];
#pragma unroll
            for (int k = 0; k < 16; ++k) { u0[k] = __uint_as_float((unsigned)up0[(size_t)(c0 + k) * 32768] << 16); u1[k] = __uint_as_float((unsigned)up1[(size_t)(c0 + k) * 32768] << 16); }
#pragma unroll
            for (int k = 0; k < 16; ++k) { rp0[(size_t)(c0 + k) * 32768] = (bf16_t)f2bf(R0); R0 = cd * R0 + u0[k]; rp1[(size_t)(c0 + k) * 32768] = (bf16_t)f2bf(R1); R1 = cd * R1 + u1[k]; }
        }
        const int v = vd >> 7, d = vd & 127;
        a.out[O_PRET + ((size_t)l * 8 + bh0) * 32768 + d * 256 + v] = R0;
        a.out[O_PRET + ((size_t)l * 8 + bh1) * 32768 + d * 256 + v] = R1;
    }
    const bf16_t* og = (const bf16_t*)(a.ws + WS_OG); const float* lse = (const float*)(a.ws + WS_LSE); bf16_t* oatt = (bf16_t*)(a.ws + WS_OATT);
    const int lane = tid & 63, gw = blockIdx.x * 8 + (tid >> 6), NGW = gridDim.x * 8;
    if constexpr (DO_COMBINE) for (int row0 = gw; row0 < MT; row0 += 2 * NGW) {
        const int j = lane >> 4;
        u32x4 q[2][3]; float ls[2][3];
#pragma unroll
        for (int rr = 0; rr < 2; ++rr) { const int row = (row0 + rr * NGW < MT) ? row0 + rr * NGW : row0;
#pragma unroll
            for (int g = 0; g < 3; ++g) { ls[rr][g] = lse[((size_t)g * MT + row) * 4 + j]; q[rr][g] = *(const u32x4*)(og + ((size_t)g * MT + row) * 512 + 8 * lane); } }
#pragma unroll
        for (int rr = 0; rr < 2; ++rr) {
            const int row = row0 + rr * NGW; if (row >= MT) break;
            const float mx = fmaxf(ls[rr][0], fmaxf(ls[rr][1], ls[rr][2]));
            float w0 = __expf(ls[rr][0] - mx), w1 = __expf(ls[rr][1] - mx), w2 = __expf(ls[rr][2] - mx);
            const float inv = 1.0f / (w0 + w1 + w2); w0 *= inv; w1 *= inv; w2 *= inv;
            const u32x4 q0 = q[rr][0], q1 = q[rr][1], q2 = q[rr][2];
            const f32x4 a0 = {bflo(q0.x), bfhi(q0.x), bflo(q0.y), bfhi(q0.y)}, a1 = {bflo(q0.z), bfhi(q0.z), bflo(q0.w), bfhi(q0.w)};
            const f32x4 b0 = {bflo(q1.x), bfhi(q1.x), bflo(q1.y), bfhi(q1.y)}, b1 = {bflo(q1.z), bfhi(q1.z), bflo(q1.w), bfhi(q1.w)};
            const f32x4 c0_ = {bflo(q2.x), bfhi(q2.x), bflo(q2.y), bfhi(q2.y)}, c1_ = {bflo(q2.z), bfhi(q2.z), bflo(q2.w), bfhi(q2.w)};
            const f32x4 r0 = a0 * w0 + b0 * w1 + c0_ * w2, r1 = a1 * w0 + b1 * w1 + c1_ * w2;
            u32x4 w; w.x = pk2(r0[0], r0[1]); w.y = pk2(r0[2], r0[3]); w.z = pk2(r1[0], r1[1]); w.w = pk2(r1[2], r1[3]);
            *(u32x4*)(oatt + (size_t)row * 512 + 8 * lane) = w;
        }
    }
}

constexpr int RO_VOFF = 128 * KVS, RO_ROFF = RO_VOFF + 128 * RVS;
__device__ __forceinline__ void ret_out_item(LAS unsigned char* lds, const bf16_t* __restrict__ z, const bf16_t* __restrict__ Rp, bf16_t* __restrict__ oret, int item, int tid) {
    const int wid = __builtin_amdgcn_readfirstlane(tid >> 6), lane = tid & 63, fr = lane & 15, quad = lane >> 4;
    const int c = item & 63, bh = item >> 6, h = bh & 3, b = bh >> 2;
    const float lg = ret_lg(h);
    const size_t zrow0 = (size_t)b * SEQ + 128 * c;
    const bf16_t* z0 = z + zrow0 * DIN;
    const bf16_t* R0 = Rp + (size_t)item * 32768;
#pragma unroll
    for (int it = 0; it < 4; ++it) {
        const int idx = tid + it * 512, jj = idx >> 4, ch = idx & 15;
        *(LAS u32x4*)(lds + jj * KVS + ch * 16) = *(const u32x4*)(z0 + (size_t)jj * DIN + Z_RK + h * 128 + ch * 8);
        *(LAS u32x4*)(lds + RO_ROFF + jj * KVS + ch * 16) = *(const u32x4*)(R0 + (size_t)jj * 128 + ch * 8);
    }
#pragma unroll
    for (int it = 0; it < 8; ++it) {
        const int idx = tid + it * 512, jj = idx >> 5, ch = idx & 31;
        *(LAS u32x4*)(lds + RO_VOFF + jj * RVS + ch * 16) = *(const u32x4*)(z0 + (size_t)jj * DIN + Z_RV + h * 256 + ch * 8);
    }
    const int iq = 16 * wid + fr;
    bf16x8 qf[4];
#pragma unroll
    for (int ks = 0; ks < 4; ++ks) qf[ks] = *(const bf16x8*)(z0 + (size_t)iq * DIN + Z_RQ + h * 128 + ks * 32 + quad * 8);
    __syncthreads();
    f32x4 o[16];
#pragma unroll
    for (int vt = 0; vt < 16; ++vt) o[vt] = (f32x4){0.f, 0.f, 0.f, 0.f};
#pragma unroll
    for (int vt = 0; vt < 8; ++vt)
#pragma unroll
        for (int ks = 0; ks < 4; ++ks) { const bf16x8 ra = *(LAS const bf16x8*)(lds + RO_ROFF + (16 * vt + fr) * KVS + ks * 64 + quad * 16); o[vt] = MFMA16(ra, qf[ks], o[vt]); }
    __syncthreads();
#pragma unroll
    for (int it = 0; it < 4; ++it) {
        const int idx = tid + it * 512, jj = idx >> 4, ch = idx & 15;
        *(LAS u32x4*)(lds + RO_ROFF + jj * KVS + ch * 16) = *(const u32x4*)(R0 + (size_t)(128 + jj) * 128 + ch * 8);
    }
    __syncthreads();
#pragma unroll
    for (int vt = 0; vt < 8; ++vt)
#pragma unroll
        for (int ks = 0; ks < 4; ++ks) { const bf16x8 ra = *(LAS const bf16x8*)(lds + RO_ROFF + (16 * vt + fr) * KVS + ks * 64 + quad * 16); o[8 + vt] = MFMA16(ra, qf[ks], o[8 + vt]); }
    const float xi = __expf(lg * (float)(iq + 1));
#pragma unroll
    for (int vt = 0; vt < 16; ++vt) o[vt] = o[vt] * xi;
#pragma unroll
    for (int kp = 0; kp < 4; ++kp) {
        if (2 * kp <= wid) {
            const bool hasB = (2 * kp + 1 <= wid);
            const int TA = 2 * kp, TB = hasB ? TA + 1 : TA;
            f32x4 sa = {0.f, 0.f, 0.f, 0.f}, sb = {0.f, 0.f, 0.f, 0.f};
#pragma unroll
            for (int ks = 0; ks < 4; ++ks) {
                const bf16x8 ka = *(LAS const bf16x8*)(lds + (16 * TA + fr) * KVS + ks * 64 + quad * 16); sa = MFMA16(ka, qf[ks], sa);
                const bf16x8 kb = *(LAS const bf16x8*)(lds + (16 * TB + fr) * KVS + ks * 64 + quad * 16); sb = MFMA16(kb, qf[ks], sb);
            }
#pragma unroll
            for (int e = 0; e < 4; ++e) {
                const int da = iq - (16 * TA + 4 * quad + e), db = iq - (16 * TB + 4 * quad + e);
                sa[e] = (da >= 0) ? sa[e] * __expf(lg * (float)da) : 0.f;
                sb[e] = (hasB && db >= 0) ? sb[e] * __expf(lg * (float)db) : 0.f;
            }
            u32x4 pw; pw.x = pk2(sa[0], sa[1]); pw.y = pk2(sa[2], sa[3]); pw.z = pk2(sb[0], sb[1]); pw.w = pk2(sb[2], sb[3]);
            const bf16x8 p8 = __builtin_bit_cast(bf16x8, pw);
            LAS const unsigned char* bA = lds + RO_VOFF + (16 * TA + 4 * quad + (fr >> 2)) * RVS + (fr & 3) * 8;
            LAS const unsigned char* bB = lds + RO_VOFF + (16 * TB + 4 * quad + (fr >> 2)) * RVS + (fr & 3) * 8;
#pragma unroll
            for (int vt = 0; vt < 16; ++vt) { const v4i16_t va = tr4(bA + vt * 32), vb = tr4(bB + vt * 32); o[vt] = MFMA16(cat8(va, vb), p8, o[vt]); }
        }
    }
    float s = 0.f;
#pragma unroll
    for (int vt = 0; vt < 16; ++vt) s += (o[vt][0] + o[vt][1]) + (o[vt][2] + o[vt][3]);
    s += __shfl_xor(s, 16); s += __shfl_xor(s, 32);
    const float mu = s * (1.0f / 256.0f); float qv = 0.f;
#pragma unroll
    for (int vt = 0; vt < 16; ++vt) { o[vt] = o[vt] - mu; qv += (o[vt][0] * o[vt][0] + o[vt][1] * o[vt][1]) + (o[vt][2] * o[vt][2] + o[vt][3] * o[vt][3]); }
    qv += __shfl_xor(qv, 16); qv += __shfl_xor(qv, 32);
    const float rstd = 1.0f / sqrtf(qv * (1.0f / 256.0f) + 1e-6f);
    const bf16_t* rgp = z0 + (size_t)iq * DIN + Z_RG + h * 256 + 4 * quad;
    bf16_t* op = oret + (zrow0 + iq) * DM + h * 256 + 4 * quad;
#pragma unroll
    for (int vt = 0; vt < 16; ++vt) {
        const u32x2 gw = *(const u32x2*)(rgp + 16 * vt);
        const float g0 = bflo(gw.x), g1 = bfhi(gw.x), g2 = bflo(gw.y), g3 = bfhi(gw.y);
        const float x0 = o[vt][0] * rstd * g0 / (1.0f + __expf(-g0)), x1 = o[vt][1] * rstd * g1 / (1.0f + __expf(-g1)), x2 = o[vt][2] * rstd * g2 / (1.0f + __expf(-g2)), x3 = o[vt][3] * rstd * g3 / (1.0f + __expf(-g3));
        u32x2 w; w.x = pk2(x0, x1); w.y = pk2(x2, x3);
        *(u32x2*)(op + 16 * vt) = w;
    }
    __syncthreads();
}

#define XB_TMO      128
#define XB_XCNT(j)  (256  + 64 * (j))
#define XB_XSUB(j)  (1280 + 64 * (j))
#define XB_XGEN(j)  (2304 + 64 * (j))
#define XB_TOP      3328
#define XB_TOPGEN   3392
#define XCD_BAR_WORDS 3456
#define XB_SPIN_CAP (1u << 18)

__device__ __forceinline__ unsigned xb_ld(unsigned* p)              { return __hip_atomic_load(p, __ATOMIC_RELAXED, __HIP_MEMORY_SCOPE_AGENT); }
__device__ __forceinline__ unsigned xb_add(unsigned* p, unsigned v) { return __hip_atomic_fetch_add(p, v, __ATOMIC_RELAXED, __HIP_MEMORY_SCOPE_AGENT); }
__device__ __forceinline__ unsigned xb_xcc_id() { return (unsigned)__builtin_amdgcn_s_getreg((3 << 11) | 20) & 0xFu; }
#define XB_SPIN(cond, bar) do { unsigned _sp = 0; while (cond) { __builtin_amdgcn_s_sleep(1); \
    if ((++_sp & 255u) == 0u) { if (xb_ld(&(bar)[XB_TMO])) break; if (_sp > XB_SPIN_CAP) { atomicAdd(&(bar)[XB_TMO], 1u); break; } } } } while (0)

struct XcdBarrier {
    unsigned* bar; unsigned x;
    volatile LAS unsigned* st;
};

__device__ __forceinline__ XcdBarrier xcd_barrier_post(unsigned* bar, volatile LAS unsigned* st) {
    XcdBarrier b; b.bar = bar; b.x = xb_xcc_id(); b.st = st;
    if (threadIdx.x == 0) (void)xb_add(&bar[XB_XCNT(b.x)], 1u);
    return b;
}
__device__ __forceinline__ void xcd_barrier_complete(unsigned* bar, unsigned x, unsigned& nloc, unsigned& nx) {
    const unsigned G = gridDim.x * gridDim.y * gridDim.z;
    unsigned sum, cnt, mine, sp = 0u;
    for (;;) {
        sum = 0u; cnt = 0u; mine = 0u;
#pragma unroll
        for (unsigned j = 0; j < 16; ++j) { const unsigned c = xb_ld(&bar[XB_XCNT(j)]); sum += c; cnt += (c > 0u) ? 1u : 0u; mine = (j == x) ? c : mine; }
        if (sum == G) break;
        __builtin_amdgcn_s_sleep(1);
        if ((++sp & 255u) == 0u) { if (xb_ld(&bar[XB_TMO])) break; if (sp > XB_SPIN_CAP) { atomicAdd(&bar[XB_TMO], 1u); break; } }
    }
    nloc = mine > 0u ? mine : 1u; nx = cnt > 0u ? cnt : 1u;
}

__device__ __forceinline__ void xcd_barrier(const XcdBarrier& b) {
    asm volatile("s_waitcnt vmcnt(0)" ::: "memory");
    __syncthreads();
    if (threadIdx.x == 0) {
        unsigned* bar = b.bar;
        __builtin_amdgcn_s_waitcnt(0);
        unsigned nloc = b.st[0], nx = b.st[1];
        if (nloc == 0u) { xcd_barrier_complete(bar, b.x, nloc, nx); b.st[0] = nloc; b.st[1] = nx; }
        const unsigned old = xb_add(&bar[XB_XSUB(b.x)], 1u);
        const unsigned gen = old / nloc;
        if (old + 1u == (gen + 1u) * nloc) {
            __builtin_amdgcn_fence(__ATOMIC_RELEASE, "agent");
            asm volatile("s_waitcnt vmcnt(0)" ::: "memory");
            const unsigned og = xb_add(&bar[XB_TOP], 1u);
            const unsigned tg = og / nx;
            if (og + 1u == (tg + 1u) * nx) xb_add(&bar[XB_TOPGEN], 1u);
            else XB_SPIN(xb_ld(&bar[XB_TOPGEN]) == tg, bar);
            __builtin_amdgcn_fence(__ATOMIC_ACQUIRE, "agent");
            xb_add(&bar[XB_XGEN(b.x)], 1u);
            asm volatile("s_waitcnt vmcnt(0)" ::: "memory");
        } else {
            XB_SPIN(xb_ld(&bar[XB_XGEN(b.x)]) == gen, bar);
            __builtin_amdgcn_fence(__ATOMIC_ACQUIRE, "agent");
            asm volatile("s_waitcnt vmcnt(0)" ::: "memory");
        }
    }
    __syncthreads();
}

template <int MODE>
__device__ __forceinline__ void skinny_phase(LAS unsigned char* lds, const bf16_t* __restrict__ A, const bf16_t* __restrict__ Wt, int K, const pg8::Epi<MODE>& E, int tid_in) {
    int tid = tid_in; asm volatile("" : "+v"(tid));
    const int wid = __builtin_amdgcn_readfirstlane(tid >> 6), lane = tid & 63, fr = lane & 15, quad = lane >> 4;
    LAS f32x4* red = (LAS f32x4*)lds;
    LAS float* ssq_l = (LAS float*)(lds + 32768);
#pragma unroll 1
    for (int slab = blockIdx.x; slab < 256; slab += gridDim.x) {
        const int rt = slab & 15, cs = slab >> 4;
        const bf16_t* arow = A + (size_t)(MP + 16 * rt + fr) * K + 8 * quad;
        const bf16_t* wrow = Wt + (size_t)(64 * cs + fr) * K + 8 * quad;
        f32x4 acc[4];
#pragma unroll
        for (int ct = 0; ct < 4; ++ct) acc[ct] = (f32x4){0.f, 0.f, 0.f, 0.f};
        const int nks = K >> 5;
#pragma unroll 4
        for (int ks = wid; ks < nks; ks += 8) {
            const bf16x8 b = *(const bf16x8*)(arow + 32 * ks);
#pragma unroll
            for (int ct = 0; ct < 4; ++ct) { const bf16x8 w = *(const bf16x8*)(wrow + (size_t)(16 * ct) * K + 32 * ks); acc[ct] = MFMA16(w, b, acc[ct]); }
        }
#pragma unroll
        for (int ct = 0; ct < 4; ++ct) red[(wid * 4 + ct) * 64 + lane] = acc[ct];
        __syncthreads();
        if (wid < 4) {
            f32x4 s = red[wid * 64 + lane];
#pragma unroll
            for (int w = 1; w < 8; ++w) s = s + red[(w * 4 + wid) * 64 + lane];
            float ssq = E.elem(MP + 16 * rt + fr, 64 * cs + 16 * wid + 4 * quad, s);
            if constexpr (MODE == pg8::E_RES || MODE == pg8::E_GATE) { ssq += __shfl_xor(ssq, 16); ssq += __shfl_xor(ssq, 32); if (quad == 0) ssq_l[wid * 16 + fr] = ssq; }
        }
        __syncthreads();
        if constexpr (MODE == pg8::E_RES || MODE == pg8::E_GATE) { if (tid < 16) E.ssp_out[(size_t)(MP + 16 * rt + tid) * 16 + cs] = (ssq_l[tid] + ssq_l[16 + tid]) + (ssq_l[32 + tid] + ssq_l[48 + tid]); }
        __syncthreads();
    }
}

#define GEMM_PHASE(MODE, Aptr, Bptr, Mm, Nn, Kk, EPI) do { int kk_ = (Kk); asm volatile("" : "+s"(kk_)); pg8::Gemm g_{(const pg8::bf16_t*)(Aptr), (const pg8::bf16_t*)(Bptr), (Mm), (Nn), kk_}; pg8::StaticOrder S_; S_.init((Mm), (Nn), (int)gridDim.x, (int)blockIdx.x); \
    pg8::gemm_phase<pg8::Epi<MODE>, pg8::StaticOrder, true, true>((PG8_LAS unsigned char*)lds, g_, S_, (EPI)); } while (0)

__global__ void __launch_bounds__(512, 2) mega_fwd(Args a) {
    extern __shared__ __attribute__((aligned(16))) unsigned char lds_raw[];
    LAS unsigned char* lds = (LAS unsigned char*)lds_raw;
    cg::grid_group grid = cg::this_grid();
    int tid = threadIdx.x;
#define OPQ() asm volatile("" : "+v"(tid))
    unsigned char* ws = a.ws;
    float* ssp = (float*)(ws + WS_SSP); bf16_t* tbuf = (bf16_t*)(ws + WS_T);
    bf16_t* z = (bf16_t*)(ws + WS_Z); bf16_t* ubuf = (bf16_t*)(ws + WS_Z);
    bf16_t* oret = (bf16_t*)(ws + WS_ORET); bf16_t* oatt = (bf16_t*)(ws + WS_OATT); bf16_t* merged = (bf16_t*)(ws + WS_MERGED);
    bf16_t* og = (bf16_t*)(ws + WS_OG); float* lse = (float*)(ws + WS_LSE); bf16_t* U = (bf16_t*)(ws + WS_U); bf16_t* Rp = (bf16_t*)(ws + WS_RP);

#ifndef PHMASK
#define PHMASK 0xFFFFF
#endif
#define PH(n) if constexpr ((PHMASK >> (n)) & 1)
    unsigned* barw = (unsigned*)(ws + WS_CTL);
    volatile LAS unsigned* MISC = (volatile LAS unsigned*)(lds + LDS_BYTES - 64);
    if (tid < 2) MISC[tid] = 0u;
    if (blockIdx.x == 0) for (int i = tid; i < XCD_BAR_WORDS; i += 512) __hip_atomic_store(barw + i, 0u, __ATOMIC_RELAXED, __HIP_MEMORY_SCOPE_AGENT);
    PH(0) p0_prologue(a, lds, tid);
    grid.sync();
    const XcdBarrier xbar = xcd_barrier_post(barw, MISC);
#define GSYNC() xcd_barrier(xbar)

#pragma unroll 1
    for (int l = 0; l < 2; ++l) {
        unsigned char* wl = ws + WS_WT + (size_t)l * WT_LAYER;
        bf16_t* xb_cur = (bf16_t*)(ws + (l == 0 ? WS_XBA : WS_XBB));
        bf16_t* xb_nxt = (bf16_t*)(ws + (l == 0 ? WS_XBB : WS_XBA));
#ifndef REP_G
#define REP_G 1
#endif
#pragma unroll 1
        for (int rg_ = 0; rg_ < REP_G; ++rg_) {
        PH(1) { pg8::Epi<pg8::E_Z> E{z, DIN, nullptr, nullptr, ssp, nullptr, nullptr, nullptr}; GEMM_PHASE(pg8::E_Z, xb_cur, wl + WT_IN, MT, DIN, DM, E); }
        if (rg_ + 1 < REP_G) GSYNC();
        }
        cache_copy_tail(a, 2470, l * 500 + 0, l * 500 + 50, tid);
        GSYNC();
#ifndef REP_MIX
#define REP_MIX 1
#endif
#pragma unroll 1
        for (int rep_ = 0; rep_ < REP_MIX; ++rep_) {
        OPQ();
        PH(3) for (int it = blockIdx.x; it < 512; it += gridDim.x) ret_u_item(lds, z, U, it, tid);
        GSYNC();
        if (blockIdx.x & 1) cache_copy_tail(a, 0, l * 500 + 190, l * 500 + 310, tid);
#pragma unroll 1
        for (int stage_ = 0; stage_ < 2; ++stage_) {
        const bool sample_now = ((stage_ == 0) == ((blockIdx.x & 1) != 0));
        if (!sample_now) {
        OPQ();
        PH(2) { const int per_ = (1536 + (int)gridDim.x - 1) / (int)gridDim.x; for (int i_ = 0; i_ < per_; ++i_) { const int it = (int)blockIdx.x * per_ + i_; if (it < 1536) attn_prompt_item(lds, z, og, lse, it, tid); } }
        } else {
        OPQ();
        PH(4) for (int it = blockIdx.x; it < 384; it += gridDim.x) {
            const int g = (it >> 2) % 3;
            attn_sample_item(lds, z, a.in[2 + 2 * g], a.in[3 + 2 * g], l, og, lse, it, tid);
        }
        OPQ();
        PH(5) for (int it = (blockIdx.x + gridDim.x / 2) % gridDim.x; it < 128; it += gridDim.x) ret_sample_item(lds, z, a.in[8] + (size_t)l * 128 * 32768, a.out + O_SRET + (size_t)l * 128 * 32768, oret, it, tid);
        }
        }
        OPQ();
        PH(7) p3_scan_combine<true, false>(a, l, tid);
        PH(6) win_copy(a, z, l, tid);
        if (!(blockIdx.x & 1)) cache_copy_tail(a, 0, l * 500 + 190, l * 500 + 310, tid);
        GSYNC();
        OPQ();
        if (blockIdx.x & 1) cache_copy_tail(a, 0, l * 500 + 310, l * 500 + 500, tid);
        PH(8) for (int it = blockIdx.x; it < 512; it += gridDim.x) ret_out_item(lds, z, Rp, oret, it, tid);
        PH(7) p3_scan_combine<false, true>(a, l, tid);
        if (!(blockIdx.x & 1)) cache_copy_tail(a, 0, l * 500 + 310, l * 500 + 500, tid);
        GSYNC();
        }
        PH(9) { pg8::Epi<pg8::E_RET> E{nullptr, DM, nullptr, tbuf, nullptr, nullptr, z + Z_GA, nullptr}; GEMM_PHASE(pg8::E_RET, oret, wl + WT_RET, MP, DM, DM, E); skinny_phase<pg8::E_RET>(lds, oret, (const bf16_t*)(wl + WT_RET), DM, E, tid); }
        PH(10) { pg8::Epi<pg8::E_ATT> E{merged, DM, nullptr, tbuf, nullptr, nullptr, z + Z_GB, nullptr}; GEMM_PHASE(pg8::E_ATT, oatt, wl + WT_ATT, MP, DM, 512, E); skinny_phase<pg8::E_ATT>(lds, oatt, (const bf16_t*)(wl + WT_ATT), 512, E, tid); }
        GSYNC();
        PH(11) { pg8::Epi<pg8::E_RES> E{xb_cur, DM, xb_cur, nullptr, nullptr, ssp, nullptr, (l == 0) ? a.in[0] : (const float*)nullptr}; GEMM_PHASE(pg8::E_RES, merged, wl + WT_OUT, MP, DM, DM, E);
          pg8::Epi<pg8::E_RES> Es{xb_cur, DM, xb_cur, nullptr, nullptr, ssp, nullptr, (l == 0) ? a.in[1] - (size_t)MP * DM : (const float*)nullptr}; skinny_phase<pg8::E_RES>(lds, merged, (const bf16_t*)(wl + WT_OUT), DM, Es, tid); }
        GSYNC();
#pragma unroll 1
        for (int rg_ = 0; rg_ < REP_G; ++rg_) {
        PH(12) { pg8::Epi<pg8::E_UP> E{ubuf, DFF, nullptr, nullptr, ssp, nullptr, nullptr, nullptr}; GEMM_PHASE(pg8::E_UP, xb_cur, wl + WT_UP, MT, DFF, DM, E); }
        if (rg_ + 1 < REP_G) GSYNC();
        }
        cache_copy_tail(a, 1040, l * 500 + 50, l * 500 + 190, tid);
        GSYNC();
        PH(13) { pg8::Epi<pg8::E_RES> E{xb_cur, DM, xb_cur, nullptr, nullptr, ssp, nullptr, nullptr}; GEMM_PHASE(pg8::E_RES, ubuf, wl + WT_DOWN, MP, DM, DFF, E); skinny_phase<pg8::E_RES>(lds, ubuf, (const bf16_t*)(wl + WT_DOWN), DFF, E, tid); }
        GSYNC();
        PH(14) { pg8::Epi<pg8::E_PLE> E{nullptr, DM, nullptr, tbuf, nullptr, nullptr, nullptr, nullptr}; GEMM_PHASE(pg8::E_PLE, ws + WS_PB + (size_t)l * MT * DPLE * 2, wl + WT_PLE, MP, DM, DPLE, E); skinny_phase<pg8::E_PLE>(lds, (const bf16_t*)(ws + WS_PB + (size_t)l * MT * DPLE * 2), (const bf16_t*)(wl + WT_PLE), DPLE, E, tid); }
        PH(15) { pg8::Epi<pg8::E_GATE> E{xb_nxt, DM, xb_cur, tbuf, nullptr, ssp, nullptr, nullptr}; GEMM_PHASE(pg8::E_GATE, xb_cur, wl + WT_GATE, MP, DM, DM, E); skinny_phase<pg8::E_GATE>(lds, xb_cur, (const bf16_t*)(wl + WT_GATE), DM, E, tid); }
        GSYNC();
    }
    {
        const int lane = tid & 63, gw = blockIdx.x * 8 + (tid >> 6), NGW = gridDim.x * 8;
        const float* nf = a.in[21];
        for (int m = gw; m < MT; m += NGW) {
            float sv = (lane < 16) ? ssp[(size_t)m * 16 + lane] : 0.f;
            sv = wave_sum(sv);
            const float rstd = 1.0f / sqrtf(sv * (1.0f / 1024.0f) + 1e-6f);
#pragma unroll
            for (int j = 0; j < 4; ++j) { const u32x2 xw_ = *(const u32x2*)((const bf16_t*)(ws + WS_XBA) + (size_t)m * DM + 4 * lane + 256 * j); const f32x4 v = {bflo(xw_.x), bfhi(xw_.x), bflo(xw_.y), bfhi(xw_.y)}; const f32x4 gn = *(const f32x4*)(nf + 4 * lane + 256 * j); *(f32x4*)(a.out + O_Y + (size_t)m * DM + 4 * lane + 256 * j) = v * rstd * gn; }
        }
    }
}

extern "C" void kernel_launch(void* const* d_in, const int* in_sizes, int n_in, void* d_out, int out_size, void* d_ws, size_t ws_size, hipStream_t stream) {
    static int grid = 0;
    if (grid == 0) {
        if (n_in != 22 || (size_t)out_size != O_END || ws_size < WS_END) { fprintf(stderr, "kernel_launch: unexpected shapes: n_in %d out %d (want %zu) ws %zu (need %zu)\n", n_in, out_size, (size_t)O_END, ws_size, (size_t)WS_END); grid = -1; return; }
        int dev = 0, cus = 0, per_cu = 0;
        if (hipGetDevice(&dev) != hipSuccess || hipDeviceGetAttribute(&cus, hipDeviceAttributeMultiprocessorCount, dev) != hipSuccess) { grid = -1; return; }
        if (hipFuncSetAttribute((const void*)mega_fwd, hipFuncAttributeMaxDynamicSharedMemorySize, LDS_BYTES) != hipSuccess) { fprintf(stderr, "kernel_launch: hipFuncSetAttribute failed\n"); grid = -1; return; }
        if (hipOccupancyMaxActiveBlocksPerMultiprocessor(&per_cu, (const void*)mega_fwd, 512, LDS_BYTES) != hipSuccess || per_cu < 1) { fprintf(stderr, "kernel_launch: occupancy query says %d\n", per_cu); per_cu = 1; }
        (void)hipGetLastError();
        grid = cus * 1;
    }
    if (grid < 0) return;
    Args a{};
    for (int i = 0; i < 22; ++i) a.in[i] = (const float*)d_in[i];
    a.out = (float*)d_out; a.ws = (unsigned char*)d_ws;
    void* args[] = {&a};
    hipError_t e = hipLaunchCooperativeKernel((const void*)mega_fwd, dim3(grid), dim3(512), args, LDS_BYTES, stream);
    if (e != hipSuccess) fprintf(stderr, "cooperative launch failed: %s (grid %d)\n", hipGetErrorString(e), grid);
}
```

```cpp
#include <hip/hip_runtime.h>
#include <hip/hip_cooperative_groups.h>
#include <cstdio>
#include <cstdint>
#include <cmath>
namespace cg = cooperative_groups;
namespace pg8 {
#define PG8_LAS __attribute__((address_space(3)))
typedef unsigned short bf16_t;
typedef short bf16x8 __attribute__((ext_vector_type(8)));
typedef float f32x4 __attribute__((ext_vector_type(4)));
typedef unsigned u32x4 __attribute__((ext_vector_type(4)));
constexpr int BM = 256, BK = 64, HALF = 128, HTB = HALF * BK * 2  , STAGE_BYTES = 8 * HTB, NXCD = 8, WGM = 8;

__host__ __device__ __forceinline__ int lds_byte(int r, int c) { const int st = (r >> 4) * 2 + (c >> 5), rr = r & 15, cc = c & 31, ob = rr * 64 + cc * 2; return st * 1024 + (ob ^ (((ob >> 9) & 1) << 5)); }
__host__ __device__ __forceinline__ void stage_rc(int b, int& R, int& C) { const int st = b / 1024, sb = b % 1024, swz = sb ^ (((sb >> 9) & 1) << 5); R = (st >> 1) * 16 + swz / 64; C = (st & 1) * 32 + (swz % 64) / 2; }
__host__ __device__ __forceinline__ int perm32(int rho) { const int n = rho >> 4, i = rho & 15; return 8 * (i >> 2) + 4 * n + (i & 3); }

struct Unit { int pm, pn; };
struct Gemm { const bf16_t* A; const bf16_t* Bt; int M, N, K; };

struct StaticOrder {
    int nM, nN, nwg, G, c;
    __host__ __device__ void init(int M, int N, int G_, int c_) { nM = M / BM; nN = N / BM; nwg = nM * nN; G = G_; c = c_; }
    __host__ __device__ bool next(int i, Unit& u) const {
        const long L = (long)i * G + c; if (L >= nwg) return false;
        int wgid = (int)L; { const int q = nwg / NXCD, r = nwg % NXCD, xcd = wgid % NXCD, off = wgid / NXCD; wgid = (xcd < r ? xcd * (q + 1) : r * (q + 1) + (xcd - r) * q) + off; }
        const int nig = WGM * nN, gid = wgid / nig, fm = gid * WGM, gsz = (nM - fm) < WGM ? (nM - fm) : WGM;
        u.pm = fm + ((wgid % nig) % gsz); u.pn = (wgid % nig) / gsz; return true;
    }
    __device__ __forceinline__ void a_ready(const Unit&) const {}
    __device__ __forceinline__ void done(const Unit&) const {}
};

__device__ __forceinline__ unsigned cvt_pk_bf16(float lo, float hi) { unsigned r; asm("v_cvt_pk_bf16_f32 %0, %1, %2" : "=v"(r) : "v"(lo), "v"(hi)); return r; }

typedef unsigned u32x2 __attribute__((ext_vector_type(2)));
__device__ __forceinline__ float bf2f(unsigned h) { return __uint_as_float(h << 16); }
__device__ __forceinline__ float sigmoidf_(float x) { return 1.0f / (1.0f + __expf(-x)); }
__device__ __forceinline__ f32x4 bf4_to_f32(u32x2 w) { f32x4 r; r[0] = bf2f(w.x & 0xffffu); r[1] = bf2f(w.x >> 16); r[2] = bf2f(w.y & 0xffffu); r[3] = bf2f(w.y >> 16); return r; }
__device__ __forceinline__ u32x2 f32_to_bf4(f32x4 v) { u32x2 w; w.x = cvt_pk_bf16(v[0], v[1]); w.y = cvt_pk_bf16(v[2], v[3]); return w; }
enum { E_Z = 0, E_UP = 1, E_RET = 2, E_ATT = 3, E_RES = 4, E_PLE = 5, E_GATE = 6 };
template <int MODE> struct Epi {
    static constexpr bool PERM = (MODE == E_Z || MODE == E_UP), AFTER_DRAIN = false;
    bf16_t* ob; int ldob; const bf16_t* xrb; bf16_t* t; const float* ssp_in; float* ssp_out; const bf16_t* gate; const float* xr;
    __device__ __forceinline__ float elem(int row, int col, const f32x4 a) const {
        const size_t off = (size_t)row * 1024 + col; float ssq = 0.f;
        if constexpr (MODE == E_RET || MODE == E_ATT) {
            const u32x2 gw = *(const u32x2*)(gate + (size_t)row * 9728 + col);
            f32x4 gv; gv[0] = sigmoidf_(bf2f(gw.x & 0xffffu)); gv[1] = sigmoidf_(bf2f(gw.x >> 16)); gv[2] = sigmoidf_(bf2f(gw.y & 0xffffu)); gv[3] = sigmoidf_(bf2f(gw.y >> 16));
            if constexpr (MODE == E_RET) { *(u32x2*)(t + off) = f32_to_bf4(gv * a); }
            else { const f32x4 tv = bf4_to_f32(*(const u32x2*)(t + off)); const f32x4 o = tv + gv * a; u32x2 w; w.x = cvt_pk_bf16(o[0], o[1]); w.y = cvt_pk_bf16(o[2], o[3]); *(u32x2*)(ob + off) = w; }
        } else if constexpr (MODE == E_PLE) {
            *(u32x2*)(t + off) = f32_to_bf4(a);
        } else if constexpr (MODE == E_RES || MODE == E_GATE) {
            f32x4 x = xr ? *(const f32x4*)(xr + off) : bf4_to_f32(*(const u32x2*)(xrb + off));
            if constexpr (MODE == E_GATE) { const f32x4 tv = bf4_to_f32(*(const u32x2*)(t + off)); f32x4 sg; sg[0] = sigmoidf_(a[0]); sg[1] = sigmoidf_(a[1]); sg[2] = sigmoidf_(a[2]); sg[3] = sigmoidf_(a[3]); x = x + tv * sg; }
            else x = x + a;
            u32x2 w; w.x = cvt_pk_bf16(x[0], x[1]); w.y = cvt_pk_bf16(x[2], x[3]); *(u32x2*)(ob + off) = w;
            ssq = (x[0] * x[0] + x[1] * x[1]) + (x[2] * x[2] + x[3] * x[3]);
        }
        return ssq;
    }
    __device__ __forceinline__ void operator()(const f32x4 (&acc)[2][2][4][2], const Unit& u, int wr, int wc, int fr, int fq) const {
        const int row0 = u.pm * BM + wr * 64 + fr;
        if constexpr (PERM) {
            const int col0 = u.pn * BM + wc * 32 + 8 * fq;
            f32x4 sp[2][4];
#pragma unroll
            for (int ai = 0; ai < 2; ++ai)
#pragma unroll
                for (int m = 0; m < 4; ++m) sp[ai][m] = *(const f32x4*)(ssp_in + (size_t)(row0 + ai * HALF + m * 16) * 16 + 4 * fq);
#pragma unroll
            for (int ai = 0; ai < 2; ++ai)
#pragma unroll
                for (int m = 0; m < 4; ++m) {
                    const int row = row0 + ai * HALF + m * 16;
                    float ss = (sp[ai][m][0] + sp[ai][m][1]) + (sp[ai][m][2] + sp[ai][m][3]);
                    ss += __shfl_xor(ss, 16); ss += __shfl_xor(ss, 32);
                    const float rstd = 1.0f / sqrtf(ss * (1.0f / 1024.0f) + 1e-6f);
                    bf16_t* rowp = ob + (size_t)row * ldob + col0;
#pragma unroll
                    for (int bj = 0; bj < 2; ++bj) {
                        f32x4 v0 = acc[ai][bj][m][0] * rstd, v1 = acc[ai][bj][m][1] * rstd;
                        if constexpr (MODE == E_UP) {
#pragma unroll
                            for (int e = 0; e < 4; ++e) { float a = fmaxf(v0[e], 0.f), b = fmaxf(v1[e], 0.f); v0[e] = a * a; v1[e] = b * b; }
                        }
                        u32x4 w; w.x = cvt_pk_bf16(v0[0], v0[1]); w.y = cvt_pk_bf16(v0[2], v0[3]); w.z = cvt_pk_bf16(v1[0], v1[1]); w.w = cvt_pk_bf16(v1[2], v1[3]);
                        *(u32x4*)(rowp + bj * HALF) = w;
                    }
                }
        } else {
            const int col0 = u.pn * BM + wc * 32 + 4 * fq;
            constexpr int MB = (MODE == E_GATE) ? 1 : 2;
#pragma unroll
            for (int aim = 0; aim < 8 / MB; ++aim) {
                const int ai = aim / (4 / MB), m0 = (aim % (4 / MB)) * MB;
                f32x4 xv[4][2][2]; u32x2 xw[4][2][2]; u32x2 tv[4][2][2]; u32x2 gw[4][2][2];
#pragma unroll
                for (int m = m0; m < m0 + MB; ++m)
#pragma unroll
                    for (int bj = 0; bj < 2; ++bj)
#pragma unroll
                        for (int n = 0; n < 2; ++n) {
                            const int row = row0 + ai * HALF + m * 16, col = col0 + bj * HALF + n * 16; const size_t off = (size_t)row * 1024 + col;
                            if constexpr (MODE == E_RES || MODE == E_GATE) { if (xr) xv[m][bj][n] = *(const f32x4*)(xr + off); else xw[m][bj][n] = *(const u32x2*)(xrb + off); }
                            if constexpr (MODE == E_ATT || MODE == E_GATE) tv[m][bj][n] = *(const u32x2*)(t + off);
                            if constexpr (MODE == E_RET || MODE == E_ATT) gw[m][bj][n] = *(const u32x2*)(gate + (size_t)row * 9728 + col);
                        }
#pragma unroll
                for (int m = m0; m < m0 + MB; ++m) {
                    const int row = row0 + ai * HALF + m * 16;
                    float ssq = 0.f;
#pragma unroll
                    for (int bj = 0; bj < 2; ++bj)
#pragma unroll
                        for (int n = 0; n < 2; ++n) {
                            const int col = col0 + bj * HALF + n * 16; const size_t off = (size_t)row * 1024 + col;
                            const f32x4 a = acc[ai][bj][m][n];
                            if constexpr (MODE == E_RET || MODE == E_ATT) {
                                const u32x2 g2 = gw[m][bj][n];
                                f32x4 gv; gv[0] = sigmoidf_(bf2f(g2.x & 0xffffu)); gv[1] = sigmoidf_(bf2f(g2.x >> 16)); gv[2] = sigmoidf_(bf2f(g2.y & 0xffffu)); gv[3] = sigmoidf_(bf2f(g2.y >> 16));
                                if constexpr (MODE == E_RET) { *(u32x2*)(t + off) = f32_to_bf4(gv * a); }
                                else { const f32x4 o = bf4_to_f32(tv[m][bj][n]) + gv * a; u32x2 w; w.x = cvt_pk_bf16(o[0], o[1]); w.y = cvt_pk_bf16(o[2], o[3]); *(u32x2*)(ob + off) = w; }
                            } else if constexpr (MODE == E_PLE) {
                                *(u32x2*)(t + off) = f32_to_bf4(a);
                            } else {
                                f32x4 x = xr ? xv[m][bj][n] : bf4_to_f32(xw[m][bj][n]);
                                if constexpr (MODE == E_GATE) { f32x4 sg; sg[0] = sigmoidf_(a[0]); sg[1] = sigmoidf_(a[1]); sg[2] = sigmoidf_(a[2]); sg[3] = sigmoidf_(a[3]); x = x + bf4_to_f32(tv[m][bj][n]) * sg; }
                                else x = x + a;
                                u32x2 w; w.x = cvt_pk_bf16(x[0], x[1]); w.y = cvt_pk_bf16(x[2], x[3]); *(u32x2*)(ob + off) = w;
                                ssq += (x[0] * x[0] + x[1] * x[1]) + (x[2] * x[2] + x[3] * x[3]);
                            }
                        }
                    if constexpr (MODE == E_RES || MODE == E_GATE) {
                        ssq += __shfl_xor(ssq, 16); ssq += __shfl_xor(ssq, 32);
                        if (fq == 0) ssp_out[(size_t)row * 16 + u.pn * 4 + wc] = ssq;
                    }
                }
            }
        }
    }
};
template <class Epi, class Sched, bool ALIGN_EPI = false, bool SP2 = false>
__device__ __forceinline__ void gemm_phase(PG8_LAS unsigned char* lds, const Gemm g, const Sched& S, const Epi& E) {
    int tid_ = threadIdx.x; asm volatile("" : "+v"(tid_));
    const int tid = tid_, wid = __builtin_amdgcn_readfirstlane(tid >> 6), lane = tid & 63, wr = wid >> 2, wc = wid & 3, fr = lane & 15, fq = lane >> 4;
    const int K = g.K, nt = K / BK;
    unsigned voffA[2], voffB[2];
#pragma unroll
    for (int i = 0; i < 2; ++i) { int R, C; stage_rc(tid * 16 + i * 8192, R, C); const int Rb = Epi::PERM ? ((R & ~31) + perm32(R & 31)) : R;
        voffA[i] = (unsigned)(R * K + C) * 2u; voffB[i] = (unsigned)(Rb * K + C) * 2u; }
    const size_t kstep = (size_t)(BK * 2);
    const size_t hstep = (size_t)HALF * K * 2;
    const size_t tstep = 2 * hstep;
    const unsigned ldsw = (unsigned)wid * 1024u;
    const int aoff = lds_byte(wr * 64 + fr, fq * 8), boff = lds_byte(wc * 32 + fr, fq * 8);
#define PG8_SA(b, h) (((b) * 2 + (h)) * HTB)
#define PG8_SB(b, h) ((4 + (b) * 2 + (h)) * HTB)
#define PG8_STAGE(bufoff, gbase, voff) do { _Pragma("unroll") for (int _i = 0; _i < 2; ++_i) \
        __builtin_amdgcn_global_load_lds((const unsigned*)((const char*)(gbase) + (voff)[_i]), (PG8_LAS unsigned*)(lds + (bufoff) + ldsw + _i * 8192), 16, 0, 0); } while (0)
#define PG8_LDA(dst, b, h) do { _Pragma("unroll") for (int m = 0; m < 4; ++m) _Pragma("unroll") for (int k = 0; k < 2; ++k) dst[m][k] = *(const PG8_LAS bf16x8*)(lds + PG8_SA(b, h) + aoff + m * 2048 + k * 1024); } while (0)
#define PG8_LDB(dst, b, h) do { _Pragma("unroll") for (int n = 0; n < 2; ++n) _Pragma("unroll") for (int k = 0; k < 2; ++k) dst[n][k] = *(const PG8_LAS bf16x8*)(lds + PG8_SB(b, h) + boff + n * 2048 + k * 1024); } while (0)
#define PG8_MMA(ai, bj, At, Bt) do { __builtin_amdgcn_s_setprio(1); _Pragma("unroll") for (int m = 0; m < 4; ++m) _Pragma("unroll") for (int n = 0; n < 2; ++n) _Pragma("unroll") for (int k = 0; k < 2; ++k) \
        acc[ai][bj][m][n] = __builtin_amdgcn_mfma_f32_16x16x32_bf16(Bt[n][k], At[m][k], acc[ai][bj][m][n], 0, 0, 0); __builtin_amdgcn_s_setprio(0); } while (0)
#define PG8_WAIT_V(n) asm volatile("s_waitcnt vmcnt(" #n ")" ::: "memory")
#define PG8_WAIT_L(n) asm volatile("s_waitcnt lgkmcnt(" #n ")" ::: "memory")
#define PG8_BAR __builtin_amdgcn_s_barrier()
#define PG8_SCHED __builtin_amdgcn_sched_barrier(0)
    Unit cur, nxt; int ui = 0;
    if (!S.next(0, cur)) return;
    f32x4 acc[2][2][4][2];
#pragma unroll
    for (int a = 0; a < 2; ++a)
#pragma unroll
        for (int b = 0; b < 2; ++b)
#pragma unroll
            for (int m = 0; m < 4; ++m)
#pragma unroll
                for (int n = 0; n < 2; ++n) acc[a][b][m][n] = (f32x4){0.f, 0.f, 0.f, 0.f};
    bf16x8 At[4][2], B0[2][2], B1[2][2];
    const char* cA = (const char*)g.A + (size_t)cur.pm * tstep; const char* cB = (const char*)g.Bt + (size_t)cur.pn * tstep;
    S.a_ready(cur);
    if constexpr (SP2) {
        PG8_STAGE(PG8_SB(0, 0), cB, voffB); PG8_STAGE(PG8_SB(0, 1), cB + hstep, voffB); PG8_STAGE(PG8_SA(0, 0), cA, voffA); PG8_STAGE(PG8_SA(0, 1), cA + hstep, voffA);
        if (wr == 1) PG8_BAR;
        PG8_WAIT_V(2); PG8_BAR;
        PG8_STAGE(PG8_SB(1, 0), cB + kstep, voffB); PG8_STAGE(PG8_SA(1, 0), cA + kstep, voffA); PG8_STAGE(PG8_SB(1, 1), cB + hstep + kstep, voffB);
        PG8_WAIT_V(6); PG8_BAR;
    } else {
        PG8_STAGE(PG8_SB(0, 0), cB, voffB); PG8_STAGE(PG8_SA(0, 0), cA, voffA); PG8_STAGE(PG8_SB(0, 1), cB + hstep, voffB); PG8_STAGE(PG8_SA(0, 1), cA + hstep, voffA);
        if (wr == 1) PG8_BAR;
        PG8_WAIT_V(4); PG8_BAR;
        PG8_STAGE(PG8_SB(1, 0), cB + kstep, voffB); PG8_STAGE(PG8_SA(1, 0), cA + kstep, voffA); PG8_STAGE(PG8_SB(1, 1), cB + hstep + kstep, voffB);
        PG8_WAIT_V(6); PG8_BAR;
    }
    for (;;) {
        const bool has_next = S.next(ui + 1, nxt);
        const char* nA = has_next ? (const char*)g.A + (size_t)nxt.pm * tstep : cA; const char* nB = has_next ? (const char*)g.Bt + (size_t)nxt.pn * tstep : cB;
        for (int t = 0; t < nt; t += 2) {
            const bool last = (t == nt - 2);
            const char* a1 = cA + (size_t)(t + 1) * kstep;
            const char* a2 = last ? nA : cA + (size_t)(t + 2) * kstep; const char* b2 = last ? nB : cB + (size_t)(t + 2) * kstep;
            const char* a3 = a2 + kstep; const char* b3 = b2 + kstep;
            if (last && has_next) S.a_ready(nxt);
            if constexpr (SP2) {
            PG8_LDB(B0, 0, 0); PG8_LDB(B1, 0, 1); PG8_SCHED; PG8_LDA(At, 0, 0); PG8_STAGE(PG8_SA(1, 1), a1 + hstep, voffA);
            PG8_WAIT_V(8); PG8_WAIT_L(0); PG8_BAR; PG8_MMA(0, 0, At, B0); PG8_MMA(0, 1, At, B1); PG8_BAR; PG8_SCHED;
            PG8_LDA(At, 0, 1); PG8_STAGE(PG8_SB(0, 0), b2, voffB); PG8_STAGE(PG8_SB(0, 1), b2 + hstep, voffB); PG8_STAGE(PG8_SA(0, 0), a2, voffA);
            PG8_WAIT_V(8); PG8_WAIT_L(0); PG8_BAR; PG8_MMA(1, 0, At, B0); PG8_MMA(1, 1, At, B1); PG8_BAR; PG8_SCHED;
            PG8_LDB(B0, 1, 0); PG8_LDB(B1, 1, 1); PG8_SCHED; PG8_LDA(At, 1, 0); PG8_STAGE(PG8_SA(0, 1), a2 + hstep, voffA);
            PG8_WAIT_V(8); PG8_WAIT_L(0); PG8_BAR; PG8_MMA(0, 0, At, B0); PG8_MMA(0, 1, At, B1); PG8_BAR; PG8_SCHED;
            PG8_LDA(At, 1, 1); PG8_STAGE(PG8_SB(1, 0), b3, voffB); PG8_STAGE(PG8_SB(1, 1), b3 + hstep, voffB); PG8_STAGE(PG8_SA(1, 0), a3, voffA);
            PG8_WAIT_V(8); PG8_WAIT_L(0); PG8_BAR; PG8_MMA(1, 0, At, B0); PG8_MMA(1, 1, At, B1); PG8_BAR; PG8_SCHED;
            } else {
            PG8_LDB(B0, 0, 0); PG8_SCHED; PG8_LDA(At, 0, 0); PG8_STAGE(PG8_SA(1, 1), a1 + hstep, voffA);
            PG8_WAIT_L(8); PG8_BAR; PG8_WAIT_L(0); PG8_MMA(0, 0, At, B0); PG8_BAR; PG8_SCHED;
            PG8_LDB(B1, 0, 1); PG8_STAGE(PG8_SB(0, 0), b2, voffB);
            PG8_BAR; PG8_WAIT_L(0); PG8_MMA(0, 1, At, B1); PG8_BAR;
            PG8_LDA(At, 0, 1); PG8_STAGE(PG8_SA(0, 0), a2, voffA);
            PG8_BAR; PG8_WAIT_L(0); PG8_MMA(1, 0, At, B0); PG8_BAR; PG8_SCHED;
            PG8_STAGE(PG8_SB(0, 1), b2 + hstep, voffB);
            PG8_WAIT_V(6); PG8_BAR; PG8_MMA(1, 1, At, B1); PG8_BAR;
            PG8_LDB(B0, 1, 0); PG8_SCHED; PG8_LDA(At, 1, 0); PG8_STAGE(PG8_SA(0, 1), a2 + hstep, voffA);
            PG8_WAIT_L(8); PG8_BAR; PG8_WAIT_L(0); PG8_MMA(0, 0, At, B0); PG8_BAR; PG8_SCHED;
            PG8_LDB(B1, 1, 1); PG8_STAGE(PG8_SB(1, 0), b3, voffB);
            PG8_BAR; PG8_WAIT_L(0); PG8_MMA(0, 1, At, B1); PG8_BAR;
            PG8_LDA(At, 1, 1); PG8_STAGE(PG8_SA(1, 0), a3, voffA);
            PG8_BAR; PG8_WAIT_L(0); PG8_MMA(1, 0, At, B0); PG8_BAR; PG8_SCHED;
            PG8_STAGE(PG8_SB(1, 1), b3 + hstep, voffB);
            PG8_WAIT_V(6); PG8_BAR; PG8_MMA(1, 1, At, B1); PG8_BAR;
            }
        }
        if constexpr (ALIGN_EPI) { if (wr == 0) PG8_BAR; }
        if constexpr (!Epi::AFTER_DRAIN) { E(acc, cur, wr, wc, fr, fq); S.done(cur); }
        if (!has_next) break;
#pragma unroll
        for (int a = 0; a < 2; ++a)
#pragma unroll
            for (int b = 0; b < 2; ++b)
#pragma unroll
                for (int m = 0; m < 4; ++m)
#pragma unroll
                    for (int n = 0; n < 2; ++n) acc[a][b][m][n] = (f32x4){0.f, 0.f, 0.f, 0.f};
        cur = nxt; cA = nA; cB = nB; ++ui;
        if constexpr (ALIGN_EPI) { if (wr == 1) PG8_BAR; }
    }
    PG8_WAIT_V(0);
    if constexpr (!ALIGN_EPI) { if (wr == 0) PG8_BAR; }
    PG8_BAR;
    if constexpr (Epi::AFTER_DRAIN) { E.fused(acc, cur, wr, wc, fr, fq, lds, wid, lane); S.done(cur); }
#undef PG8_SA
#undef PG8_SB
#undef PG8_STAGE
#undef PG8_LDA
#undef PG8_LDB
#undef PG8_MMA
#undef PG8_WAIT_V
#undef PG8_WAIT_L
#undef PG8_BAR
#undef PG8_SCHED
}
}

#define LAS __attribute__((address_space(3)))
typedef unsigned short bf16_t;
typedef short bf16x8 __attribute__((ext_vector_type(8)));
typedef short v4i16_t __attribute__((ext_vector_type(4)));
typedef float f32x4 __attribute__((ext_vector_type(4)));
typedef float f32x2 __attribute__((ext_vector_type(2)));
typedef unsigned u32x4 __attribute__((ext_vector_type(4)));
typedef unsigned u32x2 __attribute__((ext_vector_type(2)));

constexpr int MP = 16384, MS = 256, MT = MP + MS;
constexpr int DM = 1024, DIN = 9728, DFF = 4096, DPLE = 256, SEQ = 8192;
constexpr int Z_RQ = 0, Z_RK = 512, Z_RV = 1024, Z_RG = 2048, Z_AQ = 3072, Z_AK = 4608, Z_AV = 6144, Z_GA = 7680, Z_GB = 8704;
constexpr int LDS_BYTES = 147456;
constexpr float QK_SCALE = 0.08838834764831845f;

constexpr size_t WT_IN = 0, WT_RET = WT_IN + (size_t)DIN * DM * 2, WT_ATT = WT_RET + (size_t)DM * DM * 2, WT_OUT = WT_ATT + (size_t)DM * 512 * 2,
                 WT_UP = WT_OUT + (size_t)DM * DM * 2, WT_DOWN = WT_UP + (size_t)DFF * DM * 2, WT_PLE = WT_DOWN + (size_t)DFF * DM * 2,
                 WT_GATE = WT_PLE + (size_t)DM * DPLE * 2, WT_LAYER = WT_GATE + (size_t)DM * DM * 2;
constexpr size_t WS_WT = 0;
constexpr size_t WS_XF = WS_WT + 2 * WT_LAYER;
constexpr size_t WS_XBA = WS_XF + (size_t)MT * DM * 4;
constexpr size_t WS_XBB = WS_XBA + (size_t)MT * DM * 2;
constexpr size_t WS_SSP = WS_XBB + (size_t)MT * DM * 2;
constexpr size_t WS_PB = WS_SSP + (size_t)MT * 16 * 4;
constexpr size_t WS_Z = WS_PB + (size_t)2 * MT * DPLE * 2;
constexpr size_t WS_ORET = WS_Z + (size_t)MT * DIN * 2;
constexpr size_t WS_OATT = WS_ORET + (size_t)MT * DM * 2;
constexpr size_t WS_MERGED = WS_OATT + (size_t)MT * 512 * 2;
constexpr size_t WS_T = WS_MERGED + (size_t)MT * DM * 2;
constexpr size_t WS_OG = WS_T + (size_t)MT * DM * 4;
constexpr size_t WS_LSE = WS_OG + (size_t)3 * MT * 512 * 4;
constexpr size_t WS_U = WS_LSE + (size_t)3 * MT * 4 * 4;
constexpr size_t WS_RP = WS_U + (size_t)512 * 32768 * 4;
constexpr size_t WS_CTL = WS_RP + (size_t)512 * 32768 * 2;
constexpr size_t WS_END = WS_CTL + 16384;

constexpr size_t O_Y = 0;
constexpr size_t O_PWK0 = (size_t)MT * DM, O_PWV0 = O_PWK0 + 262144, O_PWK1 = O_PWV0 + 262144, O_PWV1 = O_PWK1 + 1048576, O_PWK2 = O_PWV1 + 1048576, O_PWV2 = O_PWK2 + 4194304;
constexpr size_t O_PRET = O_PWV2 + 4194304;
constexpr size_t O_SWK0 = O_PRET + 524288, O_SWV0 = O_SWK0 + 4194304, O_SWK1 = O_SWV0 + 4194304, O_SWV1 = O_SWK1 + 16777216, O_SWK2 = O_SWV1 + 16777216, O_SWV2 = O_SWK2 + 67108864;
constexpr size_t O_SRET = O_SWV2 + 67108864;
constexpr size_t O_END = O_SRET + 8388608;

struct Args { const float* in[22]; float* out; unsigned char* ws; };

__device__ __forceinline__ unsigned f2bf(float f) { unsigned u = __builtin_bit_cast(unsigned, f); return (u + 0x7fffu + ((u >> 16) & 1u)) >> 16; }
__device__ __forceinline__ unsigned pk2(float lo, float hi) { return f2bf(lo) | (f2bf(hi) << 16); }
__device__ __forceinline__ float bflo(unsigned w) { return __uint_as_float(w << 16); }
__device__ __forceinline__ float bfhi(unsigned w) { return __uint_as_float(w & 0xffff0000u); }
__device__ __forceinline__ float wave_sum(float v) {
#pragma unroll
    for (int o = 1; o < 64; o <<= 1) v += __shfl_xor(v, o);
    return v;
}
__device__ __forceinline__ float ret_lg(int h) { const float A = -3.4657359028f, B = -6.2383246250f; return log1pf(-expf(A + (B - A) * (float)h * (1.0f / 3.0f))); }
__device__ __forceinline__ v4i16_t tr4(LAS const unsigned char* p) { return __builtin_amdgcn_ds_read_tr16_b64_v4i16((LAS v4i16_t*)p); }
__device__ __forceinline__ bf16x8 cat8(v4i16_t a, v4i16_t b) { return __builtin_shufflevector(a, b, 0, 1, 2, 3, 4, 5, 6, 7); }
#define MFMA16(a, b, c) __builtin_amdgcn_mfma_f32_16x16x32_bf16((a), (b), (c), 0, 0, 0)

__device__ __forceinline__ void p0_transpose_item(const float* __restrict__ W, int K, int N, bf16_t* __restrict__ WT, const float* __restrict__ gain, bool is_in, LAS float* scr, int item, int lane) {
    const int nblk = N / 64, kb = item / nblk, nb = item % nblk, k0 = 64 * kb, n0 = 64 * nb;
    const int kr = lane >> 4, nc = 4 * (lane & 15);
#pragma unroll 8
    for (int i = 0; i < 16; ++i) { const int kk = 4 * i + kr; f32x4 v = *(const f32x4*)(W + (size_t)(k0 + kk) * N + n0 + nc); if (gain) v = v * gain[k0 + kk];
        LAS float* d = scr + kk * 65 + nc; d[0] = v[0]; d[1] = v[1]; d[2] = v[2]; d[3] = v[3]; }
    asm volatile("s_waitcnt lgkmcnt(0)" ::: "memory");
    const int c = lane & 7;
#pragma unroll
    for (int j = 0; j < 8; ++j) { const int n = (lane >> 3) + 8 * j; const LAS float* s = scr + (8 * c) * 65 + n; const int ng = n0 + n;
        const float sc = (is_in && ((ng >= Z_RK && ng < Z_RV) || (ng >= Z_AQ && ng < Z_AK))) ? QK_SCALE : 1.0f;
        u32x4 o; o.x = pk2(s[0 * 65] * sc, s[1 * 65] * sc); o.y = pk2(s[2 * 65] * sc, s[3 * 65] * sc); o.z = pk2(s[4 * 65] * sc, s[5 * 65] * sc); o.w = pk2(s[6 * 65] * sc, s[7 * 65] * sc);
        *(u32x4*)(WT + (size_t)ng * K + k0 + 8 * c) = o; }
    asm volatile("s_waitcnt lgkmcnt(0)" ::: "memory");
}

__device__ __forceinline__ void p0_prologue(const Args& a, LAS unsigned char* lds, int tid) {
    const int lane = tid & 63, wave = tid >> 6;
    const int gw = blockIdx.x * 8 + wave, NGW = gridDim.x * 8;
    LAS float* scr = (LAS float*)(lds + wave * 16640);
    constexpr int I_IN = 16 * 152, I_RET = 16 * 16, I_ATT = 8 * 16, I_OUT = 16 * 16, I_UP = 16 * 64, I_DOWN = 64 * 16, I_PLE = 4 * 16, I_GATE = 16 * 16;
    constexpr int I_LAYER = I_IN + I_RET + I_ATT + I_OUT + I_UP + I_DOWN + I_PLE + I_GATE;
    for (int it = gw; it < 2 * I_LAYER; it += NGW) {
        const int l = it / I_LAYER; int r = it % I_LAYER;
        unsigned char* wl = a.ws + WS_WT + (size_t)l * WT_LAYER;
        if (r < I_IN) { p0_transpose_item(a.in[12] + (size_t)l * DM * DIN, DM, DIN, (bf16_t*)(wl + WT_IN), a.in[11] + l * DM, true, scr, r, lane); continue; } r -= I_IN;
        if (r < I_RET) { p0_transpose_item(a.in[13] + (size_t)l * DM * DM, DM, DM, (bf16_t*)(wl + WT_RET), nullptr, false, scr, r, lane); continue; } r -= I_RET;
        if (r < I_ATT) { p0_transpose_item(a.in[14] + (size_t)l * 512 * DM, 512, DM, (bf16_t*)(wl + WT_ATT), nullptr, false, scr, r, lane); continue; } r -= I_ATT;
        if (r < I_OUT) { p0_transpose_item(a.in[15] + (size_t)l * DM * DM, DM, DM, (bf16_t*)(wl + WT_OUT), nullptr, false, scr, r, lane); continue; } r -= I_OUT;
        if (r < I_UP) { p0_transpose_item(a.in[17] + (size_t)l * DM * DFF, DM, DFF, (bf16_t*)(wl + WT_UP), a.in[16] + l * DM, false, scr, r, lane); continue; } r -= I_UP;
        if (r < I_DOWN) { p0_transpose_item(a.in[18] + (size_t)l * DFF * DM, DFF, DM, (bf16_t*)(wl + WT_DOWN), nullptr, false, scr, r, lane); continue; } r -= I_DOWN;
        if (r < I_PLE) { p0_transpose_item(a.in[19] + (size_t)l * DPLE * DM, DPLE, DM, (bf16_t*)(wl + WT_PLE), nullptr, false, scr, r, lane); continue; } r -= I_PLE;
        p0_transpose_item(a.in[20] + (size_t)l * DM * DM, DM, DM, (bf16_t*)(wl + WT_GATE), nullptr, false, scr, r, lane);
    }
    bf16_t* xb = (bf16_t*)(a.ws + WS_XBA); float* ssp = (float*)(a.ws + WS_SSP);
    for (int m = gw; m < MT; m += NGW) {
        const float* src = (m < MP) ? a.in[0] + (size_t)m * DM : a.in[1] + (size_t)(m - MP) * DM;
        f32x4 v[4]; float s = 0.f;
#pragma unroll
        for (int j = 0; j < 4; ++j) { v[j] = *(const f32x4*)(src + 4 * lane + 256 * j); s += (v[j][0] * v[j][0] + v[j][1] * v[j][1]) + (v[j][2] * v[j][2] + v[j][3] * v[j][3]); }
        s = wave_sum(s);
#pragma unroll
        for (int j = 0; j < 4; ++j) { u32x2 w; w.x = pk2(v[j][0], v[j][1]); w.y = pk2(v[j][2], v[j][3]); *(u32x2*)(xb + (size_t)m * DM + 4 * lane + 256 * j) = w; }
        if (lane < 16) ssp[(size_t)m * 16 + lane] = (lane == 0) ? s : 0.f;
    }
    bf16_t* pb = (bf16_t*)(a.ws + WS_PB);
    for (int q = gw; q < 2 * MT; q += NGW) {
        const int l = q / MT, m = q % MT;
        const float* src = (m < MP) ? a.in[9] + ((size_t)l * MP + m) * DPLE : a.in[10] + ((size_t)l * MS + (m - MP)) * DPLE;
        const f32x4 v = *(const f32x4*)(src + 4 * lane);
        u32x2 w; w.x = pk2(v[0], v[1]); w.y = pk2(v[2], v[3]); *(u32x2*)(pb + (size_t)q * DPLE + 4 * lane) = w;
    }
}

constexpr size_t CC_TOTAL = 2 * 64 * 128 * (size_t)(120 + 504 + 2040);
__device__ __forceinline__ void cache_copy_range(const Args& a, size_t q0, size_t q1, int tid) {
    size_t base = 0;
#pragma unroll 1
    for (int kvg = 0; kvg < 6; ++kvg) {
        const int g = kvg >> 1, W = 128 << (2 * g);
        const size_t per = (size_t)(W - 8) * 128, n = 64 * per, full = (size_t)W * 128;
        const size_t lo = q0 > base ? q0 : base, hi = q1 < base + n ? q1 : base + n;
        if (lo < hi) {
            const f32x4* src = (const f32x4*)a.in[2 + kvg];
            const size_t ooff = (kvg == 0) ? O_SWK0 : (kvg == 1) ? O_SWV0 : (kvg == 2) ? O_SWK1 : (kvg == 3) ? O_SWV1 : (kvg == 4) ? O_SWK2 : O_SWV2;
            f32x4* dst = (f32x4*)(a.out + ooff);
            size_t p = lo - base; const size_t pe = hi - base;
#pragma unroll 1
            while (p < pe) {
                const size_t lb = p / per, rem = p - lb * per;
                const size_t c0 = per - rem, c1 = pe - p, cnt = c0 < c1 ? c0 : c1;
                const f32x4* s = src + lb * full + 1024 + rem; f32x4* d = dst + lb * full + rem;
#pragma unroll 1
                for (size_t i = tid; i < cnt; i += 512 * 16) {
                    f32x4 v[16];
#pragma unroll
                    for (int k = 0; k < 16; ++k) if (i + k * 512 < cnt) v[k] = __builtin_nontemporal_load(s + i + k * 512);
#pragma unroll
                    for (int k = 0; k < 16; ++k) if (i + k * 512 < cnt) __builtin_nontemporal_store(v[k], d + i + k * 512);
                }
                p += cnt;
            }
        }
        base += n;
    }
}
__device__ __forceinline__ void cache_copy_tail(const Args& a, int nwg, int f0, int f1, int tid) {
    const int G = gridDim.x, fi = nwg % G, c = blockIdx.x;
    if (c < fi) return;
    const size_t R0 = CC_TOTAL * (size_t)f0 / 1000, R1 = CC_TOTAL * (size_t)f1 / 1000, nidle = (size_t)(G - fi), idx = (size_t)(c - fi);
    cache_copy_range(a, R0 + (R1 - R0) * idx / nidle, R0 + (R1 - R0) * (idx + 1) / nidle, tid);
}

constexpr int KVS = 272;
constexpr int AT_VOFF = 256 * KVS;
__device__ __forceinline__ void attn_prompt_item(LAS unsigned char* lds, const bf16_t* __restrict__ z, bf16_t* __restrict__ og, float* __restrict__ lse, int item, int tid) {
    const int wid = __builtin_amdgcn_readfirstlane(tid >> 6), lane = tid & 63, fr = lane & 15, quad = lane >> 4;
    const int blk = item & 63; int rest = item >> 6; const int j = rest & 3; rest >>= 2; const int g = rest % 3, b = rest / 3;
    const int dsh = 2 * g, dil = 1 << dsh, r = blk >> (6 - dsh), qb = blk & ((64 >> dsh) - 1), hh = g * 4 + j;
    const float slope_d = exp2f(-8.0f * (float)(hh + 1) / 12.0f) * (float)dil;
    const bf16_t* zb = z + (size_t)b * SEQ * DIN;
#pragma unroll
    for (int it = 0; it < 8; ++it) {
        const int idx = tid + it * 512, kk = idx >> 4, ch = idx & 15, sp = 128 * qb - 128 + kk;
        u32x4 kv = {0u, 0u, 0u, 0u}, vv = {0u, 0u, 0u, 0u};
        if (sp >= 0) { const bf16_t* zr = zb + (size_t)(sp * dil + r) * DIN + hh * 128 + ch * 8; kv = *(const u32x4*)(zr + Z_AK); vv = *(const u32x4*)(zr + Z_AV); }
        *(LAS u32x4*)(lds + kk * KVS + ch * 16) = kv; *(LAS u32x4*)(lds + AT_VOFF + kk * KVS + ch * 16) = vv;
    }
    const int sq = 128 * qb + 16 * wid + fr;
    const size_t qrow = (size_t)b * SEQ + (size_t)(sq * dil + r);
    bf16x8 qf[4];
#pragma unroll
    for (int ks = 0; ks < 4; ++ks) qf[ks] = *(const bf16x8*)(z + qrow * DIN + Z_AQ + hh * 128 + ks * 32 + quad * 8);
    __syncthreads();
    f32x4 sc[9];
#pragma unroll
    for (int kt = 0; kt < 9; ++kt) {
        f32x4 acc = {0.f, 0.f, 0.f, 0.f};
#pragma unroll
        for (int ks = 0; ks < 4; ++ks) { const bf16x8 ka = *(LAS const bf16x8*)(lds + (16 * (wid + kt) + fr) * KVS + ks * 64 + quad * 16); acc = MFMA16(ka, qf[ks], acc); }
        sc[kt] = acc;
    }
    float mx = -INFINITY;
#pragma unroll
    for (int kt = 0; kt < 9; ++kt)
#pragma unroll
        for (int e = 0; e < 4; ++e) {
            const int dist = 128 - 16 * kt + fr - 4 * quad - e, keyrel = 16 * (wid + kt) + 4 * quad + e;
            const bool valid = (dist >= 0) && (dist <= 128) && (qb > 0 || keyrel >= 128);
            const float s = valid ? sc[kt][e] - slope_d * (float)dist : -INFINITY;
            sc[kt][e] = s; mx = fmaxf(mx, s);
        }
    mx = fmaxf(mx, __shfl_xor(mx, 16)); mx = fmaxf(mx, __shfl_xor(mx, 32));
    float den = 0.f;
#pragma unroll
    for (int kt = 0; kt < 9; ++kt)
#pragma unroll
        for (int e = 0; e < 4; ++e) { const float p = __expf(sc[kt][e] - mx); sc[kt][e] = p; den += p; }
    den += __shfl_xor(den, 16); den += __shfl_xor(den, 32);
    const float inv = 1.0f / den;
    f32x4 o[8];
#pragma unroll
    for (int dt = 0; dt < 8; ++dt) o[dt] = (f32x4){0.f, 0.f, 0.f, 0.f};
#pragma unroll
    for (int kp = 0; kp < 5; ++kp) {
        const int TA = wid + 2 * kp, TB = (2 * kp + 1 < 9) ? TA + 1 : TA;
        u32x4 pw; pw.x = pk2(sc[2 * kp][0] * inv, sc[2 * kp][1] * inv); pw.y = pk2(sc[2 * kp][2] * inv, sc[2 * kp][3] * inv);
        if (2 * kp + 1 < 9) { pw.z = pk2(sc[(2 * kp + 1) % 9][0] * inv, sc[(2 * kp + 1) % 9][1] * inv); pw.w = pk2(sc[(2 * kp + 1) % 9][2] * inv, sc[(2 * kp + 1) % 9][3] * inv); } else { pw.z = 0u; pw.w = 0u; }
        const bf16x8 p8 = __builtin_bit_cast(bf16x8, pw);
        LAS const unsigned char* bA = lds + AT_VOFF + (16 * TA + 4 * quad + (fr >> 2)) * KVS + (fr & 3) * 8;
        LAS const unsigned char* bB = lds + AT_VOFF + (16 * TB + 4 * quad + (fr >> 2)) * KVS + (fr & 3) * 8;
#pragma unroll
        for (int dt = 0; dt < 8; ++dt) { const v4i16_t va = tr4(bA + dt * 32), vb = tr4(bB + dt * 32); o[dt] = MFMA16(cat8(va, vb), p8, o[dt]); }
    }
    bf16_t* orow = og + ((size_t)g * MT + qrow) * 512 + j * 128 + 4 * quad;
#pragma unroll
    for (int dt = 0; dt < 8; ++dt) { u32x2 w; w.x = pk2(o[dt][0], o[dt][1]); w.y = pk2(o[dt][2], o[dt][3]); *(u32x2*)(orow + 16 * dt) = w; }
    if (quad == 0) lse[((size_t)g * MT + qrow) * 4 + j] = mx + __logf(den);
    __syncthreads();
}

constexpr int RVS = 528;
constexpr int RU_VOFF = 128 * KVS;
__device__ __forceinline__ void ret_u_item(LAS unsigned char* lds, const bf16_t* __restrict__ z, bf16_t* __restrict__ U, int item, int tid) {
    const int wid = __builtin_amdgcn_readfirstlane(tid >> 6), lane = tid & 63, fr = lane & 15, quad = lane >> 4;
    const int c = item & 63, bh = item >> 6, h = bh & 3, b = bh >> 2;
    const float lg = ret_lg(h);
    const bf16_t* z0 = z + ((size_t)b * SEQ + 128 * c) * DIN;
#pragma unroll
    for (int it = 0; it < 4; ++it) {
        const int idx = tid + it * 512, jj = idx >> 4, ch = idx & 15;
        const u32x4 kv = *(const u32x4*)(z0 + (size_t)jj * DIN + Z_RK + h * 128 + ch * 8);
        const float zeta = __expf(lg * (float)(127 - jj));
        u32x4 o; o.x = pk2(bflo(kv.x) * zeta, bfhi(kv.x) * zeta); o.y = pk2(bflo(kv.y) * zeta, bfhi(kv.y) * zeta); o.z = pk2(bflo(kv.z) * zeta, bfhi(kv.z) * zeta); o.w = pk2(bflo(kv.w) * zeta, bfhi(kv.w) * zeta);
        *(LAS u32x4*)(lds + jj * KVS + ch * 16) = o;
    }
#pragma unroll
    for (int it = 0; it < 8; ++it) {
        const int idx = tid + it * 512, jj = idx >> 5, ch = idx & 31;
        *(LAS u32x4*)(lds + RU_VOFF + jj * RVS + ch * 16) = *(const u32x4*)(z0 + (size_t)jj * DIN + Z_RV + h * 256 + ch * 8);
    }
    __syncthreads();
    f32x4 acc[2][8];
#pragma unroll
    for (int a = 0; a < 2; ++a)
#pragma unroll
        for (int d = 0; d < 8; ++d) acc[a][d] = (f32x4){0.f, 0.f, 0.f, 0.f};
#pragma unroll
    for (int ks = 0; ks < 4; ++ks) {
        const int jrow = 32 * ks + 8 * quad + (fr >> 2);
        bf16x8 A[2];
#pragma unroll
        for (int a = 0; a < 2; ++a) { LAS const unsigned char* p = lds + RU_VOFF + jrow * RVS + (16 * (2 * wid + a) + 4 * (fr & 3)) * 2; A[a] = cat8(tr4(p), tr4(p + 4 * RVS)); }
#pragma unroll
        for (int d = 0; d < 8; ++d) { LAS const unsigned char* p = lds + jrow * KVS + (16 * d + 4 * (fr & 3)) * 2; const bf16x8 B = cat8(tr4(p), tr4(p + 4 * KVS));
            acc[0][d] = MFMA16(B, A[0], acc[0][d]); acc[1][d] = MFMA16(B, A[1], acc[1][d]); }
    }
    bf16_t* Uo = U + (size_t)item * 32768;
#pragma unroll
    for (int a = 0; a < 2; ++a)
#pragma unroll
        for (int d = 0; d < 8; ++d) { u32x2 w; w.x = pk2(acc[a][d][0], acc[a][d][1]); w.y = pk2(acc[a][d][2], acc[a][d][3]); *(u32x2*)(Uo + (16 * (2 * wid + a) + fr) * 128 + 16 * d + 4 * quad) = w; }
    __syncthreads();
}

__device__ __forceinline__ void ret_sample_item(LAS unsigned char* lds, const bf16_t* __restrict__ z, const float* __restrict__ S0, float* __restrict__ Sout, bf16_t* __restrict__ oret, int item, int tid) {
    const int h = item & 3, b = item >> 2;
    const int lane = tid & 63, wave = tid >> 6;
    const float lg = ret_lg(h);
    LAS float* qs = (LAS float*)lds;
    LAS float* ksm = qs + 1024;
    LAS float* Pm = ksm + 1024;
    LAS float* red = Pm + 64;
    LAS float* ob = red + 4096;
    const bf16_t* z0 = z + (size_t)(MP + b * 8) * DIN;
    for (int idx = tid; idx < 1024; idx += 512) { const int i = idx >> 7, d = idx & 127; qs[idx] = __uint_as_float((unsigned)z0[(size_t)i * DIN + Z_RQ + h * 128 + d] << 16); ksm[idx] = __uint_as_float((unsigned)z0[(size_t)i * DIN + Z_RK + h * 128 + d] << 16); }
    const int v = tid & 255, half = tid >> 8;
    float vv[8], vz[8];
#pragma unroll
    for (int jj = 0; jj < 8; ++jj) { vv[jj] = __uint_as_float((unsigned)z0[(size_t)jj * DIN + Z_RV + h * 256 + v] << 16); vz[jj] = vv[jj] * __expf(lg * (float)(7 - jj)); }
    __syncthreads();
    if (tid < 64) { const int i = tid >> 3, jj = tid & 7; float s = 0.f; for (int d = 0; d < 128; ++d) s += qs[i * 128 + d] * ksm[jj * 128 + d]; Pm[tid] = (jj <= i) ? s * __expf(lg * (float)(i - jj)) : 0.f; }
    const float cd = __expf(lg * 8.0f);
    float cr[8];
#pragma unroll
    for (int i = 0; i < 8; ++i) cr[i] = 0.f;
    const float* Sp = S0 + (size_t)item * 32768 + v; float* So = Sout + (size_t)item * 32768 + v;
#pragma unroll 16
    for (int dd = 0; dd < 64; ++dd) {
        const int d = half * 64 + dd;
        const float s = Sp[(size_t)d * 256];
        float nw = cd * s;
#pragma unroll
        for (int i = 0; i < 8; ++i) { cr[i] += qs[i * 128 + d] * s; nw += ksm[i * 128 + d] * vz[i]; }
        So[(size_t)d * 256] = nw;
    }
#pragma unroll
    for (int i = 0; i < 8; ++i) red[(half * 8 + i) * 256 + v] = cr[i];
    __syncthreads();
#pragma unroll
    for (int ii = 0; ii < 4; ++ii) {
        const int i = half * 4 + ii;
        float o = (red[i * 256 + v] + red[(8 + i) * 256 + v]) * __expf(lg * (float)(i + 1));
#pragma unroll
        for (int jj = 0; jj < 8; ++jj) o += Pm[i * 8 + jj] * vv[jj];
        ob[i * 256 + v] = o;
    }
    __syncthreads();
    {
        const int i = wave; float x[4]; float s = 0.f;
#pragma unroll
        for (int e = 0; e < 4; ++e) { x[e] = ob[i * 256 + 4 * lane + e]; s += x[e]; }
        const float mu = wave_sum(s) * (1.0f / 256.0f); float q = 0.f;
#pragma unroll
        for (int e = 0; e < 4; ++e) { x[e] -= mu; q += x[e] * x[e]; }
        const float rstd = 1.0f / sqrtf(wave_sum(q) * (1.0f / 256.0f) + 1e-6f);
        const u32x2 gw = *(const u32x2*)(z0 + (size_t)i * DIN + Z_RG + h * 256 + 4 * lane);
        float gq[4] = {bflo(gw.x), bfhi(gw.x), bflo(gw.y), bfhi(gw.y)};
#pragma unroll
        for (int e = 0; e < 4; ++e) x[e] = x[e] * rstd * gq[e] / (1.0f + __expf(-gq[e]));
        u32x2 w; w.x = pk2(x[0], x[1]); w.y = pk2(x[2], x[3]);
        *(u32x2*)(oret + (size_t)(MP + b * 8 + i) * DM + h * 256 + 4 * lane) = w;
    }
    __syncthreads();
}

__device__ __forceinline__ void attn_sample_item(LAS unsigned char* lds, const bf16_t* __restrict__ z, const float* __restrict__ ck, const float* __restrict__ cv, int l, bf16_t* __restrict__ og, float* __restrict__ lse, int item, int tid) {
    const int j = item & 3; int rest = item >> 2; const int g = rest % 3, b = rest / 3;
    const int lane = tid & 63, i = tid >> 6, dsh = 2 * g, dil = 1 << dsh, W = 128 << dsh, hh = g * 4 + j;
    const float slope_d = exp2f(-8.0f * (float)(hh + 1) / 12.0f) * (float)dil;
    LAS float* sc = (LAS float*)lds + i * 136;
    const size_t zrow = (size_t)MP + b * 8 + i;
    const bf16_t* zq = z + zrow * DIN + Z_AQ + hh * 128;
    const int c16 = lane & 15, rr = lane >> 4;
    float q[8];
    { const u32x2 a0 = *(const u32x2*)(zq + 4 * c16), a1 = *(const u32x2*)(zq + 64 + 4 * c16);
      q[0] = bflo(a0.x); q[1] = bfhi(a0.x); q[2] = bflo(a0.y); q[3] = bfhi(a0.y); q[4] = bflo(a1.x); q[5] = bfhi(a1.x); q[6] = bflo(a1.y); q[7] = bfhi(a1.y); }
    const float* ckb = ck + ((size_t)(l * 32 + b) * W) * 512 + j * 128 + 4 * c16;
    const float* cvb = cv + ((size_t)(l * 32 + b) * W) * 512 + j * 128 + 4 * c16;
    const bf16_t* znew = z + (size_t)(MP + b * 8) * DIN + hh * 128 + 4 * c16;
    const size_t rstride = (size_t)dil * 512 * 4;
    const float* kp0 = ckb + (size_t)(i + rr * dil) * 512;
#pragma unroll 1
    for (int bt = 0; bt < 2; ++bt) {
        f32x4 k0[15], k1[15];
#pragma unroll
        for (int t = 0; t < 15; ++t) { const float* p = kp0 + (size_t)(bt * 15 + t) * rstride; k0[t] = __builtin_nontemporal_load((const f32x4*)p); k1[t] = __builtin_nontemporal_load((const f32x4*)(p + 64)); }
#pragma unroll
        for (int t = 0; t < 15; ++t) {
            float s = (q[0] * k0[t][0] + q[1] * k0[t][1]) + (q[2] * k0[t][2] + q[3] * k0[t][3]) + (q[4] * k1[t][0] + q[5] * k1[t][1]) + (q[6] * k1[t][2] + q[7] * k1[t][3]);
            s += __shfl_xor(s, 1); s += __shfl_xor(s, 2); s += __shfl_xor(s, 4); s += __shfl_xor(s, 8);
            const int u = 4 * (bt * 15 + t) + rr;
            if (c16 == 0) sc[u] = s - slope_d * (float)(128 - u);
        }
    }
#pragma unroll
    for (int it = 30; it < 33; ++it) {
        const int u = 4 * it + rr; float s = 0.f;
        if (u <= 128) {
            const int index = i + u * dil;
            float k[8];
            if (index < W) { const f32x4 a0 = *(const f32x4*)(ckb + (size_t)index * 512), a1 = *(const f32x4*)(ckb + (size_t)index * 512 + 64);
                k[0] = a0[0]; k[1] = a0[1]; k[2] = a0[2]; k[3] = a0[3]; k[4] = a1[0]; k[5] = a1[1]; k[6] = a1[2]; k[7] = a1[3]; }
            else { const bf16_t* zk = znew + (size_t)(index - W) * DIN + Z_AK; const u32x2 a0 = *(const u32x2*)zk, a1 = *(const u32x2*)(zk + 64);
                k[0] = bflo(a0.x); k[1] = bfhi(a0.x); k[2] = bflo(a0.y); k[3] = bfhi(a0.y); k[4] = bflo(a1.x); k[5] = bfhi(a1.x); k[6] = bflo(a1.y); k[7] = bfhi(a1.y); }
#pragma unroll
            for (int e = 0; e < 8; ++e) s += q[e] * k[e];
        }
        s += __shfl_xor(s, 1); s += __shfl_xor(s, 2); s += __shfl_xor(s, 4); s += __shfl_xor(s, 8);
        if (c16 == 0 && u <= 128) sc[u] = s - slope_d * (float)(128 - u);
    }
    asm volatile("s_waitcnt lgkmcnt(0)" ::: "memory");
    __syncthreads();
    float s0 = sc[lane], s1 = sc[lane + 64], s2 = (lane == 0) ? sc[128] : -INFINITY;
    float mx = fmaxf(fmaxf(s0, s1), s2);
#pragma unroll
    for (int o = 1; o < 64; o <<= 1) mx = fmaxf(mx, __shfl_xor(mx, o));
    s0 = __expf(s0 - mx); s1 = __expf(s1 - mx); s2 = __expf(s2 - mx);
    const float den = wave_sum(s0 + s1 + s2), inv = 1.0f / den;
    __syncthreads();
    sc[lane] = s0 * inv; sc[lane + 64] = s1 * inv; if (lane == 0) sc[128] = s2 * inv;
    if (lane >= 1 && lane < 4) sc[128 + lane] = 0.f;
    asm volatile("s_waitcnt lgkmcnt(0)" ::: "memory");
    __syncthreads();
    float o[8];
#pragma unroll
    for (int e = 0; e < 8; ++e) o[e] = 0.f;
    const float* vp0 = cvb + (size_t)(i + rr * dil) * 512;
#pragma unroll 1
    for (int bt = 0; bt < 2; ++bt) {
        f32x4 v0[15], v1[15];
#pragma unroll
        for (int t = 0; t < 15; ++t) { const float* p = vp0 + (size_t)(bt * 15 + t) * rstride; v0[t] = __builtin_nontemporal_load((const f32x4*)p); v1[t] = __builtin_nontemporal_load((const f32x4*)(p + 64)); }
#pragma unroll
        for (int t = 0; t < 15; ++t) { const float p = sc[4 * (bt * 15 + t) + rr];
#pragma unroll
            for (int e = 0; e < 4; ++e) { o[e] += p * v0[t][e]; o[4 + e] += p * v1[t][e]; } }
    }
#pragma unroll
    for (int it = 30; it < 33; ++it) {
        const int u = 4 * it + rr;
        if (u <= 128) {
            const int index = i + u * dil; const float p = sc[u];
            float v[8];
            if (index < W) { const f32x4 a0 = *(const f32x4*)(cvb + (size_t)index * 512), a1 = *(const f32x4*)(cvb + (size_t)index * 512 + 64);
                v[0] = a0[0]; v[1] = a0[1]; v[2] = a0[2]; v[3] = a0[3]; v[4] = a1[0]; v[5] = a1[1]; v[6] = a1[2]; v[7] = a1[3]; }
            else { const bf16_t* zv = znew + (size_t)(index - W) * DIN + Z_AV; const u32x2 a0 = *(const u32x2*)zv, a1 = *(const u32x2*)(zv + 64);
                v[0] = bflo(a0.x); v[1] = bfhi(a0.x); v[2] = bflo(a0.y); v[3] = bfhi(a0.y); v[4] = bflo(a1.x); v[5] = bfhi(a1.x); v[6] = bflo(a1.y); v[7] = bfhi(a1.y); }
#pragma unroll
            for (int e = 0; e < 8; ++e) o[e] += p * v[e];
        }
    }
#pragma unroll
    for (int e = 0; e < 8; ++e) { o[e] += __shfl_xor(o[e], 16); o[e] += __shfl_xor(o[e], 32); }
    if (rr == 0) {
        bf16_t* op = og + ((size_t)g * MT + zrow) * 512 + j * 128 + 4 * c16;
        u32x2 w0, w1; w0.x = pk2(o[0], o[1]); w0.y = pk2(o[2], o[3]); w1.x = pk2(o[4], o[5]); w1.y = pk2(o[6], o[7]);
        *(u32x2*)op = w0; *(u32x2*)(op + 64) = w1;
    }
    if (lane == 0) lse[((size_t)g * MT + zrow) * 4 + j] = mx + __logf(den);
    __syncthreads();
}

__device__ __forceinline__ void win_copy(const Args& a, const bf16_t* __restrict__ z, int l, int tid) {
    const int lane = tid & 63, gw = blockIdx.x * 8 + (tid >> 6), NGW = gridDim.x * 8;
    for (int idx = gw; idx < 12288; idx += NGW) {
        const int kv = idx / 6144; int rem = idx % 6144;
        size_t zrow; int g; float* dst;
        if (rem < 5376) {
            int W, bw;
            if (rem < 256) { g = 0; W = 128; bw = rem; } else if (rem < 1280) { g = 1; W = 512; bw = rem - 256; } else { g = 2; W = 2048; bw = rem - 1280; }
            const int b = bw / W, w = bw % W;
            zrow = (size_t)b * SEQ + (SEQ - W) + w;
            const size_t ooff = (g == 0) ? (kv ? O_PWV0 : O_PWK0) : (g == 1) ? (kv ? O_PWV1 : O_PWK1) : (kv ? O_PWV2 : O_PWK2);
            dst = a.out + ooff + (((size_t)l * 2 + b) * W + w) * 512;
        } else {
            rem -= 5376; g = rem >> 8; const int b = (rem & 255) >> 3, i = rem & 7, W = 128 << (2 * g);
            zrow = (size_t)MP + b * 8 + i;
            const size_t ooff = (g == 0) ? (kv ? O_SWV0 : O_SWK0) : (g == 1) ? (kv ? O_SWV1 : O_SWK1) : (kv ? O_SWV2 : O_SWK2);
            dst = a.out + ooff + (((size_t)l * 32 + b) * W + (W - 8) + i) * 512;
        }
        const u32x4 w4 = *(const u32x4*)(z + zrow * DIN + (kv ? Z_AV : Z_AK) + g * 512 + 8 * lane);
        *(f32x4*)(dst + 8 * lane) = (f32x4){bflo(w4.x), bfhi(w4.x), bflo(w4.y), bfhi(w4.y)};
        *(f32x4*)(dst + 8 * lane + 4) = (f32x4){bflo(w4.z), bfhi(w4.z), bflo(w4.w), bfhi(w4.w)};
    }
}

template <bool DO_SCAN, bool DO_COMBINE>
__device__ __forceinline__ void p3_scan_combine(const Args& a, int l, int tid) {
    const bf16_t* U = (const bf16_t*)(a.ws + WS_U); bf16_t* Rp = (bf16_t*)(a.ws + WS_RP);
    const int gt = blockIdx.x * 512 + tid, GT = gridDim.x * 512;
    if constexpr (DO_SCAN) for (int e = gt; e < 131072; e += GT) {
        const int vd = e & 32767, bh0 = e >> 15, bh1 = bh0 + 4, h = bh0 & 3;
        const float cd = __expf(ret_lg(h) * 128.0f);
        float R0 = 0.f, R1 = 0.f;
        const bf16_t* up0 = U + (size_t)bh0 * 64 * 32768 + vd; bf16_t* rp0 = Rp + (size_t)bh0 * 64 * 32768 + vd;
        const bf16_t* up1 = U + (size_t)bh1 * 64 * 32768 + vd; bf16_t* rp1 = Rp + (size_t)bh1 * 64 * 32768 + vd;
#pragma unroll 1
        for (int c0 = 0; c0 < 64; c0 += 16) {
            float u0[16], u1[16];
#pragma unroll
            for (int k = 0; k < 16; ++k) { u0[k] = __uint_as_float((unsigned)up0[(size_t)(c0 + k) * 32768] << 16); u1[k] = __uint_as_float((unsigned)up1[(size_t)(c0 + k) * 32768] << 16); }
#pragma unroll
            for (int k = 0; k < 16; ++k) { rp0[(size_t)(c0 + k) * 32768] = (bf16_t)f2bf(R0); R0 = cd * R0 + u0[k]; rp1[(size_t)(c0 + k) * 32768] = (bf16_t)f2bf(R1); R1 = cd * R1 + u1[k]; }
        }
        const int v = vd >> 7, d = vd & 127;
        a.out[O_PRET + ((size_t)l * 8 + bh0) * 32768 + d * 256 + v] = R0;
        a.out[O_PRET + ((size_t)l * 8 + bh1) * 32768 + d * 256 + v] = R1;
    }
    const bf16_t* og = (const bf16_t*)(a.ws + WS_OG); const float* lse = (const float*)(a.ws + WS_LSE); bf16_t* oatt = (bf16_t*)(a.ws + WS_OATT);
    const int lane = tid & 63, gw = blockIdx.x * 8 + (tid >> 6), NGW = gridDim.x * 8;
    if constexpr (DO_COMBINE) for (int row0 = gw; row0 < MT; row0 += 2 * NGW) {
        const int j = lane >> 4;
        u32x4 q[2][3]; float ls[2][3];
#pragma unroll
        for (int rr = 0; rr < 2; ++rr) { const int row = (row0 + rr * NGW < MT) ? row0 + rr * NGW : row0;
#pragma unroll
            for (int g = 0; g < 3; ++g) { ls[rr][g] = lse[((size_t)g * MT + row) * 4 + j]; q[rr][g] = *(const u32x4*)(og + ((size_t)g * MT + row) * 512 + 8 * lane); } }
#pragma unroll
        for (int rr = 0; rr < 2; ++rr) {
            const int row = row0 + rr * NGW; if (row >= MT) break;
            const float mx = fmaxf(ls[rr][0], fmaxf(ls[rr][1], ls[rr][2]));
            float w0 = __expf(ls[rr][0] - mx), w1 = __expf(ls[rr][1] - mx), w2 = __expf(ls[rr][2] - mx);
            const float inv = 1.0f / (w0 + w1 + w2); w0 *= inv; w1 *= inv; w2 *= inv;
            const u32x4 q0 = q[rr][0], q1 = q[rr][1], q2 = q[rr][2];
            const f32x4 a0 = {bflo(q0.x), bfhi(q0.x), bflo(q0.y), bfhi(q0.y)}, a1 = {bflo(q0.z), bfhi(q0.z), bflo(q0.w), bfhi(q0.w)};
            const f32x4 b0 = {bflo(q1.x), bfhi(q1.x), bflo(q1.y), bfhi(q1.y)}, b1 = {bflo(q1.z), bfhi(q1.z), bflo(q1.w), bfhi(q1.w)};
            const f32x4 c0_ = {bflo(q2.x), bfhi(q2.x), bflo(q2.y), bfhi(q2.y)}, c1_ = {bflo(q2.z), bfhi(q2.z), bflo(q2.w), bfhi(q2.w)};
            const f32x4 r0 = a0 * w0 + b0 * w1 + c0_ * w2, r1 = a1 * w0 + b1 * w1 + c1_ * w2;
            u32x4 w; w.x = pk2(r0[0], r0[1]); w.y = pk2(r0[2], r0[3]); w.z = pk2(r1[0], r1[1]); w.w = pk2(r1[2], r1[3]);
            *(u32x4*)(oatt + (size_t)row * 512 + 8 * lane) = w;
        }
    }
}

constexpr int RO_VOFF = 128 * KVS, RO_ROFF = RO_VOFF + 128 * RVS;
__device__ __forceinline__ void ret_out_item(LAS unsigned char* lds, const bf16_t* __restrict__ z, const bf16_t* __restrict__ Rp, bf16_t* __restrict__ oret, int item, int tid) {
    const int wid = __builtin_amdgcn_readfirstlane(tid >> 6), lane = tid & 63, fr = lane & 15, quad = lane >> 4;
    const int c = item & 63, bh = item >> 6, h = bh & 3, b = bh >> 2;
    const float lg = ret_lg(h);
    const size_t zrow0 = (size_t)b * SEQ + 128 * c;
    const bf16_t* z0 = z + zrow0 * DIN;
    const bf16_t* R0 = Rp + (size_t)item * 32768;
#pragma unroll
    for (int it = 0; it < 4; ++it) {
        const int idx = tid + it * 512, jj = idx >> 4, ch = idx & 15;
        *(LAS u32x4*)(lds + jj * KVS + ch * 16) = *(const u32x4*)(z0 + (size_t)jj * DIN + Z_RK + h * 128 + ch * 8);
        *(LAS u32x4*)(lds + RO_ROFF + jj * KVS + ch * 16) = *(const u32x4*)(R0 + (size_t)jj * 128 + ch * 8);
    }
#pragma unroll
    for (int it = 0; it < 8; ++it) {
        const int idx = tid + it * 512, jj = idx >> 5, ch = idx & 31;
        *(LAS u32x4*)(lds + RO_VOFF + jj * RVS + ch * 16) = *(const u32x4*)(z0 + (size_t)jj * DIN + Z_RV + h * 256 + ch * 8);
    }
    const int iq = 16 * wid + fr;
    bf16x8 qf[4];
#pragma unroll
    for (int ks = 0; ks < 4; ++ks) qf[ks] = *(const bf16x8*)(z0 + (size_t)iq * DIN + Z_RQ + h * 128 + ks * 32 + quad * 8);
    __syncthreads();
    f32x4 o[16];
#pragma unroll
    for (int vt = 0; vt < 16; ++vt) o[vt] = (f32x4){0.f, 0.f, 0.f, 0.f};
#pragma unroll
    for (int vt = 0; vt < 8; ++vt)
#pragma unroll
        for (int ks = 0; ks < 4; ++ks) { const bf16x8 ra = *(LAS const bf16x8*)(lds + RO_ROFF + (16 * vt + fr) * KVS + ks * 64 + quad * 16); o[vt] = MFMA16(ra, qf[ks], o[vt]); }
    __syncthreads();
#pragma unroll
    for (int it = 0; it < 4; ++it) {
        const int idx = tid + it * 512, jj = idx >> 4, ch = idx & 15;
        *(LAS u32x4*)(lds + RO_ROFF + jj * KVS + ch * 16) = *(const u32x4*)(R0 + (size_t)(128 + jj) * 128 + ch * 8);
    }
    __syncthreads();
#pragma unroll
    for (int vt = 0; vt < 8; ++vt)
#pragma unroll
        for (int ks = 0; ks < 4; ++ks) { const bf16x8 ra = *(LAS const bf16x8*)(lds + RO_ROFF + (16 * vt + fr) * KVS + ks * 64 + quad * 16); o[8 + vt] = MFMA16(ra, qf[ks], o[8 + vt]); }
    const float xi = __expf(lg * (float)(iq + 1));
#pragma unroll
    for (int vt = 0; vt < 16; ++vt) o[vt] = o[vt] * xi;
#pragma unroll
    for (int kp = 0; kp < 4; ++kp) {
        if (2 * kp <= wid) {
            const bool hasB = (2 * kp + 1 <= wid);
            const int TA = 2 * kp, TB = hasB ? TA + 1 : TA;
            f32x4 sa = {0.f, 0.f, 0.f, 0.f}, sb = {0.f, 0.f, 0.f, 0.f};
#pragma unroll
            for (int ks = 0; ks < 4; ++ks) {
                const bf16x8 ka = *(LAS const bf16x8*)(lds + (16 * TA + fr) * KVS + ks * 64 + quad * 16); sa = MFMA16(ka, qf[ks], sa);
                const bf16x8 kb = *(LAS const bf16x8*)(lds + (16 * TB + fr) * KVS + ks * 64 + quad * 16); sb = MFMA16(kb, qf[ks], sb);
            }
#pragma unroll
            for (int e = 0; e < 4; ++e) {
                const int da = iq - (16 * TA + 4 * quad + e), db = iq - (16 * TB + 4 * quad + e);
                sa[e] = (da >= 0) ? sa[e] * __expf(lg * (float)da) : 0.f;
                sb[e] = (hasB && db >= 0) ? sb[e] * __expf(lg * (float)db) : 0.f;
            }
            u32x4 pw; pw.x = pk2(sa[0], sa[1]); pw.y = pk2(sa[2], sa[3]); pw.z = pk2(sb[0], sb[1]); pw.w = pk2(sb[2], sb[3]);
            const bf16x8 p8 = __builtin_bit_cast(bf16x8, pw);
            LAS const unsigned char* bA = lds + RO_VOFF + (16 * TA + 4 * quad + (fr >> 2)) * RVS + (fr & 3) * 8;
            LAS const unsigned char* bB = lds + RO_VOFF + (16 * TB + 4 * quad + (fr >> 2)) * RVS + (fr & 3) * 8;
#pragma unroll
            for (int vt = 0; vt < 16; ++vt) { const v4i16_t va = tr4(bA + vt * 32), vb = tr4(bB + vt * 32); o[vt] = MFMA16(cat8(va, vb), p8, o[vt]); }
        }
    }
    float s = 0.f;
#pragma unroll
    for (int vt = 0; vt < 16; ++vt) s += (o[vt][0] + o[vt][1]) + (o[vt][2] + o[vt][3]);
    s += __shfl_xor(s, 16); s += __shfl_xor(s, 32);
    const float mu = s * (1.0f / 256.0f); float qv = 0.f;
#pragma unroll
    for (int vt = 0; vt < 16; ++vt) { o[vt] = o[vt] - mu; qv += (o[vt][0] * o[vt][0] + o[vt][1] * o[vt][1]) + (o[vt][2] * o[vt][2] + o[vt][3] * o[vt][3]); }
    qv += __shfl_xor(qv, 16); qv += __shfl_xor(qv, 32);
    const float rstd = 1.0f / sqrtf(qv * (1.0f / 256.0f) + 1e-6f);
    const bf16_t* rgp = z0 + (size_t)iq * DIN + Z_RG + h * 256 + 4 * quad;
    bf16_t* op = oret + (zrow0 + iq) * DM + h * 256 + 4 * quad;
#pragma unroll
    for (int vt = 0; vt < 16; ++vt) {
        const u32x2 gw = *(const u32x2*)(rgp + 16 * vt);
        const float g0 = bflo(gw.x), g1 = bfhi(gw.x), g2 = bflo(gw.y), g3 = bfhi(gw.y);
        const float x0 = o[vt][0] * rstd * g0 / (1.0f + __expf(-g0)), x1 = o[vt][1] * rstd * g1 / (1.0f + __expf(-g1)), x2 = o[vt][2] * rstd * g2 / (1.0f + __expf(-g2)), x3 = o[vt][3] * rstd * g3 / (1.0f + __expf(-g3));
        u32x2 w; w.x = pk2(x0, x1); w.y = pk2(x2, x3);
        *(u32x2*)(op + 16 * vt) = w;
    }
    __syncthreads();
}

#define XB_TMO      128
#define XB_XCNT(j)  (256  + 64 * (j))
#define XB_XSUB(j)  (1280 + 64 * (j))
#define XB_XGEN(j)  (2304 + 64 * (j))
#define XB_TOP      3328
#define XB_TOPGEN   3392
#define XCD_BAR_WORDS 3456
#define XB_SPIN_CAP (1u << 18)

__device__ __forceinline__ unsigned xb_ld(unsigned* p)              { return __hip_atomic_load(p, __ATOMIC_RELAXED, __HIP_MEMORY_SCOPE_AGENT); }
__device__ __forceinline__ unsigned xb_add(unsigned* p, unsigned v) { return __hip_atomic_fetch_add(p, v, __ATOMIC_RELAXED, __HIP_MEMORY_SCOPE_AGENT); }
__device__ __forceinline__ unsigned xb_xcc_id() { return (unsigned)__builtin_amdgcn_s_getreg((3 << 11) | 20) & 0xFu; }
#define XB_SPIN(cond, bar) do { unsigned _sp = 0; while (cond) { __builtin_amdgcn_s_sleep(1); \
    if ((++_sp & 255u) == 0u) { if (xb_ld(&(bar)[XB_TMO])) break; if (_sp > XB_SPIN_CAP) { atomicAdd(&(bar)[XB_TMO], 1u); break; } } } } while (0)

struct XcdBarrier {
    unsigned* bar; unsigned x;
    volatile LAS unsigned* st;
};

__device__ __forceinline__ XcdBarrier xcd_barrier_post(unsigned* bar, volatile LAS unsigned* st) {
    XcdBarrier b; b.bar = bar; b.x = xb_xcc_id(); b.st = st;
    if (threadIdx.x == 0) (void)xb_add(&bar[XB_XCNT(b.x)], 1u);
    return b;
}
__device__ __forceinline__ void xcd_barrier_complete(unsigned* bar, unsigned x, unsigned& nloc, unsigned& nx) {
    const unsigned G = gridDim.x * gridDim.y * gridDim.z;
    unsigned sum, cnt, mine, sp = 0u;
    for (;;) {
        sum = 0u; cnt = 0u; mine = 0u;
#pragma unroll
        for (unsigned j = 0; j < 16; ++j) { const unsigned c = xb_ld(&bar[XB_XCNT(j)]); sum += c; cnt += (c > 0u) ? 1u : 0u; mine = (j == x) ? c : mine; }
        if (sum == G) break;
        __builtin_amdgcn_s_sleep(1);
        if ((++sp & 255u) == 0u) { if (xb_ld(&bar[XB_TMO])) break; if (sp > XB_SPIN_CAP) { atomicAdd(&bar[XB_TMO], 1u); break; } }
    }
    nloc = mine > 0u ? mine : 1u; nx = cnt > 0u ? cnt : 1u;
}

__device__ __forceinline__ void xcd_barrier(const XcdBarrier& b) {
    asm volatile("s_waitcnt vmcnt(0)" ::: "memory");
    __syncthreads();
    if (threadIdx.x == 0) {
        unsigned* bar = b.bar;
        __builtin_amdgcn_s_waitcnt(0);
        unsigned nloc = b.st[0], nx = b.st[1];
        if (nloc == 0u) { xcd_barrier_complete(bar, b.x, nloc, nx); b.st[0] = nloc; b.st[1] = nx; }
        const unsigned old = xb_add(&bar[XB_XSUB(b.x)], 1u);
        const unsigned gen = old / nloc;
        if (old + 1u == (gen + 1u) * nloc) {
            __builtin_amdgcn_fence(__ATOMIC_RELEASE, "agent");
            asm volatile("s_waitcnt vmcnt(0)" ::: "memory");
            const unsigned og = xb_add(&bar[XB_TOP], 1u);
            const unsigned tg = og / nx;
            if (og + 1u == (tg + 1u) * nx) xb_add(&bar[XB_TOPGEN], 1u);
            else XB_SPIN(xb_ld(&bar[XB_TOPGEN]) == tg, bar);
            __builtin_amdgcn_fence(__ATOMIC_ACQUIRE, "agent");
            xb_add(&bar[XB_XGEN(b.x)], 1u);
            asm volatile("s_waitcnt vmcnt(0)" ::: "memory");
        } else {
            XB_SPIN(xb_ld(&bar[XB_XGEN(b.x)]) == gen, bar);
            __builtin_amdgcn_fence(__ATOMIC_ACQUIRE, "agent");
            asm volatile("s_waitcnt vmcnt(0)" ::: "memory");
        }
    }
    __syncthreads();
}

template <int MODE>
__device__ __forceinline__ void skinny_phase(LAS unsigned char* lds, const bf16_t* __restrict__ A, const bf16_t* __restrict__ Wt, int K, const pg8::Epi<MODE>& E, int tid_in) {
    int tid = tid_in; asm volatile("" : "+v"(tid));
    const int wid = __builtin_amdgcn_readfirstlane(tid >> 6), lane = tid & 63, fr = lane & 15, quad = lane >> 4;
    LAS f32x4* red = (LAS f32x4*)lds;
    LAS float* ssq_l = (LAS float*)(lds + 32768);
#pragma unroll 1
    for (int slab = blockIdx.x; slab < 256; slab += gridDim.x) {
        const int rt = slab & 15, cs = slab >> 4;
        const bf16_t* arow = A + (size_t)(MP + 16 * rt + fr) * K + 8 * quad;
        const bf16_t* wrow = Wt + (size_t)(64 * cs + fr) * K + 8 * quad;
        f32x4 acc[4];
#pragma unroll
        for (int ct = 0; ct < 4; ++ct) acc[ct] = (f32x4){0.f, 0.f, 0.f, 0.f};
        const int nks = K >> 5;
#pragma unroll 4
        for (int ks = wid; ks < nks; ks += 8) {
            const bf16x8 b = *(const bf16x8*)(arow + 32 * ks);
#pragma unroll
            for (int ct = 0; ct < 4; ++ct) { const bf16x8 w = *(const bf16x8*)(wrow + (size_t)(16 * ct) * K + 32 * ks); acc[ct] = MFMA16(w, b, acc[ct]); }
        }
#pragma unroll
        for (int ct = 0; ct < 4; ++ct) red[(wid * 4 + ct) * 64 + lane] = acc[ct];
        __syncthreads();
        if (wid < 4) {
            f32x4 s = red[wid * 64 + lane];
#pragma unroll
            for (int w = 1; w < 8; ++w) s = s + red[(w * 4 + wid) * 64 + lane];
            float ssq = E.elem(MP + 16 * rt + fr, 64 * cs + 16 * wid + 4 * quad, s);
            if constexpr (MODE == pg8::E_RES || MODE == pg8::E_GATE) { ssq += __shfl_xor(ssq, 16); ssq += __shfl_xor(ssq, 32); if (quad == 0) ssq_l[wid * 16 + fr] = ssq; }
        }
        __syncthreads();
        if constexpr (MODE == pg8::E_RES || MODE == pg8::E_GATE) { if (tid < 16) E.ssp_out[(size_t)(MP + 16 * rt + tid) * 16 + cs] = (ssq_l[tid] + ssq_l[16 + tid]) + (ssq_l[32 + tid] + ssq_l[48 + tid]); }
        __syncthreads();
    }
}

#define GEMM_PHASE(MODE, Aptr, Bptr, Mm, Nn, Kk, EPI) do { int kk_ = (Kk); asm volatile("" : "+s"(kk_)); pg8::Gemm g_{(const pg8::bf16_t*)(Aptr), (const pg8::bf16_t*)(Bptr), (Mm), (Nn), kk_}; pg8::StaticOrder S_; S_.init((Mm), (Nn), (int)gridDim.x, (int)blockIdx.x); \
    pg8::gemm_phase<pg8::Epi<MODE>, pg8::StaticOrder, true, true>((PG8_LAS unsigned char*)lds, g_, S_, (EPI)); } while (0)

__global__ void __launch_bounds__(512, 2) mega_fwd(Args a) {
    extern __shared__ __attribute__((aligned(16))) unsigned char lds_raw[];
    LAS unsigned char* lds = (LAS unsigned char*)lds_raw;
    cg::grid_group grid = cg::this_grid();
    int tid = threadIdx.x;
#define OPQ() asm volatile("" : "+v"(tid))
    unsigned char* ws = a.ws;
    float* ssp = (float*)(ws + WS_SSP); bf16_t* tbuf = (bf16_t*)(ws + WS_T);
    bf16_t* z = (bf16_t*)(ws + WS_Z); bf16_t* ubuf = (bf16_t*)(ws + WS_Z);
    bf16_t* oret = (bf16_t*)(ws + WS_ORET); bf16_t* oatt = (bf16_t*)(ws + WS_OATT); bf16_t* merged = (bf16_t*)(ws + WS_MERGED);
    bf16_t* og = (bf16_t*)(ws + WS_OG); float* lse = (float*)(ws + WS_LSE); bf16_t* U = (bf16_t*)(ws + WS_U); bf16_t* Rp = (bf16_t*)(ws + WS_RP);

#ifndef PHMASK
#define PHMASK 0xFFFFF
#endif
#define PH(n) if constexpr ((PHMASK >> (n)) & 1)
    unsigned* barw = (unsigned*)(ws + WS_CTL);
    volatile LAS unsigned* MISC = (volatile LAS unsigned*)(lds + LDS_BYTES - 64);
    if (tid < 2) MISC[tid] = 0u;
    if (blockIdx.x == 0) for (int i = tid; i < XCD_BAR_WORDS; i += 512) __hip_atomic_store(barw + i, 0u, __ATOMIC_RELAXED, __HIP_MEMORY_SCOPE_AGENT);
    PH(0) p0_prologue(a, lds, tid);
    grid.sync();
    const XcdBarrier xbar = xcd_barrier_post(barw, MISC);
#define GSYNC() xcd_barrier(xbar)

#pragma unroll 1
    for (int l = 0; l < 2; ++l) {
        unsigned char* wl = ws + WS_WT + (size_t)l * WT_LAYER;
        bf16_t* xb_cur = (bf16_t*)(ws + (l == 0 ? WS_XBA : WS_XBB));
        bf16_t* xb_nxt = (bf16_t*)(ws + (l == 0 ? WS_XBB : WS_XBA));
#ifndef REP_G
#define REP_G 1
#endif
#pragma unroll 1
        for (int rg_ = 0; rg_ < REP_G; ++rg_) {
        PH(1) { pg8::Epi<pg8::E_Z> E{z, DIN, nullptr, nullptr, ssp, nullptr, nullptr, nullptr}; GEMM_PHASE(pg8::E_Z, xb_cur, wl + WT_IN, MT, DIN, DM, E); }
        if (rg_ + 1 < REP_G) GSYNC();
        }
        cache_copy_tail(a, 2470, l * 500 + 0, l * 500 + 50, tid);
        GSYNC();
#ifndef REP_MIX
#define REP_MIX 1
#endif
#pragma unroll 1
        for (int rep_ = 0; rep_ < REP_MIX; ++rep_) {
        OPQ();
        if (blockIdx.x & 1) cache_copy_tail(a, 0, l * 500 + 190, l * 500 + 260, tid);
        PH(3) for (int it = blockIdx.x; it < 512; it += gridDim.x) ret_u_item(lds, z, U, it, tid);
        if (!(blockIdx.x & 1)) cache_copy_tail(a, 0, l * 500 + 190, l * 500 + 260, tid);
        GSYNC();
        if (blockIdx.x & 1) cache_copy_tail(a, 0, l * 500 + 260, l * 500 + 310, tid);
#pragma unroll 1
        for (int stage_ = 0; stage_ < 2; ++stage_) {
        const bool sample_now = ((stage_ == 0) == ((blockIdx.x & 1) != 0));
        if (!sample_now) {
        OPQ();
        PH(2) { const int per_ = (1536 + (int)gridDim.x - 1) / (int)gridDim.x; for (int i_ = 0; i_ < per_; ++i_) { const int it = (int)blockIdx.x * per_ + i_; if (it < 1536) attn_prompt_item(lds, z, og, lse, it, tid); } }
        } else {
        OPQ();
        PH(4) for (int it = blockIdx.x; it < 384; it += gridDim.x) {
            const int g = (it >> 2) % 3;
            attn_sample_item(lds, z, a.in[2 + 2 * g], a.in[3 + 2 * g], l, og, lse, it, tid);
        }
        OPQ();
        PH(5) for (int it = (blockIdx.x + gridDim.x / 2) % gridDim.x; it < 128; it += gridDim.x) ret_sample_item(lds, z, a.in[8] + (size_t)l * 128 * 32768, a.out + O_SRET + (size_t)l * 128 * 32768, oret, it, tid);
        }
        }
        OPQ();
        PH(7) p3_scan_combine<true, false>(a, l, tid);
        PH(6) win_copy(a, z, l, tid);
        if (!(blockIdx.x & 1)) cache_copy_tail(a, 0, l * 500 + 260, l * 500 + 310, tid);
        GSYNC();
        OPQ();
        if (blockIdx.x & 1) cache_copy_tail(a, 0, l * 500 + 310, l * 500 + 500, tid);
        PH(8) for (int it = blockIdx.x; it < 512; it += gridDim.x) ret_out_item(lds, z, Rp, oret, it, tid);
        PH(7) p3_scan_combine<false, true>(a, l, tid);
        if (!(blockIdx.x & 1)) cache_copy_tail(a, 0, l * 500 + 310, l * 500 + 500, tid);
        GSYNC();
        }
        PH(9) { pg8::Epi<pg8::E_RET> E{nullptr, DM, nullptr, tbuf, nullptr, nullptr, z + Z_GA, nullptr}; GEMM_PHASE(pg8::E_RET, oret, wl + WT_RET, MP, DM, DM, E); skinny_phase<pg8::E_RET>(lds, oret, (const bf16_t*)(wl + WT_RET), DM, E, tid); }
        PH(10) { pg8::Epi<pg8::E_ATT> E{merged, DM, nullptr, tbuf, nullptr, nullptr, z + Z_GB, nullptr}; GEMM_PHASE(pg8::E_ATT, oatt, wl + WT_ATT, MP, DM, 512, E); skinny_phase<pg8::E_ATT>(lds, oatt, (const bf16_t*)(wl + WT_ATT), 512, E, tid); }
        GSYNC();
        PH(11) { pg8::Epi<pg8::E_RES> E{xb_cur, DM, xb_cur, nullptr, nullptr, ssp, nullptr, (l == 0) ? a.in[0] : (const float*)nullptr}; GEMM_PHASE(pg8::E_RES, merged, wl + WT_OUT, MP, DM, DM, E);
          pg8::Epi<pg8::E_RES> Es{xb_cur, DM, xb_cur, nullptr, nullptr, ssp, nullptr, (l == 0) ? a.in[1] - (size_t)MP * DM : (const float*)nullptr}; skinny_phase<pg8::E_RES>(lds, merged, (const bf16_t*)(wl + WT_OUT), DM, Es, tid); }
        GSYNC();
#pragma unroll 1
        for (int rg_ = 0; rg_ < REP_G; ++rg_) {
        PH(12) { pg8::Epi<pg8::E_UP> E{ubuf, DFF, nullptr, nullptr, ssp, nullptr, nullptr, nullptr}; GEMM_PHASE(pg8::E_UP, xb_cur, wl + WT_UP, MT, DFF, DM, E); }
        if (rg_ + 1 < REP_G) GSYNC();
        }
        cache_copy_tail(a, 1040, l * 500 + 50, l * 500 + 190, tid);
        GSYNC();
        PH(13) { pg8::Epi<pg8::E_RES> E{xb_cur, DM, xb_cur, nullptr, nullptr, ssp, nullptr, nullptr}; GEMM_PHASE(pg8::E_RES, ubuf, wl + WT_DOWN, MP, DM, DFF, E); skinny_phase<pg8::E_RES>(lds, ubuf, (const bf16_t*)(wl + WT_DOWN), DFF, E, tid); }
        GSYNC();
        PH(14) { pg8::Epi<pg8::E_PLE> E{nullptr, DM, nullptr, tbuf, nullptr, nullptr, nullptr, nullptr}; GEMM_PHASE(pg8::E_PLE, ws + WS_PB + (size_t)l * MT * DPLE * 2, wl + WT_PLE, MP, DM, DPLE, E); skinny_phase<pg8::E_PLE>(lds, (const bf16_t*)(ws + WS_PB + (size_t)l * MT * DPLE * 2), (const bf16_t*)(wl + WT_PLE), DPLE, E, tid); }
        PH(15) { pg8::Epi<pg8::E_GATE> E{xb_nxt, DM, xb_cur, tbuf, nullptr, ssp, nullptr, nullptr}; GEMM_PHASE(pg8::E_GATE, xb_cur, wl + WT_GATE, MP, DM, DM, E); skinny_phase<pg8::E_GATE>(lds, xb_cur, (const bf16_t*)(wl + WT_GATE), DM, E, tid); }
        GSYNC();
    }
    {
        const int lane = tid & 63, gw = blockIdx.x * 8 + (tid >> 6), NGW = gridDim.x * 8;
        const float* nf = a.in[21];
        for (int m = gw; m < MT; m += NGW) {
            float sv = (lane < 16) ? ssp[(size_t)m * 16 + lane] : 0.f;
            sv = wave_sum(sv);
            const float rstd = 1.0f / sqrtf(sv * (1.0f / 1024.0f) + 1e-6f);
#pragma unroll
            for (int j = 0; j < 4; ++j) { const u32x2 xw_ = *(const u32x2*)((const bf16_t*)(ws + WS_XBA) + (size_t)m * DM + 4 * lane + 256 * j); const f32x4 v = {bflo(xw_.x), bfhi(xw_.x), bflo(xw_.y), bfhi(xw_.y)}; const f32x4 gn = *(const f32x4*)(nf + 4 * lane + 256 * j); *(f32x4*)(a.out + O_Y + (size_t)m * DM + 4 * lane + 256 * j) = v * rstd * gn; }
        }
    }
}

extern "C" void kernel_launch(void* const* d_in, const int* in_sizes, int n_in, void* d_out, int out_size, void* d_ws, size_t ws_size, hipStream_t stream) {
    static int grid = 0;
    if (grid == 0) {
        if (n_in != 22 || (size_t)out_size != O_END || ws_size < WS_END) { fprintf(stderr, "kernel_launch: unexpected shapes: n_in %d out %d (want %zu) ws %zu (need %zu)\n", n_in, out_size, (size_t)O_END, ws_size, (size_t)WS_END); grid = -1; return; }
        int dev = 0, cus = 0, per_cu = 0;
        if (hipGetDevice(&dev) != hipSuccess || hipDeviceGetAttribute(&cus, hipDeviceAttributeMultiprocessorCount, dev) != hipSuccess) { grid = -1; return; }
        if (hipFuncSetAttribute((const void*)mega_fwd, hipFuncAttributeMaxDynamicSharedMemorySize, LDS_BYTES) != hipSuccess) { fprintf(stderr, "kernel_launch: hipFuncSetAttribute failed\n"); grid = -1; return; }
        if (hipOccupancyMaxActiveBlocksPerMultiprocessor(&per_cu, (const void*)mega_fwd, 512, LDS_BYTES) != hipSuccess || per_cu < 1) { fprintf(stderr, "kernel_launch: occupancy query says %d\n", per_cu); per_cu = 1; }
        (void)hipGetLastError();
        grid = cus * 1;
    }
    if (grid < 0) return;
    Args a{};
    for (int i = 0; i < 22; ++i) a.in[i] = (const float*)d_in[i];
    a.out = (float*)d_out; a.ws = (unsigned char*)d_ws;
    void* args[] = {&a};
    hipError_t e = hipLaunchCooperativeKernel((const void*)mega_fwd, dim3(grid), dim3(512), args, LDS_BYTES, stream);
    if (e != hipSuccess) fprintf(stderr, "cooperative launch failed: %s (grid %d)\n", hipGetErrorString(e), grid);
}
```

```cpp
#include <hip/hip_runtime.h>
#include <hip/hip_cooperative_groups.h>
#include <cstdio>
#include <cstdint>
#include <cmath>
namespace cg = cooperative_groups;
namespace pg8 {
#define PG8_LAS __attribute__((address_space(3)))
typedef unsigned short bf16_t;
typedef short bf16x8 __attribute__((ext_vector_type(8)));
typedef float f32x4 __attribute__((ext_vector_type(4)));
typedef unsigned u32x4 __attribute__((ext_vector_type(4)));
constexpr int BM = 256, BK = 64, HALF = 128, HTB = HALF * BK * 2  , STAGE_BYTES = 8 * HTB, NXCD = 8, WGM = 8;

__host__ __device__ __forceinline__ int lds_byte(int r, int c) { const int st = (r >> 4) * 2 + (c >> 5), rr = r & 15, cc = c & 31, ob = rr * 64 + cc * 2; return st * 1024 + (ob ^ (((ob >> 9) & 1) << 5)); }
__host__ __device__ __forceinline__ void stage_rc(int b, int& R, int& C) { const int st = b / 1024, sb = b % 1024, swz = sb ^ (((sb >> 9) & 1) << 5); R = (st >> 1) * 16 + swz / 64; C = (st & 1) * 32 + (swz % 64) / 2; }
__host__ __device__ __forceinline__ int perm32(int rho) { const int n = rho >> 4, i = rho & 15; return 8 * (i >> 2) + 4 * n + (i & 3); }

struct Unit { int pm, pn; };
struct Gemm { const bf16_t* A; const bf16_t* Bt; int M, N, K; };

struct StaticOrder {
    int nM, nN, nwg, G, c;
    __host__ __device__ void init(int M, int N, int G_, int c_) { nM = M / BM; nN = N / BM; nwg = nM * nN; G = G_; c = c_; }
    __host__ __device__ bool next(int i, Unit& u) const {
        const long L = (long)i * G + c; if (L >= nwg) return false;
        int wgid = (int)L; { const int q = nwg / NXCD, r = nwg % NXCD, xcd = wgid % NXCD, off = wgid / NXCD; wgid = (xcd < r ? xcd * (q + 1) : r * (q + 1) + (xcd - r) * q) + off; }
        const int nig = WGM * nN, gid = wgid / nig, fm = gid * WGM, gsz = (nM - fm) < WGM ? (nM - fm) : WGM;
        u.pm = fm + ((wgid % nig) % gsz); u.pn = (wgid % nig) / gsz; return true;
    }
    __device__ __forceinline__ void a_ready(const Unit&) const {}
    __device__ __forceinline__ void done(const Unit&) const {}
};

__device__ __forceinline__ unsigned cvt_pk_bf16(float lo, float hi) { unsigned r; asm("v_cvt_pk_bf16_f32 %0, %1, %2" : "=v"(r) : "v"(lo), "v"(hi)); return r; }

typedef unsigned u32x2 __attribute__((ext_vector_type(2)));
__device__ __forceinline__ float bf2f(unsigned h) { return __uint_as_float(h << 16); }
__device__ __forceinline__ float sigmoidf_(float x) { return 1.0f / (1.0f + __expf(-x)); }
__device__ __forceinline__ f32x4 bf4_to_f32(u32x2 w) { f32x4 r; r[0] = bf2f(w.x & 0xffffu); r[1] = bf2f(w.x >> 16); r[2] = bf2f(w.y & 0xffffu); r[3] = bf2f(w.y >> 16); return r; }
__device__ __forceinline__ u32x2 f32_to_bf4(f32x4 v) { u32x2 w; w.x = cvt_pk_bf16(v[0], v[1]); w.y = cvt_pk_bf16(v[2], v[3]); return w; }
enum { E_Z = 0, E_UP = 1, E_RET = 2, E_ATT = 3, E_RES = 4, E_PLE = 5, E_GATE = 6 };
template <int MODE> struct Epi {
    static constexpr bool PERM = (MODE == E_Z || MODE == E_UP), AFTER_DRAIN = false;
    bf16_t* ob; int ldob; const bf16_t* xrb; bf16_t* t; const float* ssp_in; float* ssp_out; const bf16_t* gate; const float* xr;
    __device__ __forceinline__ float elem(int row, int col, const f32x4 a) const {
        const size_t off = (size_t)row * 1024 + col; float ssq = 0.f;
        if constexpr (MODE == E_RET || MODE == E_ATT) {
            const u32x2 gw = *(const u32x2*)(gate + (size_t)row * 9728 + col);
            f32x4 gv; gv[0] = sigmoidf_(bf2f(gw.x & 0xffffu)); gv[1] = sigmoidf_(bf2f(gw.x >> 16)); gv[2] = sigmoidf_(bf2f(gw.y & 0xffffu)); gv[3] = sigmoidf_(bf2f(gw.y >> 16));
            if constexpr (MODE == E_RET) { *(u32x2*)(t + off) = f32_to_bf4(gv * a); }
            else { const f32x4 tv = bf4_to_f32(*(const u32x2*)(t + off)); const f32x4 o = tv + gv * a; u32x2 w; w.x = cvt_pk_bf16(o[0], o[1]); w.y = cvt_pk_bf16(o[2], o[3]); *(u32x2*)(ob + off) = w; }
        } else if constexpr (MODE == E_PLE) {
            *(u32x2*)(t + off) = f32_to_bf4(a);
        } else if constexpr (MODE == E_RES || MODE == E_GATE) {
            f32x4 x = xr ? *(const f32x4*)(xr + off) : bf4_to_f32(*(const u32x2*)(xrb + off));
            if constexpr (MODE == E_GATE) { const f32x4 tv = bf4_to_f32(*(const u32x2*)(t + off)); f32x4 sg; sg[0] = sigmoidf_(a[0]); sg[1] = sigmoidf_(a[1]); sg[2] = sigmoidf_(a[2]); sg[3] = sigmoidf_(a[3]); x = x + tv * sg; }
            else x = x + a;
            u32x2 w; w.x = cvt_pk_bf16(x[0], x[1]); w.y = cvt_pk_bf16(x[2], x[3]); *(u32x2*)(ob + off) = w;
            ssq = (x[0] * x[0] + x[1] * x[1]) + (x[2] * x[2] + x[3] * x[3]);
        }
        return ssq;
    }
    __device__ __forceinline__ void operator()(const f32x4 (&acc)[2][2][4][2], const Unit& u, int wr, int wc, int fr, int fq) const {
        const int row0 = u.pm * BM + wr * 64 + fr;
        if constexpr (PERM) {
            const int col0 = u.pn * BM + wc * 32 + 8 * fq;
            f32x4 sp[2][4];
#pragma unroll
            for (int ai = 0; ai < 2; ++ai)
#pragma unroll
                for (int m = 0; m < 4; ++m) sp[ai][m] = *(const f32x4*)(ssp_in + (size_t)(row0 + ai * HALF + m * 16) * 16 + 4 * fq);
#pragma unroll
            for (int ai = 0; ai < 2; ++ai)
#pragma unroll
                for (int m = 0; m < 4; ++m) {
                    const int row = row0 + ai * HALF + m * 16;
                    float ss = (sp[ai][m][0] + sp[ai][m][1]) + (sp[ai][m][2] + sp[ai][m][3]);
                    ss += __shfl_xor(ss, 16); ss += __shfl_xor(ss, 32);
                    const float rstd = 1.0f / sqrtf(ss * (1.0f / 1024.0f) + 1e-6f);
                    bf16_t* rowp = ob + (size_t)row * ldob + col0;
#pragma unroll
                    for (int bj = 0; bj < 2; ++bj) {
                        f32x4 v0 = acc[ai][bj][m][0] * rstd, v1 = acc[ai][bj][m][1] * rstd;
                        if constexpr (MODE == E_UP) {
#pragma unroll
                            for (int e = 0; e < 4; ++e) { float a = fmaxf(v0[e], 0.f), b = fmaxf(v1[e], 0.f); v0[e] = a * a; v1[e] = b * b; }
                        }
                        u32x4 w; w.x = cvt_pk_bf16(v0[0], v0[1]); w.y = cvt_pk_bf16(v0[2], v0[3]); w.z = cvt_pk_bf16(v1[0], v1[1]); w.w = cvt_pk_bf16(v1[2], v1[3]);
                        *(u32x4*)(rowp + bj * HALF) = w;
                    }
                }
        } else {
            const int col0 = u.pn * BM + wc * 32 + 4 * fq;
            constexpr int MB = (MODE == E_GATE) ? 1 : 2;
#pragma unroll
            for (int aim = 0; aim < 8 / MB; ++aim) {
                const int ai = aim / (4 / MB), m0 = (aim % (4 / MB)) * MB;
                f32x4 xv[4][2][2]; u32x2 xw[4][2][2]; u32x2 tv[4][2][2]; u32x2 gw[4][2][2];
#pragma unroll
                for (int m = m0; m < m0 + MB; ++m)
#pragma unroll
                    for (int bj = 0; bj < 2; ++bj)
#pragma unroll
                        for (int n = 0; n < 2; ++n) {
                            const int row = row0 + ai * HALF + m * 16, col = col0 + bj * HALF + n * 16; const size_t off = (size_t)row * 1024 + col;
                            if constexpr (MODE == E_RES || MODE == E_GATE) { if (xr) xv[m][bj][n] = *(const f32x4*)(xr + off); else xw[m][bj][n] = *(const u32x2*)(xrb + off); }
                            if constexpr (MODE == E_ATT || MODE == E_GATE) tv[m][bj][n] = *(const u32x2*)(t + off);
                            if constexpr (MODE == E_RET || MODE == E_ATT) gw[m][bj][n] = *(const u32x2*)(gate + (size_t)row * 9728 + col);
                        }
#pragma unroll
                for (int m = m0; m < m0 + MB; ++m) {
                    const int row = row0 + ai * HALF + m * 16;
                    float ssq = 0.f;
#pragma unroll
                    for (int bj = 0; bj < 2; ++bj)
#pragma unroll
                        for (int n = 0; n < 2; ++n) {
                            const int col = col0 + bj * HALF + n * 16; const size_t off = (size_t)row * 1024 + col;
                            const f32x4 a = acc[ai][bj][m][n];
                            if constexpr (MODE == E_RET || MODE == E_ATT) {
                                const u32x2 g2 = gw[m][bj][n];
                                f32x4 gv; gv[0] = sigmoidf_(bf2f(g2.x & 0xffffu)); gv[1] = sigmoidf_(bf2f(g2.x >> 16)); gv[2] = sigmoidf_(bf2f(g2.y & 0xffffu)); gv[3] = sigmoidf_(bf2f(g2.y >> 16));
                                if constexpr (MODE == E_RET) { *(u32x2*)(t + off) = f32_to_bf4(gv * a); }
                                else { const f32x4 o = bf4_to_f32(tv[m][bj][n]) + gv * a; u32x2 w; w.x = cvt_pk_bf16(o[0], o[1]); w.y = cvt_pk_bf16(o[2], o[3]); *(u32x2*)(ob + off) = w; }
                            } else if constexpr (MODE == E_PLE) {
                                *(u32x2*)(t + off) = f32_to_bf4(a);
                            } else {
                                f32x4 x = xr ? xv[m][bj][n] : bf4_to_f32(xw[m][bj][n]);
                                if constexpr (MODE == E_GATE) { f32x4 sg; sg[0] = sigmoidf_(a[0]); sg[1] = sigmoidf_(a[1]); sg[2] = sigmoidf_(a[2]); sg[3] = sigmoidf_(a[3]); x = x + bf4_to_f32(tv[m][bj][n]) * sg; }
                                else x = x + a;
                                u32x2 w; w.x = cvt_pk_bf16(x[0], x[1]); w.y = cvt_pk_bf16(x[2], x[3]); *(u32x2*)(ob + off) = w;
                                ssq += (x[0] * x[0] + x[1] * x[1]) + (x[2] * x[2] + x[3] * x[3]);
                            }
                        }
                    if constexpr (MODE == E_RES || MODE == E_GATE) {
                        ssq += __shfl_xor(ssq, 16); ssq += __shfl_xor(ssq, 32);
                        if (fq == 0) ssp_out[(size_t)row * 16 + u.pn * 4 + wc] = ssq;
                    }
                }
            }
        }
    }
};
template <class Epi, class Sched, bool ALIGN_EPI = false, bool SP2 = false>
__device__ __forceinline__ void gemm_phase(PG8_LAS unsigned char* lds, const Gemm g, const Sched& S, const Epi& E) {
    int tid_ = threadIdx.x; asm volatile("" : "+v"(tid_));
    const int tid = tid_, wid = __builtin_amdgcn_readfirstlane(tid >> 6), lane = tid & 63, wr = wid >> 2, wc = wid & 3, fr = lane & 15, fq = lane >> 4;
    const int K = g.K, nt = K / BK;
    unsigned voffA[2], voffB[2];
#pragma unroll
    for (int i = 0; i < 2; ++i) { int R, C; stage_rc(tid * 16 + i * 8192, R, C); const int Rb = Epi::PERM ? ((R & ~31) + perm32(R & 31)) : R;
        voffA[i] = (unsigned)(R * K + C) * 2u; voffB[i] = (unsigned)(Rb * K + C) * 2u; }
    const size_t kstep = (size_t)(BK * 2);
    const size_t hstep = (size_t)HALF * K * 2;
    const size_t tstep = 2 * hstep;
    const unsigned ldsw = (unsigned)wid * 1024u;
    const int aoff = lds_byte(wr * 64 + fr, fq * 8), boff = lds_byte(wc * 32 + fr, fq * 8);
#define PG8_SA(b, h) (((b) * 2 + (h)) * HTB)
#define PG8_SB(b, h) ((4 + (b) * 2 + (h)) * HTB)
#define PG8_STAGE(bufoff, gbase, voff) do { _Pragma("unroll") for (int _i = 0; _i < 2; ++_i) \
        __builtin_amdgcn_global_load_lds((const unsigned*)((const char*)(gbase) + (voff)[_i]), (PG8_LAS unsigned*)(lds + (bufoff) + ldsw + _i * 8192), 16, 0, 0); } while (0)
#define PG8_LDA(dst, b, h) do { _Pragma("unroll") for (int m = 0; m < 4; ++m) _Pragma("unroll") for (int k = 0; k < 2; ++k) dst[m][k] = *(const PG8_LAS bf16x8*)(lds + PG8_SA(b, h) + aoff + m * 2048 + k * 1024); } while (0)
#define PG8_LDB(dst, b, h) do { _Pragma("unroll") for (int n = 0; n < 2; ++n) _Pragma("unroll") for (int k = 0; k < 2; ++k) dst[n][k] = *(const PG8_LAS bf16x8*)(lds + PG8_SB(b, h) + boff + n * 2048 + k * 1024); } while (0)
#define PG8_MMA(ai, bj, At, Bt) do { __builtin_amdgcn_s_setprio(1); _Pragma("unroll") for (int m = 0; m < 4; ++m) _Pragma("unroll") for (int n = 0; n < 2; ++n) _Pragma("unroll") for (int k = 0; k < 2; ++k) \
        acc[ai][bj][m][n] = __builtin_amdgcn_mfma_f32_16x16x32_bf16(Bt[n][k], At[m][k], acc[ai][bj][m][n], 0, 0, 0); __builtin_amdgcn_s_setprio(0); } while (0)
#define PG8_WAIT_V(n) asm volatile("s_waitcnt vmcnt(" #n ")" ::: "memory")
#define PG8_WAIT_L(n) asm volatile("s_waitcnt lgkmcnt(" #n ")" ::: "memory")
#define PG8_BAR __builtin_amdgcn_s_barrier()
#define PG8_SCHED __builtin_amdgcn_sched_barrier(0)
    Unit cur, nxt; int ui = 0;
    if (!S.next(0, cur)) return;
    f32x4 acc[2][2][4][2];
#pragma unroll
    for (int a = 0; a < 2; ++a)
#pragma unroll
        for (int b = 0; b < 2; ++b)
#pragma unroll
            for (int m = 0; m < 4; ++m)
#pragma unroll
                for (int n = 0; n < 2; ++n) acc[a][b][m][n] = (f32x4){0.f, 0.f, 0.f, 0.f};
    bf16x8 At[4][2], B0[2][2], B1[2][2];
    const char* cA = (const char*)g.A + (size_t)cur.pm * tstep; const char* cB = (const char*)g.Bt + (size_t)cur.pn * tstep;
    S.a_ready(cur);
    if constexpr (SP2) {
        PG8_STAGE(PG8_SB(0, 0), cB, voffB); PG8_STAGE(PG8_SB(0, 1), cB + hstep, voffB); PG8_STAGE(PG8_SA(0, 0), cA, voffA); PG8_STAGE(PG8_SA(0, 1), cA + hstep, voffA);
        if (wr == 1) PG8_BAR;
        PG8_WAIT_V(2); PG8_BAR;
        PG8_STAGE(PG8_SB(1, 0), cB + kstep, voffB); PG8_STAGE(PG8_SA(1, 0), cA + kstep, voffA); PG8_STAGE(PG8_SB(1, 1), cB + hstep + kstep, voffB);
        PG8_WAIT_V(6); PG8_BAR;
    } else {
        PG8_STAGE(PG8_SB(0, 0), cB, voffB); PG8_STAGE(PG8_SA(0, 0), cA, voffA); PG8_STAGE(PG8_SB(0, 1), cB + hstep, voffB); PG8_STAGE(PG8_SA(0, 1), cA + hstep, voffA);
        if (wr == 1) PG8_BAR;
        PG8_WAIT_V(4); PG8_BAR;
        PG8_STAGE(PG8_SB(1, 0), cB + kstep, voffB); PG8_STAGE(PG8_SA(1, 0), cA + kstep, voffA); PG8_STAGE(PG8_SB(1, 1), cB + hstep + kstep, voffB);
        PG8_WAIT_V(6); PG8_BAR;
    }
    for (;;) {
        const bool has_next = S.next(ui + 1, nxt);
        const char* nA = has_next ? (const char*)g.A + (size_t)nxt.pm * tstep : cA; const char* nB = has_next ? (const char*)g.Bt + (size_t)nxt.pn * tstep : cB;
        for (int t = 0; t < nt; t += 2) {
            const bool last = (t == nt - 2);
            const char* a1 = cA + (size_t)(t + 1) * kstep;
            const char* a2 = last ? nA : cA + (size_t)(t + 2) * kstep; const char* b2 = last ? nB : cB + (size_t)(t + 2) * kstep;
            const char* a3 = a2 + kstep; const char* b3 = b2 + kstep;
            if (last && has_next) S.a_ready(nxt);
            if constexpr (SP2) {
            PG8_LDB(B0, 0, 0); PG8_LDB(B1, 0, 1); PG8_SCHED; PG8_LDA(At, 0, 0); PG8_STAGE(PG8_SA(1, 1), a1 + hstep, voffA);
            PG8_WAIT_V(8); PG8_WAIT_L(0); PG8_BAR; PG8_MMA(0, 0, At, B0); PG8_MMA(0, 1, At, B1); PG8_BAR; PG8_SCHED;
            PG8_LDA(At, 0, 1); PG8_STAGE(PG8_SB(0, 0), b2, voffB); PG8_STAGE(PG8_SB(0, 1), b2 + hstep, voffB); PG8_STAGE(PG8_SA(0, 0), a2, voffA);
            PG8_WAIT_V(8); PG8_WAIT_L(0); PG8_BAR; PG8_MMA(1, 0, At, B0); PG8_MMA(1, 1, At, B1); PG8_BAR; PG8_SCHED;
            PG8_LDB(B0, 1, 0); PG8_LDB(B1, 1, 1); PG8_SCHED; PG8_LDA(At, 1, 0); PG8_STAGE(PG8_SA(0, 1), a2 + hstep, voffA);
            PG8_WAIT_V(8); PG8_WAIT_L(0); PG8_BAR; PG8_MMA(0, 0, At, B0); PG8_MMA(0, 1, At, B1); PG8_BAR; PG8_SCHED;
            PG8_LDA(At, 1, 1); PG8_STAGE(PG8_SB(1, 0), b3, voffB); PG8_STAGE(PG8_SB(1, 1), b3 + hstep, voffB); PG8_STAGE(PG8_SA(1, 0), a3, voffA);
            PG8_WAIT_V(8); PG8_WAIT_L(0); PG8_BAR; PG8_MMA(1, 0, At, B0); PG8_MMA(1, 1, At, B1); PG8_BAR; PG8_SCHED;
            } else {
            PG8_LDB(B0, 0, 0); PG8_SCHED; PG8_LDA(At, 0, 0); PG8_STAGE(PG8_SA(1, 1), a1 + hstep, voffA);
            PG8_WAIT_L(8); PG8_BAR; PG8_WAIT_L(0); PG8_MMA(0, 0, At, B0); PG8_BAR; PG8_SCHED;
            PG8_LDB(B1, 0, 1); PG8_STAGE(PG8_SB(0, 0), b2, voffB);
            PG8_BAR; PG8_WAIT_L(0); PG8_MMA(0, 1, At, B1); PG8_BAR;
            PG8_LDA(At, 0, 1); PG8_STAGE(PG8_SA(0, 0), a2, voffA);
            PG8_BAR; PG8_WAIT_L(0); PG8_MMA(1, 0, At, B0); PG8_BAR; PG8_SCHED;
            PG8_STAGE(PG8_SB(0, 1), b2 + hstep, voffB);
            PG8_WAIT_V(6); PG8_BAR; PG8_MMA(1, 1, At, B1); PG8_BAR;
            PG8_LDB(B0, 1, 0); PG8_SCHED; PG8_LDA(At, 1, 0); PG8_STAGE(PG8_SA(0, 1), a2 + hstep, voffA);
            PG8_WAIT_L(8); PG8_BAR; PG8_WAIT_L(0); PG8_MMA(0, 0, At, B0); PG8_BAR; PG8_SCHED;
            PG8_LDB(B1, 1, 1); PG8_STAGE(PG8_SB(1, 0), b3, voffB);
            PG8_BAR; PG8_WAIT_L(0); PG8_MMA(0, 1, At, B1); PG8_BAR;
            PG8_LDA(At, 1, 1); PG8_STAGE(PG8_SA(1, 0), a3, voffA);
            PG8_BAR; PG8_WAIT_L(0); PG8_MMA(1, 0, At, B0); PG8_BAR; PG8_SCHED;
            PG8_STAGE(PG8_SB(1, 1), b3 + hstep, voffB);
            PG8_WAIT_V(6); PG8_BAR; PG8_MMA(1, 1, At, B1); PG8_BAR;
            }
        }
        if constexpr (ALIGN_EPI) { if (wr == 0) PG8_BAR; }
        if constexpr (!Epi::AFTER_DRAIN) { E(acc, cur, wr, wc, fr, fq); S.done(cur); }
        if (!has_next) break;
#pragma unroll
        for (int a = 0; a < 2; ++a)
#pragma unroll
            for (int b = 0; b < 2; ++b)
#pragma unroll
                for (int m = 0; m < 4; ++m)
#pragma unroll
                    for (int n = 0; n < 2; ++n) acc[a][b][m][n] = (f32x4){0.f, 0.f, 0.f, 0.f};
        cur = nxt; cA = nA; cB = nB; ++ui;
        if constexpr (ALIGN_EPI) { if (wr == 1) PG8_BAR; }
    }
    PG8_WAIT_V(0);
    if constexpr (!ALIGN_EPI) { if (wr == 0) PG8_BAR; }
    PG8_BAR;
    if constexpr (Epi::AFTER_DRAIN) { E.fused(acc, cur, wr, wc, fr, fq, lds, wid, lane); S.done(cur); }
#undef PG8_SA
#undef PG8_SB
#undef PG8_STAGE
#undef PG8_LDA
#undef PG8_LDB
#undef PG8_MMA
#undef PG8_WAIT_V
#undef PG8_WAIT_L
#undef PG8_BAR
#undef PG8_SCHED
}
}

#define LAS __attribute__((address_space(3)))
typedef unsigned short bf16_t;
typedef short bf16x8 __attribute__((ext_vector_type(8)));
typedef short v4i16_t __attribute__((ext_vector_type(4)));
typedef float f32x4 __attribute__((ext_vector_type(4)));
typedef float f32x2 __attribute__((ext_vector_type(2)));
typedef unsigned u32x4 __attribute__((ext_vector_type(4)));
typedef unsigned u32x2 __attribute__((ext_vector_type(2)));

constexpr int MP = 16384, MS = 256, MT = MP + MS;
constexpr int DM = 1024, DIN = 9728, DFF = 4096, DPLE = 256, SEQ = 8192;
constexpr int Z_RQ = 0, Z_RK = 512, Z_RV = 1024, Z_RG = 2048, Z_AQ = 3072, Z_AK = 4608, Z_AV = 6144, Z_GA = 7680, Z_GB = 8704;
constexpr int LDS_BYTES = 147456;
constexpr float QK_SCALE = 0.08838834764831845f;

constexpr size_t WT_IN = 0, WT_RET = WT_IN + (size_t)DIN * DM * 2, WT_ATT = WT_RET + (size_t)DM * DM * 2, WT_OUT = WT_ATT + (size_t)DM * 512 * 2,
                 WT_UP = WT_OUT + (size_t)DM * DM * 2, WT_DOWN = WT_UP + (size_t)DFF * DM * 2, WT_PLE = WT_DOWN + (size_t)DFF * DM * 2,
                 WT_GATE = WT_PLE + (size_t)DM * DPLE * 2, WT_LAYER = WT_GATE + (size_t)DM * DM * 2;
constexpr size_t WS_WT = 0;
constexpr size_t WS_XF = WS_WT + 2 * WT_LAYER;
constexpr size_t WS_XBA = WS_XF + (size_t)MT * DM * 4;
constexpr size_t WS_XBB = WS_XBA + (size_t)MT * DM * 2;
constexpr size_t WS_SSP = WS_XBB + (size_t)MT * DM * 2;
constexpr size_t WS_PB = WS_SSP + (size_t)MT * 16 * 4;
constexpr size_t WS_Z = WS_PB + (size_t)2 * MT * DPLE * 2;
constexpr size_t WS_ORET = WS_Z + (size_t)MT * DIN * 2;
constexpr size_t WS_OATT = WS_ORET + (size_t)MT * DM * 2;
constexpr size_t WS_MERGED = WS_OATT + (size_t)MT * 512 * 2;
constexpr size_t WS_T = WS_MERGED + (size_t)MT * DM * 2;
constexpr size_t WS_OG = WS_T + (size_t)MT * DM * 4;
constexpr size_t WS_LSE = WS_OG + (size_t)3 * MT * 512 * 4;
constexpr size_t WS_U = WS_LSE + (size_t)3 * MT * 4 * 4;
constexpr size_t WS_RP = WS_U + (size_t)512 * 32768 * 4;
constexpr size_t WS_CTL = WS_RP + (size_t)512 * 32768 * 2;
constexpr size_t WS_END = WS_CTL + 16384;

constexpr size_t O_Y = 0;
constexpr size_t O_PWK0 = (size_t)MT * DM, O_PWV0 = O_PWK0 + 262144, O_PWK1 = O_PWV0 + 262144, O_PWV1 = O_PWK1 + 1048576, O_PWK2 = O_PWV1 + 1048576, O_PWV2 = O_PWK2 + 4194304;
constexpr size_t O_PRET = O_PWV2 + 4194304;
constexpr size_t O_SWK0 = O_PRET + 524288, O_SWV0 = O_SWK0 + 4194304, O_SWK1 = O_SWV0 + 4194304, O_SWV1 = O_SWK1 + 16777216, O_SWK2 = O_SWV1 + 16777216, O_SWV2 = O_SWK2 + 67108864;
constexpr size_t O_SRET = O_SWV2 + 67108864;
constexpr size_t O_END = O_SRET + 8388608;

struct Args { const float* in[22]; float* out; unsigned char* ws; };

__device__ __forceinline__ unsigned f2bf(float f) { unsigned u = __builtin_bit_cast(unsigned, f); return (u + 0x7fffu + ((u >> 16) & 1u)) >> 16; }
__device__ __forceinline__ unsigned pk2(float lo, float hi) { return f2bf(lo) | (f2bf(hi) << 16); }
__device__ __forceinline__ float bflo(unsigned w) { return __uint_as_float(w << 16); }
__device__ __forceinline__ float bfhi(unsigned w) { return __uint_as_float(w & 0xffff0000u); }
__device__ __forceinline__ float wave_sum(float v) {
#pragma unroll
    for (int o = 1; o < 64; o <<= 1) v += __shfl_xor(v, o);
    return v;
}
__device__ __forceinline__ float ret_lg(int h) { const float A = -3.4657359028f, B = -6.2383246250f; return log1pf(-expf(A + (B - A) * (float)h * (1.0f / 3.0f))); }
__device__ __forceinline__ v4i16_t tr4(LAS const unsigned char* p) { return __builtin_amdgcn_ds_read_tr16_b64_v4i16((LAS v4i16_t*)p); }
__device__ __forceinline__ bf16x8 cat8(v4i16_t a, v4i16_t b) { return __builtin_shufflevector(a, b, 0, 1, 2, 3, 4, 5, 6, 7); }
#define MFMA16(a, b, c) __builtin_amdgcn_mfma_f32_16x16x32_bf16((a), (b), (c), 0, 0, 0)

__device__ __forceinline__ void p0_transpose_item(const float* __restrict__ W, int K, int N, bf16_t* __restrict__ WT, const float* __restrict__ gain, bool is_in, LAS float* scr, int item, int lane) {
    const int nblk = N / 64, kb = item / nblk, nb = item % nblk, k0 = 64 * kb, n0 = 64 * nb;
    const int kr = lane >> 4, nc = 4 * (lane & 15);
#pragma unroll 8
    for (int i = 0; i < 16; ++i) { const int kk = 4 * i + kr; f32x4 v = __builtin_nontemporal_load((const f32x4*)(W + (size_t)(k0 + kk) * N + n0 + nc)); if (gain) v = v * gain[k0 + kk];
        LAS float* d = scr + kk * 65 + nc; d[0] = v[0]; d[1] = v[1]; d[2] = v[2]; d[3] = v[3]; }
    asm volatile("s_waitcnt lgkmcnt(0)" ::: "memory");
    const int c = lane & 7;
#pragma unroll
    for (int j = 0; j < 8; ++j) { const int n = (lane >> 3) + 8 * j; const LAS float* s = scr + (8 * c) * 65 + n; const int ng = n0 + n;
        const float sc = (is_in && ((ng >= Z_RK && ng < Z_RV) || (ng >= Z_AQ && ng < Z_AK))) ? QK_SCALE : 1.0f;
        u32x4 o; o.x = pk2(s[0 * 65] * sc, s[1 * 65] * sc); o.y = pk2(s[2 * 65] * sc, s[3 * 65] * sc); o.z = pk2(s[4 * 65] * sc, s[5 * 65] * sc); o.w = pk2(s[6 * 65] * sc, s[7 * 65] * sc);
        *(u32x4*)(WT + (size_t)ng * K + k0 + 8 * c) = o; }
    asm volatile("s_waitcnt lgkmcnt(0)" ::: "memory");
}

__device__ __forceinline__ void p0_prologue(const Args& a, LAS unsigned char* lds, int tid) {
    const int lane = tid & 63, wave = tid >> 6;
    const int gw = blockIdx.x * 8 + wave, NGW = gridDim.x * 8;
    LAS float* scr = (LAS float*)(lds + wave * 16640);
    constexpr int I_IN = 16 * 152, I_RET = 16 * 16, I_ATT = 8 * 16, I_OUT = 16 * 16, I_UP = 16 * 64, I_DOWN = 64 * 16, I_PLE = 4 * 16, I_GATE = 16 * 16;
    constexpr int I_LAYER = I_IN + I_RET + I_ATT + I_OUT + I_UP + I_DOWN + I_PLE + I_GATE;
    for (int it = gw; it < 2 * I_LAYER; it += NGW) {
        const int l = it / I_LAYER; int r = it % I_LAYER;
        unsigned char* wl = a.ws + WS_WT + (size_t)l * WT_LAYER;
        if (r < I_IN) { p0_transpose_item(a.in[12] + (size_t)l * DM * DIN, DM, DIN, (bf16_t*)(wl + WT_IN), a.in[11] + l * DM, true, scr, r, lane); continue; } r -= I_IN;
        if (r < I_RET) { p0_transpose_item(a.in[13] + (size_t)l * DM * DM, DM, DM, (bf16_t*)(wl + WT_RET), nullptr, false, scr, r, lane); continue; } r -= I_RET;
        if (r < I_ATT) { p0_transpose_item(a.in[14] + (size_t)l * 512 * DM, 512, DM, (bf16_t*)(wl + WT_ATT), nullptr, false, scr, r, lane); continue; } r -= I_ATT;
        if (r < I_OUT) { p0_transpose_item(a.in[15] + (size_t)l * DM * DM, DM, DM, (bf16_t*)(wl + WT_OUT), nullptr, false, scr, r, lane); continue; } r -= I_OUT;
        if (r < I_UP) { p0_transpose_item(a.in[17] + (size_t)l * DM * DFF, DM, DFF, (bf16_t*)(wl + WT_UP), a.in[16] + l * DM, false, scr, r, lane); continue; } r -= I_UP;
        if (r < I_DOWN) { p0_transpose_item(a.in[18] + (size_t)l * DFF * DM, DFF, DM, (bf16_t*)(wl + WT_DOWN), nullptr, false, scr, r, lane); continue; } r -= I_DOWN;
        if (r < I_PLE) { p0_transpose_item(a.in[19] + (size_t)l * DPLE * DM, DPLE, DM, (bf16_t*)(wl + WT_PLE), nullptr, false, scr, r, lane); continue; } r -= I_PLE;
        p0_transpose_item(a.in[20] + (size_t)l * DM * DM, DM, DM, (bf16_t*)(wl + WT_GATE), nullptr, false, scr, r, lane);
    }
    bf16_t* xb = (bf16_t*)(a.ws + WS_XBA); float* ssp = (float*)(a.ws + WS_SSP);
    for (int m = gw; m < MT; m += NGW) {
        const float* src = (m < MP) ? a.in[0] + (size_t)m * DM : a.in[1] + (size_t)(m - MP) * DM;
        f32x4 v[4]; float s = 0.f;
#pragma unroll
        for (int j = 0; j < 4; ++j) { v[j] = __builtin_nontemporal_load((const f32x4*)(src + 4 * lane + 256 * j)); s += (v[j][0] * v[j][0] + v[j][1] * v[j][1]) + (v[j][2] * v[j][2] + v[j][3] * v[j][3]); }
        s = wave_sum(s);
#pragma unroll
        for (int j = 0; j < 4; ++j) { u32x2 w; w.x = pk2(v[j][0], v[j][1]); w.y = pk2(v[j][2], v[j][3]); *(u32x2*)(xb + (size_t)m * DM + 4 * lane + 256 * j) = w; }
        if (lane < 16) ssp[(size_t)m * 16 + lane] = (lane == 0) ? s : 0.f;
    }
    bf16_t* pb = (bf16_t*)(a.ws + WS_PB);
    for (int q = gw; q < 2 * MT; q += NGW) {
        const int l = q / MT, m = q % MT;
        const float* src = (m < MP) ? a.in[9] + ((size_t)l * MP + m) * DPLE : a.in[10] + ((size_t)l * MS + (m - MP)) * DPLE;
        const f32x4 v = __builtin_nontemporal_load((const f32x4*)(src + 4 * lane));
        u32x2 w; w.x = pk2(v[0], v[1]); w.y = pk2(v[2], v[3]); *(u32x2*)(pb + (size_t)q * DPLE + 4 * lane) = w;
    }
}

constexpr size_t CC_TOTAL = 2 * 64 * 128 * (size_t)(120 + 504 + 2040);
__device__ __forceinline__ void cache_copy_range(const Args& a, size_t q0, size_t q1, int tid) {
    size_t base = 0;
#pragma unroll 1
    for (int kvg = 0; kvg < 6; ++kvg) {
        const int g = kvg >> 1, W = 128 << (2 * g);
        const size_t per = (size_t)(W - 8) * 128, n = 64 * per, full = (size_t)W * 128;
        const size_t lo = q0 > base ? q0 : base, hi = q1 < base + n ? q1 : base + n;
        if (lo < hi) {
            const f32x4* src = (const f32x4*)a.in[2 + kvg];
            const size_t ooff = (kvg == 0) ? O_SWK0 : (kvg == 1) ? O_SWV0 : (kvg == 2) ? O_SWK1 : (kvg == 3) ? O_SWV1 : (kvg == 4) ? O_SWK2 : O_SWV2;
            f32x4* dst = (f32x4*)(a.out + ooff);
            size_t p = lo - base; const size_t pe = hi - base;
#pragma unroll 1
            while (p < pe) {
                const size_t lb = p / per, rem = p - lb * per;
                const size_t c0 = per - rem, c1 = pe - p, cnt = c0 < c1 ? c0 : c1;
                const f32x4* s = src + lb * full + 1024 + rem; f32x4* d = dst + lb * full + rem;
#pragma unroll 1
                for (size_t i = tid; i < cnt; i += 512 * 16) {
                    f32x4 v[16];
#pragma unroll
                    for (int k = 0; k < 16; ++k) if (i + k * 512 < cnt) v[k] = __builtin_nontemporal_load(s + i + k * 512);
#pragma unroll
                    for (int k = 0; k < 16; ++k) if (i + k * 512 < cnt) __builtin_nontemporal_store(v[k], d + i + k * 512);
                }
                p += cnt;
            }
        }
        base += n;
    }
}
__device__ __forceinline__ void cache_copy_tail(const Args& a, int nwg, int f0, int f1, int tid) {
    const int G = gridDim.x, fi = nwg % G, c = blockIdx.x;
    if (c < fi) return;
    const size_t R0 = CC_TOTAL * (size_t)f0 / 1000, R1 = CC_TOTAL * (size_t)f1 / 1000, nidle = (size_t)(G - fi), idx = (size_t)(c - fi);
    cache_copy_range(a, R0 + (R1 - R0) * idx / nidle, R0 + (R1 - R0) * (idx + 1) / nidle, tid);
}

constexpr int KVS = 272;
constexpr int AT_VOFF = 256 * KVS;
__device__ __forceinline__ void attn_prompt_item(LAS unsigned char* lds, const bf16_t* __restrict__ z, bf16_t* __restrict__ og, float* __restrict__ lse, int item, int tid) {
    const int wid = __builtin_amdgcn_readfirstlane(tid >> 6), lane = tid & 63, fr = lane & 15, quad = lane >> 4;
    const int blk = item & 63; int rest = item >> 6; const int j = rest & 3; rest >>= 2; const int g = rest % 3, b = rest / 3;
    const int dsh = 2 * g, dil = 1 << dsh, r = blk >> (6 - dsh), qb = blk & ((64 >> dsh) - 1), hh = g * 4 + j;
    const float slope_d = exp2f(-8.0f * (float)(hh + 1) / 12.0f) * (float)dil;
    const bf16_t* zb = z + (size_t)b * SEQ * DIN;
#pragma unroll
    for (int it = 0; it < 8; ++it) {
        const int idx = tid + it * 512, kk = idx >> 4, ch = idx & 15, sp = 128 * qb - 128 + kk;
        u32x4 kv = {0u, 0u, 0u, 0u}, vv = {0u, 0u, 0u, 0u};
        if (sp >= 0) { const bf16_t* zr = zb + (size_t)(sp * dil + r) * DIN + hh * 128 + ch * 8; kv = *(const u32x4*)(zr + Z_AK); vv = *(const u32x4*)(zr + Z_AV); }
        *(LAS u32x4*)(lds + kk * KVS + ch * 16) = kv; *(LAS u32x4*)(lds + AT_VOFF + kk * KVS + ch * 16) = vv;
    }
    const int sq = 128 * qb + 16 * wid + fr;
    const size_t qrow = (size_t)b * SEQ + (size_t)(sq * dil + r);
    bf16x8 qf[4];
#pragma unroll
    for (int ks = 0; ks < 4; ++ks) qf[ks] = *(const bf16x8*)(z + qrow * DIN + Z_AQ + hh * 128 + ks * 32 + quad * 8);
    __syncthreads();
    f32x4 sc[9];
#pragma unroll
    for (int kt = 0; kt < 9; ++kt) {
        f32x4 acc = {0.f, 0.f, 0.f, 0.f};
#pragma unroll
        for (int ks = 0; ks < 4; ++ks) { const bf16x8 ka = *(LAS const bf16x8*)(lds + (16 * (wid + kt) + fr) * KVS + ks * 64 + quad * 16); acc = MFMA16(ka, qf[ks], acc); }
        sc[kt] = acc;
    }
    float mx = -INFINITY;
#pragma unroll
    for (int kt = 0; kt < 9; ++kt)
#pragma unroll
        for (int e = 0; e < 4; ++e) {
            const int dist = 128 - 16 * kt + fr - 4 * quad - e, keyrel = 16 * (wid + kt) + 4 * quad + e;
            const bool valid = (dist >= 0) && (dist <= 128) && (qb > 0 || keyrel >= 128);
            const float s = valid ? sc[kt][e] - slope_d * (float)dist : -INFINITY;
            sc[kt][e] = s; mx = fmaxf(mx, s);
        }
    mx = fmaxf(mx, __shfl_xor(mx, 16)); mx = fmaxf(mx, __shfl_xor(mx, 32));
    float den = 0.f;
#pragma unroll
    for (int kt = 0; kt < 9; ++kt)
#pragma unroll
        for (int e = 0; e < 4; ++e) { const float p = __expf(sc[kt][e] - mx); sc[kt][e] = p; den += p; }
    den += __shfl_xor(den, 16); den += __shfl_xor(den, 32);
    const float inv = 1.0f / den;
    f32x4 o[8];
#pragma unroll
    for (int dt = 0; dt < 8; ++dt) o[dt] = (f32x4){0.f, 0.f, 0.f, 0.f};
#pragma unroll
    for (int kp = 0; kp < 5; ++kp) {
        const int TA = wid + 2 * kp, TB = (2 * kp + 1 < 9) ? TA + 1 : TA;
        u32x4 pw; pw.x = pk2(sc[2 * kp][0] * inv, sc[2 * kp][1] * inv); pw.y = pk2(sc[2 * kp][2] * inv, sc[2 * kp][3] * inv);
        if (2 * kp + 1 < 9) { pw.z = pk2(sc[(2 * kp + 1) % 9][0] * inv, sc[(2 * kp + 1) % 9][1] * inv); pw.w = pk2(sc[(2 * kp + 1) % 9][2] * inv, sc[(2 * kp + 1) % 9][3] * inv); } else { pw.z = 0u; pw.w = 0u; }
        const bf16x8 p8 = __builtin_bit_cast(bf16x8, pw);
        LAS const unsigned char* bA = lds + AT_VOFF + (16 * TA + 4 * quad + (fr >> 2)) * KVS + (fr & 3) * 8;
        LAS const unsigned char* bB = lds + AT_VOFF + (16 * TB + 4 * quad + (fr >> 2)) * KVS + (fr & 3) * 8;
#pragma unroll
        for (int dt = 0; dt < 8; ++dt) { const v4i16_t va = tr4(bA + dt * 32), vb = tr4(bB + dt * 32); o[dt] = MFMA16(cat8(va, vb), p8, o[dt]); }
    }
    bf16_t* orow = og + ((size_t)g * MT + qrow) * 512 + j * 128 + 4 * quad;
#pragma unroll
    for (int dt = 0; dt < 8; ++dt) { u32x2 w; w.x = pk2(o[dt][0], o[dt][1]); w.y = pk2(o[dt][2], o[dt][3]); *(u32x2*)(orow + 16 * dt) = w; }
    if (quad == 0) lse[((size_t)g * MT + qrow) * 4 + j] = mx + __logf(den);
    __syncthreads();
}

constexpr int RVS = 528;
constexpr int RU_VOFF = 128 * KVS;
__device__ __forceinline__ void ret_u_item(LAS unsigned char* lds, const bf16_t* __restrict__ z, bf16_t* __restrict__ U, int item, int tid) {
    const int wid = __builtin_amdgcn_readfirstlane(tid >> 6), lane = tid & 63, fr = lane & 15, quad = lane >> 4;
    const int c = item & 63, bh = item >> 6, h = bh & 3, b = bh >> 2;
    const float lg = ret_lg(h);
    const bf16_t* z0 = z + ((size_t)b * SEQ + 128 * c) * DIN;
#pragma unroll
    for (int it = 0; it < 4; ++it) {
        const int idx = tid + it * 512, jj = idx >> 4, ch = idx & 15;
        const u32x4 kv = *(const u32x4*)(z0 + (size_t)jj * DIN + Z_RK + h * 128 + ch * 8);
        const float zeta = __expf(lg * (float)(127 - jj));
        u32x4 o; o.x = pk2(bflo(kv.x) * zeta, bfhi(kv.x) * zeta); o.y = pk2(bflo(kv.y) * zeta, bfhi(kv.y) * zeta); o.z = pk2(bflo(kv.z) * zeta, bfhi(kv.z) * zeta); o.w = pk2(bflo(kv.w) * zeta, bfhi(kv.w) * zeta);
        *(LAS u32x4*)(lds + jj * KVS + ch * 16) = o;
    }
#pragma unroll
    for (int it = 0; it < 8; ++it) {
        const int idx = tid + it * 512, jj = idx >> 5, ch = idx & 31;
        *(LAS u32x4*)(lds + RU_VOFF + jj * RVS + ch * 16) = *(const u32x4*)(z0 + (size_t)jj * DIN + Z_RV + h * 256 + ch * 8);
    }
    __syncthreads();
    f32x4 acc[2][8];
#pragma unroll
    for (int a = 0; a < 2; ++a)
#pragma unroll
        for (int d = 0; d < 8; ++d) acc[a][d] = (f32x4){0.f, 0.f, 0.f, 0.f};
#pragma unroll
    for (int ks = 0; ks < 4; ++ks) {
        const int jrow = 32 * ks + 8 * quad + (fr >> 2);
        bf16x8 A[2];
#pragma unroll
        for (int a = 0; a < 2; ++a) { LAS const unsigned char* p = lds + RU_VOFF + jrow * RVS + (16 * (2 * wid + a) + 4 * (fr & 3)) * 2; A[a] = cat8(tr4(p), tr4(p + 4 * RVS)); }
#pragma unroll
        for (int d = 0; d < 8; ++d) { LAS const unsigned char* p = lds + jrow * KVS + (16 * d + 4 * (fr & 3)) * 2; const bf16x8 B = cat8(tr4(p), tr4(p + 4 * KVS));
            acc[0][d] = MFMA16(B, A[0], acc[0][d]); acc[1][d] = MFMA16(B, A[1], acc[1][d]); }
    }
    bf16_t* Uo = U + (size_t)item * 32768;
#pragma unroll
    for (int a = 0; a < 2; ++a)
#pragma unroll
        for (int d = 0; d < 8; ++d) { u32x2 w; w.x = pk2(acc[a][d][0], acc[a][d][1]); w.y = pk2(acc[a][d][2], acc[a][d][3]); *(u32x2*)(Uo + (16 * (2 * wid + a) + fr) * 128 + 16 * d + 4 * quad) = w; }
    __syncthreads();
}

__device__ __forceinline__ void ret_sample_item(LAS unsigned char* lds, const bf16_t* __restrict__ z, const float* __restrict__ S0, float* __restrict__ Sout, bf16_t* __restrict__ oret, int item, int tid) {
    const int h = item & 3, b = item >> 2;
    const int lane = tid & 63, wave = tid >> 6;
    const float lg = ret_lg(h);
    LAS float* qs = (LAS float*)lds;
    LAS float* ksm = qs + 1024;
    LAS float* Pm = ksm + 1024;
    LAS float* red = Pm + 64;
    LAS float* ob = red + 4096;
    const bf16_t* z0 = z + (size_t)(MP + b * 8) * DIN;
    for (int idx = tid; idx < 1024; idx += 512) { const int i = idx >> 7, d = idx & 127; qs[idx] = __uint_as_float((unsigned)z0[(size_t)i * DIN + Z_RQ + h * 128 + d] << 16); ksm[idx] = __uint_as_float((unsigned)z0[(size_t)i * DIN + Z_RK + h * 128 + d] << 16); }
    const int v = tid & 255, half = tid >> 8;
    float vv[8], vz[8];
#pragma unroll
    for (int jj = 0; jj < 8; ++jj) { vv[jj] = __uint_as_float((unsigned)z0[(size_t)jj * DIN + Z_RV + h * 256 + v] << 16); vz[jj] = vv[jj] * __expf(lg * (float)(7 - jj)); }
    __syncthreads();
    if (tid < 64) { const int i = tid >> 3, jj = tid & 7; float s = 0.f; for (int d = 0; d < 128; ++d) s += qs[i * 128 + d] * ksm[jj * 128 + d]; Pm[tid] = (jj <= i) ? s * __expf(lg * (float)(i - jj)) : 0.f; }
    const float cd = __expf(lg * 8.0f);
    float cr[8];
#pragma unroll
    for (int i = 0; i < 8; ++i) cr[i] = 0.f;
    const float* Sp = S0 + (size_t)item * 32768 + v; float* So = Sout + (size_t)item * 32768 + v;
#pragma unroll 16
    for (int dd = 0; dd < 64; ++dd) {
        const int d = half * 64 + dd;
        const float s = __builtin_nontemporal_load(Sp + (size_t)d * 256);
        float nw = cd * s;
#pragma unroll
        for (int i = 0; i < 8; ++i) { cr[i] += qs[i * 128 + d] * s; nw += ksm[i * 128 + d] * vz[i]; }
        __builtin_nontemporal_store(nw, So + (size_t)d * 256);
    }
#pragma unroll
    for (int i = 0; i < 8; ++i) red[(half * 8 + i) * 256 + v] = cr[i];
    __syncthreads();
#pragma unroll
    for (int ii = 0; ii < 4; ++ii) {
        const int i = half * 4 + ii;
        float o = (red[i * 256 + v] + red[(8 + i) * 256 + v]) * __expf(lg * (float)(i + 1));
#pragma unroll
        for (int jj = 0; jj < 8; ++jj) o += Pm[i * 8 + jj] * vv[jj];
        ob[i * 256 + v] = o;
    }
    __syncthreads();
    {
        const int i = wave; float x[4]; float s = 0.f;
#pragma unroll
        for (int e = 0; e < 4; ++e) { x[e] = ob[i * 256 + 4 * lane + e]; s += x[e]; }
        const float mu = wave_sum(s) * (1.0f / 256.0f); float q = 0.f;
#pragma unroll
        for (int e = 0; e < 4; ++e) { x[e] -= mu; q += x[e] * x[e]; }
        const float rstd = 1.0f / sqrtf(wave_sum(q) * (1.0f / 256.0f) + 1e-6f);
        const u32x2 gw = *(const u32x2*)(z0 + (size_t)i * DIN + Z_RG + h * 256 + 4 * lane);
        float gq[4] = {bflo(gw.x), bfhi(gw.x), bflo(gw.y), bfhi(gw.y)};
#pragma unroll
        for (int e = 0; e < 4; ++e) x[e] = x[e] * rstd * gq[e] / (1.0f + __expf(-gq[e]));
        u32x2 w; w.x = pk2(x[0], x[1]); w.y = pk2(x[2], x[3]);
        *(u32x2*)(oret + (size_t)(MP + b * 8 + i) * DM + h * 256 + 4 * lane) = w;
    }
    __syncthreads();
}

__device__ __forceinline__ void attn_sample_item(LAS unsigned char* lds, const bf16_t* __restrict__ z, const float* __restrict__ ck, const float* __restrict__ cv, int l, bf16_t* __restrict__ og, float* __restrict__ lse, int item, int tid) {
    const int j = item & 3; int rest = item >> 2; const int g = rest % 3, b = rest / 3;
    const int lane = tid & 63, i = tid >> 6, dsh = 2 * g, dil = 1 << dsh, W = 128 << dsh, hh = g * 4 + j;
    const float slope_d = exp2f(-8.0f * (float)(hh + 1) / 12.0f) * (float)dil;
    LAS float* sc = (LAS float*)lds + i * 136;
    const size_t zrow = (size_t)MP + b * 8 + i;
    const bf16_t* zq = z + zrow * DIN + Z_AQ + hh * 128;
    const int c16 = lane & 15, rr = lane >> 4;
    float q[8];
    { const u32x2 a0 = *(const u32x2*)(zq + 4 * c16), a1 = *(const u32x2*)(zq + 64 + 4 * c16);
      q[0] = bflo(a0.x); q[1] = bfhi(a0.x); q[2] = bflo(a0.y); q[3] = bfhi(a0.y); q[4] = bflo(a1.x); q[5] = bfhi(a1.x); q[6] = bflo(a1.y); q[7] = bfhi(a1.y); }
    const float* ckb = ck + ((size_t)(l * 32 + b) * W) * 512 + j * 128 + 4 * c16;
    const float* cvb = cv + ((size_t)(l * 32 + b) * W) * 512 + j * 128 + 4 * c16;
    const bf16_t* znew = z + (size_t)(MP + b * 8) * DIN + hh * 128 + 4 * c16;
    const size_t rstride = (size_t)dil * 512 * 4;
    const float* kp0 = ckb + (size_t)(i + rr * dil) * 512;
#pragma unroll 1
    for (int bt = 0; bt < 2; ++bt) {
        f32x4 k0[15], k1[15];
#pragma unroll
        for (int t = 0; t < 15; ++t) { const float* p = kp0 + (size_t)(bt * 15 + t) * rstride; k0[t] = __builtin_nontemporal_load((const f32x4*)p); k1[t] = __builtin_nontemporal_load((const f32x4*)(p + 64)); }
#pragma unroll
        for (int t = 0; t < 15; ++t) {
            float s = (q[0] * k0[t][0] + q[1] * k0[t][1]) + (q[2] * k0[t][2] + q[3] * k0[t][3]) + (q[4] * k1[t][0] + q[5] * k1[t][1]) + (q[6] * k1[t][2] + q[7] * k1[t][3]);
            s += __shfl_xor(s, 1); s += __shfl_xor(s, 2); s += __shfl_xor(s, 4); s += __shfl_xor(s, 8);
            const int u = 4 * (bt * 15 + t) + rr;
            if (c16 == 0) sc[u] = s - slope_d * (float)(128 - u);
        }
    }
#pragma unroll
    for (int it = 30; it < 33; ++it) {
        const int u = 4 * it + rr; float s = 0.f;
        if (u <= 128) {
            const int index = i + u * dil;
            float k[8];
            if (index < W) { const f32x4 a0 = *(const f32x4*)(ckb + (size_t)index * 512), a1 = *(const f32x4*)(ckb + (size_t)index * 512 + 64);
                k[0] = a0[0]; k[1] = a0[1]; k[2] = a0[2]; k[3] = a0[3]; k[4] = a1[0]; k[5] = a1[1]; k[6] = a1[2]; k[7] = a1[3]; }
            else { const bf16_t* zk = znew + (size_t)(index - W) * DIN + Z_AK; const u32x2 a0 = *(const u32x2*)zk, a1 = *(const u32x2*)(zk + 64);
                k[0] = bflo(a0.x); k[1] = bfhi(a0.x); k[2] = bflo(a0.y); k[3] = bfhi(a0.y); k[4] = bflo(a1.x); k[5] = bfhi(a1.x); k[6] = bflo(a1.y); k[7] = bfhi(a1.y); }
#pragma unroll
            for (int e = 0; e < 8; ++e) s += q[e] * k[e];
        }
        s += __shfl_xor(s, 1); s += __shfl_xor(s, 2); s += __shfl_xor(s, 4); s += __shfl_xor(s, 8);
        if (c16 == 0 && u <= 128) sc[u] = s - slope_d * (float)(128 - u);
    }
    asm volatile("s_waitcnt lgkmcnt(0)" ::: "memory");
    __syncthreads();
    float s0 = sc[lane], s1 = sc[lane + 64], s2 = (lane == 0) ? sc[128] : -INFINITY;
    float mx = fmaxf(fmaxf(s0, s1), s2);
#pragma unroll
    for (int o = 1; o < 64; o <<= 1) mx = fmaxf(mx, __shfl_xor(mx, o));
    s0 = __expf(s0 - mx); s1 = __expf(s1 - mx); s2 = __expf(s2 - mx);
    const float den = wave_sum(s0 + s1 + s2), inv = 1.0f / den;
    __syncthreads();
    sc[lane] = s0 * inv; sc[lane + 64] = s1 * inv; if (lane == 0) sc[128] = s2 * inv;
    if (lane >= 1 && lane < 4) sc[128 + lane] = 0.f;
    asm volatile("s_waitcnt lgkmcnt(0)" ::: "memory");
    __syncthreads();
    float o[8];
#pragma unroll
    for (int e = 0; e < 8; ++e) o[e] = 0.f;
    const float* vp0 = cvb + (size_t)(i + rr * dil) * 512;
#pragma unroll 1
    for (int bt = 0; bt < 2; ++bt) {
        f32x4 v0[15], v1[15];
#pragma unroll
        for (int t = 0; t < 15; ++t) { const float* p = vp0 + (size_t)(bt * 15 + t) * rstride; v0[t] = __builtin_nontemporal_load((const f32x4*)p); v1[t] = __builtin_nontemporal_load((const f32x4*)(p + 64)); }
#pragma unroll
        for (int t = 0; t < 15; ++t) { const float p = sc[4 * (bt * 15 + t) + rr];
#pragma unroll
            for (int e = 0; e < 4; ++e) { o[e] += p * v0[t][e]; o[4 + e] += p * v1[t][e]; } }
    }
#pragma unroll
    for (int it = 30; it < 33; ++it) {
        const int u = 4 * it + rr;
        if (u <= 128) {
            const int index = i + u * dil; const float p = sc[u];
            float v[8];
            if (index < W) { const f32x4 a0 = *(const f32x4*)(cvb + (size_t)index * 512), a1 = *(const f32x4*)(cvb + (size_t)index * 512 + 64);
                v[0] = a0[0]; v[1] = a0[1]; v[2] = a0[2]; v[3] = a0[3]; v[4] = a1[0]; v[5] = a1[1]; v[6] = a1[2]; v[7] = a1[3]; }
            else { const bf16_t* zv = znew + (size_t)(index - W) * DIN + Z_AV; const u32x2 a0 = *(const u32x2*)zv, a1 = *(const u32x2*)(zv + 64);
                v[0] = bflo(a0.x); v[1] = bfhi(a0.x); v[2] = bflo(a0.y); v[3] = bfhi(a0.y); v[4] = bflo(a1.x); v[5] = bfhi(a1.x); v[6] = bflo(a1.y); v[7] = bfhi(a1.y); }
#pragma unroll
            for (int e = 0; e < 8; ++e) o[e] += p * v[e];
        }
    }
#pragma unroll
    for (int e = 0; e < 8; ++e) { o[e] += __shfl_xor(o[e], 16); o[e] += __shfl_xor(o[e], 32); }
    if (rr == 0) {
        bf16_t* op = og + ((size_t)g * MT + zrow) * 512 + j * 128 + 4 * c16;
        u32x2 w0, w1; w0.x = pk2(o[0], o[1]); w0.y = pk2(o[2], o[3]); w1.x = pk2(o[4], o[5]); w1.y = pk2(o[6], o[7]);
        *(u32x2*)op = w0; *(u32x2*)(op + 64) = w1;
    }
    if (lane == 0) lse[((size_t)g * MT + zrow) * 4 + j] = mx + __logf(den);
    __syncthreads();
}

__device__ __forceinline__ void win_copy(const Args& a, const bf16_t* __restrict__ z, int l, int tid) {
    const int lane = tid & 63, gw = blockIdx.x * 8 + (tid >> 6), NGW = gridDim.x * 8;
    for (int idx = gw; idx < 12288; idx += NGW) {
        const int kv = idx / 6144; int rem = idx % 6144;
        size_t zrow; int g; float* dst;
        if (rem < 5376) {
            int W, bw;
            if (rem < 256) { g = 0; W = 128; bw = rem; } else if (rem < 1280) { g = 1; W = 512; bw = rem - 256; } else { g = 2; W = 2048; bw = rem - 1280; }
            const int b = bw / W, w = bw % W;
            zrow = (size_t)b * SEQ + (SEQ - W) + w;
            const size_t ooff = (g == 0) ? (kv ? O_PWV0 : O_PWK0) : (g == 1) ? (kv ? O_PWV1 : O_PWK1) : (kv ? O_PWV2 : O_PWK2);
            dst = a.out + ooff + (((size_t)l * 2 + b) * W + w) * 512;
        } else {
            rem -= 5376; g = rem >> 8; const int b = (rem & 255) >> 3, i = rem & 7, W = 128 << (2 * g);
            zrow = (size_t)MP + b * 8 + i;
            const size_t ooff = (g == 0) ? (kv ? O_SWV0 : O_SWK0) : (g == 1) ? (kv ? O_SWV1 : O_SWK1) : (kv ? O_SWV2 : O_SWK2);
            dst = a.out + ooff + (((size_t)l * 32 + b) * W + (W - 8) + i) * 512;
        }
        const u32x4 w4 = *(const u32x4*)(z + zrow * DIN + (kv ? Z_AV : Z_AK) + g * 512 + 8 * lane);
        __builtin_nontemporal_store((f32x4){bflo(w4.x), bfhi(w4.x), bflo(w4.y), bfhi(w4.y)}, (f32x4*)(dst + 8 * lane));
        __builtin_nontemporal_store((f32x4){bflo(w4.z), bfhi(w4.z), bflo(w4.w), bfhi(w4.w)}, (f32x4*)(dst + 8 * lane + 4));
    }
}

template <bool DO_SCAN, bool DO_COMBINE>
__device__ __forceinline__ void p3_scan_combine(const Args& a, int l, int tid) {
    const bf16_t* U = (const bf16_t*)(a.ws + WS_U); bf16_t* Rp = (bf16_t*)(a.ws + WS_RP);
    const int gt = blockIdx.x * 512 + tid, GT = gridDim.x * 512;
    if constexpr (DO_SCAN) for (int e = gt; e < 131072; e += GT) {
        const int vd = e & 32767, bh0 = e >> 15, bh1 = bh0 + 4, h = bh0 & 3;
        const float cd = __expf(ret_lg(h) * 128.0f);
        float R0 = 0.f, R1 = 0.f;
        const bf16_t* up0 = U + (size_t)bh0 * 64 * 32768 + vd; bf16_t* rp0 = Rp + (size_t)bh0 * 64 * 32768 + vd;
        const bf16_t* up1 = U + (size_t)bh1 * 64 * 32768 + vd; bf16_t* rp1 = Rp + (size_t)bh1 * 64 * 32768 + vd;
#pragma unroll 1
        for (int c0 = 0; c0 < 64; c0 += 16) {
            float u0[16], u1[16];
#pragma unroll
            for (int k = 0; k < 16; ++k) { u0[k] = __uint_as_float((unsigned)up0[(size_t)(c0 + k) * 32768] << 16); u1[k] = __uint_as_float((unsigned)up1[(size_t)(c0 + k) * 32768] << 16); }
#pragma unroll
            for (int k = 0; k < 16; ++k) { rp0[(size_t)(c0 + k) * 32768] = (bf16_t)f2bf(R0); R0 = cd * R0 + u0[k]; rp1[(size_t)(c0 + k) * 32768] = (bf16_t)f2bf(R1); R1 = cd * R1 + u1[k]; }
        }
        const int v = vd >> 7, d = vd & 127;
        a.out[O_PRET + ((size_t)l * 8 + bh0) * 32768 + d * 256 + v] = R0;
        a.out[O_PRET + ((size_t)l * 8 + bh1) * 32768 + d * 256 + v] = R1;
    }
    const bf16_t* og = (const bf16_t*)(a.ws + WS_OG); const float* lse = (const float*)(a.ws + WS_LSE); bf16_t* oatt = (bf16_t*)(a.ws + WS_OATT);
    const int lane = tid & 63, gw = blockIdx.x * 8 + (tid >> 6), NGW = gridDim.x * 8;
    if constexpr (DO_COMBINE) for (int row0 = gw; row0 < MT; row0 += 2 * NGW) {
        const int j = lane >> 4;
        u32x4 q[2][3]; float ls[2][3];
#pragma unroll
        for (int rr = 0; rr < 2; ++rr) { const int row = (row0 + rr * NGW < MT) ? row0 + rr * NGW : row0;
#pragma unroll
            for (int g = 0; g < 3; ++g) { ls[rr][g] = lse[((size_t)g * MT + row) * 4 + j]; q[rr][g] = *(const u32x4*)(og + ((size_t)g * MT + row) * 512 + 8 * lane); } }
#pragma unroll
        for (int rr = 0; rr < 2; ++rr) {
            const int row = row0 + rr * NGW; if (row >= MT) break;
            const float mx = fmaxf(ls[rr][0], fmaxf(ls[rr][1], ls[rr][2]));
            float w0 = __expf(ls[rr][0] - mx), w1 = __expf(ls[rr][1] - mx), w2 = __expf(ls[rr][2] - mx);
            const float inv = 1.0f / (w0 + w1 + w2); w0 *= inv; w1 *= inv; w2 *= inv;
            const u32x4 q0 = q[rr][0], q1 = q[rr][1], q2 = q[rr][2];
            const f32x4 a0 = {bflo(q0.x), bfhi(q0.x), bflo(q0.y), bfhi(q0.y)}, a1 = {bflo(q0.z), bfhi(q0.z), bflo(q0.w), bfhi(q0.w)};
            const f32x4 b0 = {bflo(q1.x), bfhi(q1.x), bflo(q1.y), bfhi(q1.y)}, b1 = {bflo(q1.z), bfhi(q1.z), bflo(q1.w), bfhi(q1.w)};
            const f32x4 c0_ = {bflo(q2.x), bfhi(q2.x), bflo(q2.y), bfhi(q2.y)}, c1_ = {bflo(q2.z), bfhi(q2.z), bflo(q2.w), bfhi(q2.w)};
            const f32x4 r0 = a0 * w0 + b0 * w1 + c0_ * w2, r1 = a1 * w0 + b1 * w1 + c1_ * w2;
            u32x4 w; w.x = pk2(r0[0], r0[1]); w.y = pk2(r0[2], r0[3]); w.z = pk2(r1[0], r1[1]); w.w = pk2(r1[2], r1[3]);
            *(u32x4*)(oatt + (size_t)row * 512 + 8 * lane) = w;
        }
    }
}

constexpr int RO_VOFF = 128 * KVS, RO_ROFF = RO_VOFF + 128 * RVS;
__device__ __forceinline__ void ret_out_item(LAS unsigned char* lds, const bf16_t* __restrict__ z, const bf16_t* __restrict__ Rp, bf16_t* __restrict__ oret, int item, int tid) {
    const int wid = __builtin_amdgcn_readfirstlane(tid >> 6), lane = tid & 63, fr = lane & 15, quad = lane >> 4;
    const int c = item & 63, bh = item >> 6, h = bh & 3, b = bh >> 2;
    const float lg = ret_lg(h);
    const size_t zrow0 = (size_t)b * SEQ + 128 * c;
    const bf16_t* z0 = z + zrow0 * DIN;
    const bf16_t* R0 = Rp + (size_t)item * 32768;
#pragma unroll
    for (int it = 0; it < 4; ++it) {
        const int idx = tid + it * 512, jj = idx >> 4, ch = idx & 15;
        *(LAS u32x4*)(lds + jj * KVS + ch * 16) = *(const u32x4*)(z0 + (size_t)jj * DIN + Z_RK + h * 128 + ch * 8);
        *(LAS u32x4*)(lds + RO_ROFF + jj * KVS + ch * 16) = *(const u32x4*)(R0 + (size_t)jj * 128 + ch * 8);
    }
#pragma unroll
    for (int it = 0; it < 8; ++it) {
        const int idx = tid + it * 512, jj = idx >> 5, ch = idx & 31;
        *(LAS u32x4*)(lds + RO_VOFF + jj * RVS + ch * 16) = *(const u32x4*)(z0 + (size_t)jj * DIN + Z_RV + h * 256 + ch * 8);
    }
    const int iq = 16 * wid + fr;
    bf16x8 qf[4];
#pragma unroll
    for (int ks = 0; ks < 4; ++ks) qf[ks] = *(const bf16x8*)(z0 + (size_t)iq * DIN + Z_RQ + h * 128 + ks * 32 + quad * 8);
    __syncthreads();
    f32x4 o[16];
#pragma unroll
    for (int vt = 0; vt < 16; ++vt) o[vt] = (f32x4){0.f, 0.f, 0.f, 0.f};
#pragma unroll
    for (int vt = 0; vt < 8; ++vt)
#pragma unroll
        for (int ks = 0; ks < 4; ++ks) { const bf16x8 ra = *(LAS const bf16x8*)(lds + RO_ROFF + (16 * vt + fr) * KVS + ks * 64 + quad * 16); o[vt] = MFMA16(ra, qf[ks], o[vt]); }
    __syncthreads();
#pragma unroll
    for (int it = 0; it < 4; ++it) {
        const int idx = tid + it * 512, jj = idx >> 4, ch = idx & 15;
        *(LAS u32x4*)(lds + RO_ROFF + jj * KVS + ch * 16) = *(const u32x4*)(R0 + (size_t)(128 + jj) * 128 + ch * 8);
    }
    __syncthreads();
#pragma unroll
    for (int vt = 0; vt < 8; ++vt)
#pragma unroll
        for (int ks = 0; ks < 4; ++ks) { const bf16x8 ra = *(LAS const bf16x8*)(lds + RO_ROFF + (16 * vt + fr) * KVS + ks * 64 + quad * 16); o[8 + vt] = MFMA16(ra, qf[ks], o[8 + vt]); }
    const float xi = __expf(lg * (float)(iq + 1));
#pragma unroll
    for (int vt = 0; vt < 16; ++vt) o[vt] = o[vt] * xi;
#pragma unroll
    for (int kp = 0; kp < 4; ++kp) {
        if (2 * kp <= wid) {
            const bool hasB = (2 * kp + 1 <= wid);
            const int TA = 2 * kp, TB = hasB ? TA + 1 : TA;
            f32x4 sa = {0.f, 0.f, 0.f, 0.f}, sb = {0.f, 0.f, 0.f, 0.f};
#pragma unroll
            for (int ks = 0; ks < 4; ++ks) {
                const bf16x8 ka = *(LAS const bf16x8*)(lds + (16 * TA + fr) * KVS + ks * 64 + quad * 16); sa = MFMA16(ka, qf[ks], sa);
                const bf16x8 kb = *(LAS const bf16x8*)(lds + (16 * TB + fr) * KVS + ks * 64 + quad * 16); sb = MFMA16(kb, qf[ks], sb);
            }
#pragma unroll
            for (int e = 0; e < 4; ++e) {
                const int da = iq - (16 * TA + 4 * quad + e), db = iq - (16 * TB + 4 * quad + e);
                sa[e] = (da >= 0) ? sa[e] * __expf(lg * (float)da) : 0.f;
                sb[e] = (hasB && db >= 0) ? sb[e] * __expf(lg * (float)db) : 0.f;
            }
            u32x4 pw; pw.x = pk2(sa[0], sa[1]); pw.y = pk2(sa[2], sa[3]); pw.z = pk2(sb[0], sb[1]); pw.w = pk2(sb[2], sb[3]);
            const bf16x8 p8 = __builtin_bit_cast(bf16x8, pw);
            LAS const unsigned char* bA = lds + RO_VOFF + (16 * TA + 4 * quad + (fr >> 2)) * RVS + (fr & 3) * 8;
            LAS const unsigned char* bB = lds + RO_VOFF + (16 * TB + 4 * quad + (fr >> 2)) * RVS + (fr & 3) * 8;
#pragma unroll
            for (int vt = 0; vt < 16; ++vt) { const v4i16_t va = tr4(bA + vt * 32), vb = tr4(bB + vt * 32); o[vt] = MFMA16(cat8(va, vb), p8, o[vt]); }
        }
    }
    float s = 0.f;
#pragma unroll
    for (int vt = 0; vt < 16; ++vt) s += (o[vt][0] + o[vt][1]) + (o[vt][2] + o[vt][3]);
    s += __shfl_xor(s, 16); s += __shfl_xor(s, 32);
    const float mu = s * (1.0f / 256.0f); float qv = 0.f;
#pragma unroll
    for (int vt = 0; vt < 16; ++vt) { o[vt] = o[vt] - mu; qv += (o[vt][0] * o[vt][0] + o[vt][1] * o[vt][1]) + (o[vt][2] * o[vt][2] + o[vt][3] * o[vt][3]); }
    qv += __shfl_xor(qv, 16); qv += __shfl_xor(qv, 32);
    const float rstd = 1.0f / sqrtf(qv * (1.0f / 256.0f) + 1e-6f);
    const bf16_t* rgp = z0 + (size_t)iq * DIN + Z_RG + h * 256 + 4 * quad;
    bf16_t* op = oret + (zrow0 + iq) * DM + h * 256 + 4 * quad;
#pragma unroll
    for (int vt = 0; vt < 16; ++vt) {
        const u32x2 gw = *(const u32x2*)(rgp + 16 * vt);
        const float g0 = bflo(gw.x), g1 = bfhi(gw.x), g2 = bflo(gw.y), g3 = bfhi(gw.y);
        const float x0 = o[vt][0] * rstd * g0 / (1.0f + __expf(-g0)), x1 = o[vt][1] * rstd * g1 / (1.0f + __expf(-g1)), x2 = o[vt][2] * rstd * g2 / (1.0f + __expf(-g2)), x3 = o[vt][3] * rstd * g3 / (1.0f + __expf(-g3));
        u32x2 w; w.x = pk2(x0, x1); w.y = pk2(x2, x3);
        *(u32x2*)(op + 16 * vt) = w;
    }
    __syncthreads();
}

#define XB_TMO      128
#define XB_XCNT(j)  (256  + 64 * (j))
#define XB_XSUB(j)  (1280 + 64 * (j))
#define XB_XGEN(j)  (2304 + 64 * (j))
#define XB_TOP      3328
#define XB_TOPGEN   3392
#define XCD_BAR_WORDS 3456
#define XB_SPIN_CAP (1u << 18)

__device__ __forceinline__ unsigned xb_ld(unsigned* p)              { return __hip_atomic_load(p, __ATOMIC_RELAXED, __HIP_MEMORY_SCOPE_AGENT); }
__device__ __forceinline__ unsigned xb_add(unsigned* p, unsigned v) { return __hip_atomic_fetch_add(p, v, __ATOMIC_RELAXED, __HIP_MEMORY_SCOPE_AGENT); }
__device__ __forceinline__ unsigned xb_xcc_id() { return (unsigned)__builtin_amdgcn_s_getreg((3 << 11) | 20) & 0xFu; }
#define XB_SPIN(cond, bar) do { unsigned _sp = 0; while (cond) { __builtin_amdgcn_s_sleep(1); \
    if ((++_sp & 255u) == 0u) { if (xb_ld(&(bar)[XB_TMO])) break; if (_sp > XB_SPIN_CAP) { atomicAdd(&(bar)[XB_TMO], 1u); break; } } } } while (0)

struct XcdBarrier {
    unsigned* bar; unsigned x;
    volatile LAS unsigned* st;
};

__device__ __forceinline__ XcdBarrier xcd_barrier_post(unsigned* bar, volatile LAS unsigned* st) {
    XcdBarrier b; b.bar = bar; b.x = xb_xcc_id(); b.st = st;
    if (threadIdx.x == 0) (void)xb_add(&bar[XB_XCNT(b.x)], 1u);
    return b;
}
__device__ __forceinline__ void xcd_barrier_complete(unsigned* bar, unsigned x, unsigned& nloc, unsigned& nx) {
    const unsigned G = gridDim.x * gridDim.y * gridDim.z;
    unsigned sum, cnt, mine, sp = 0u;
    for (;;) {
        sum = 0u; cnt = 0u; mine = 0u;
#pragma unroll
        for (unsigned j = 0; j < 16; ++j) { const unsigned c = xb_ld(&bar[XB_XCNT(j)]); sum += c; cnt += (c > 0u) ? 1u : 0u; mine = (j == x) ? c : mine; }
        if (sum == G) break;
        __builtin_amdgcn_s_sleep(1);
        if ((++sp & 255u) == 0u) { if (xb_ld(&bar[XB_TMO])) break; if (sp > XB_SPIN_CAP) { atomicAdd(&bar[XB_TMO], 1u); break; } }
    }
    nloc = mine > 0u ? mine : 1u; nx = cnt > 0u ? cnt : 1u;
}

__device__ __forceinline__ void xcd_barrier(const XcdBarrier& b) {
    asm volatile("s_waitcnt vmcnt(0)" ::: "memory");
    __syncthreads();
    if (threadIdx.x == 0) {
        unsigned* bar = b.bar;
        __builtin_amdgcn_s_waitcnt(0);
        unsigned nloc = b.st[0], nx = b.st[1];
        if (nloc == 0u) { xcd_barrier_complete(bar, b.x, nloc, nx); b.st[0] = nloc; b.st[1] = nx; }
        const unsigned old = xb_add(&bar[XB_XSUB(b.x)], 1u);
        const unsigned gen = old / nloc;
        if (old + 1u == (gen + 1u) * nloc) {
            __builtin_amdgcn_fence(__ATOMIC_RELEASE, "agent");
            asm volatile("s_waitcnt vmcnt(0)" ::: "memory");
            const unsigned og = xb_add(&bar[XB_TOP], 1u);
            const unsigned tg = og / nx;
            if (og + 1u == (tg + 1u) * nx) xb_add(&bar[XB_TOPGEN], 1u);
            else XB_SPIN(xb_ld(&bar[XB_TOPGEN]) == tg, bar);
            __builtin_amdgcn_fence(__ATOMIC_ACQUIRE, "agent");
            xb_add(&bar[XB_XGEN(b.x)], 1u);
            asm volatile("s_waitcnt vmcnt(0)" ::: "memory");
        } else {
            XB_SPIN(xb_ld(&bar[XB_XGEN(b.x)]) == gen, bar);
            __builtin_amdgcn_fence(__ATOMIC_ACQUIRE, "agent");
            asm volatile("s_waitcnt vmcnt(0)" ::: "memory");
        }
    }
    __syncthreads();
}

template <int MODE>
__device__ __forceinline__ void skinny_phase(LAS unsigned char* lds, const bf16_t* __restrict__ A, const bf16_t* __restrict__ Wt, int K, const pg8::Epi<MODE>& E, int tid_in) {
    int tid = tid_in; asm volatile("" : "+v"(tid));
    const int wid = __builtin_amdgcn_readfirstlane(tid >> 6), lane = tid & 63, fr = lane & 15, quad = lane >> 4;
    LAS f32x4* red = (LAS f32x4*)lds;
    LAS float* ssq_l = (LAS float*)(lds + 32768);
#pragma unroll 1
    for (int slab = blockIdx.x; slab < 256; slab += gridDim.x) {
        const int rt = slab & 15, cs = slab >> 4;
        const bf16_t* arow = A + (size_t)(MP + 16 * rt + fr) * K + 8 * quad;
        const bf16_t* wrow = Wt + (size_t)(64 * cs + fr) * K + 8 * quad;
        f32x4 acc[4];
#pragma unroll
        for (int ct = 0; ct < 4; ++ct) acc[ct] = (f32x4){0.f, 0.f, 0.f, 0.f};
        const int nks = K >> 5;
#pragma unroll 4
        for (int ks = wid; ks < nks; ks += 8) {
            const bf16x8 b = *(const bf16x8*)(arow + 32 * ks);
#pragma unroll
            for (int ct = 0; ct < 4; ++ct) { const bf16x8 w = *(const bf16x8*)(wrow + (size_t)(16 * ct) * K + 32 * ks); acc[ct] = MFMA16(w, b, acc[ct]); }
        }
#pragma unroll
        for (int ct = 0; ct < 4; ++ct) red[(wid * 4 + ct) * 64 + lane] = acc[ct];
        __syncthreads();
        if (wid < 4) {
            f32x4 s = red[wid * 64 + lane];
#pragma unroll
            for (int w = 1; w < 8; ++w) s = s + red[(w * 4 + wid) * 64 + lane];
            float ssq = E.elem(MP + 16 * rt + fr, 64 * cs + 16 * wid + 4 * quad, s);
            if constexpr (MODE == pg8::E_RES || MODE == pg8::E_GATE) { ssq += __shfl_xor(ssq, 16); ssq += __shfl_xor(ssq, 32); if (quad == 0) ssq_l[wid * 16 + fr] = ssq; }
        }
        __syncthreads();
        if constexpr (MODE == pg8::E_RES || MODE == pg8::E_GATE) { if (tid < 16) E.ssp_out[(size_t)(MP + 16 * rt + tid) * 16 + cs] = (ssq_l[tid] + ssq_l[16 + tid]) + (ssq_l[32 + tid] + ssq_l[48 + tid]); }
        __syncthreads();
    }
}

#define GEMM_PHASE(MODE, Aptr, Bptr, Mm, Nn, Kk, EPI) do { int kk_ = (Kk); asm volatile("" : "+s"(kk_)); pg8::Gemm g_{(const pg8::bf16_t*)(Aptr), (const pg8::bf16_t*)(Bptr), (Mm), (Nn), kk_}; pg8::StaticOrder S_; S_.init((Mm), (Nn), (int)gridDim.x, (int)blockIdx.x); \
    pg8::gemm_phase<pg8::Epi<MODE>, pg8::StaticOrder, true, true>((PG8_LAS unsigned char*)lds, g_, S_, (EPI)); } while (0)

__global__ void __launch_bounds__(512, 2) mega_fwd(Args a) {
    extern __shared__ __attribute__((aligned(16))) unsigned char lds_raw[];
    LAS unsigned char* lds = (LAS unsigned char*)lds_raw;
    cg::grid_group grid = cg::this_grid();
    int tid = threadIdx.x;
#define OPQ() asm volatile("" : "+v"(tid))
    unsigned char* ws = a.ws;
    float* ssp = (float*)(ws + WS_SSP); bf16_t* tbuf = (bf16_t*)(ws + WS_T);
    bf16_t* z = (bf16_t*)(ws + WS_Z); bf16_t* ubuf = (bf16_t*)(ws + WS_Z);
    bf16_t* oret = (bf16_t*)(ws + WS_ORET); bf16_t* oatt = (bf16_t*)(ws + WS_OATT); bf16_t* merged = (bf16_t*)(ws + WS_MERGED);
    bf16_t* og = (bf16_t*)(ws + WS_OG); float* lse = (float*)(ws + WS_LSE); bf16_t* U = (bf16_t*)(ws + WS_U); bf16_t* Rp = (bf16_t*)(ws + WS_RP);

#ifndef PHMASK
#define PHMASK 0xFFFFF
#endif
#define PH(n) if constexpr ((PHMASK >> (n)) & 1)
    unsigned* barw = (unsigned*)(ws + WS_CTL);
    volatile LAS unsigned* MISC = (volatile LAS unsigned*)(lds + LDS_BYTES - 64);
    if (tid < 2) MISC[tid] = 0u;
    if (blockIdx.x == 0) for (int i = tid; i < XCD_BAR_WORDS; i += 512) __hip_atomic_store(barw + i, 0u, __ATOMIC_RELAXED, __HIP_MEMORY_SCOPE_AGENT);
    PH(0) p0_prologue(a, lds, tid);
    grid.sync();
    const XcdBarrier xbar = xcd_barrier_post(barw, MISC);
#define GSYNC() xcd_barrier(xbar)

#pragma unroll 1
    for (int l = 0; l < 2; ++l) {
        unsigned char* wl = ws + WS_WT + (size_t)l * WT_LAYER;
        bf16_t* xb_cur = (bf16_t*)(ws + (l == 0 ? WS_XBA : WS_XBB));
        bf16_t* xb_nxt = (bf16_t*)(ws + (l == 0 ? WS_XBB : WS_XBA));
#ifndef REP_G
#define REP_G 1
#endif
#pragma unroll 1
        for (int rg_ = 0; rg_ < REP_G; ++rg_) {
        PH(1) { pg8::Epi<pg8::E_Z> E{z, DIN, nullptr, nullptr, ssp, nullptr, nullptr, nullptr}; GEMM_PHASE(pg8::E_Z, xb_cur, wl + WT_IN, MT, DIN, DM, E); }
        if (rg_ + 1 < REP_G) GSYNC();
        }
        cache_copy_tail(a, 2470, l * 500 + 0, l * 500 + 50, tid);
        GSYNC();
#ifndef REP_MIX
#define REP_MIX 1
#endif
#pragma unroll 1
        for (int rep_ = 0; rep_ < REP_MIX; ++rep_) {
        OPQ();
        if (blockIdx.x & 1) cache_copy_tail(a, 0, l * 500 + 190, l * 500 + 260, tid);
        PH(3) for (int it = blockIdx.x; it < 512; it += gridDim.x) ret_u_item(lds, z, U, it, tid);
        if (!(blockIdx.x & 1)) cache_copy_tail(a, 0, l * 500 + 190, l * 500 + 260, tid);
        GSYNC();
        if (blockIdx.x & 1) cache_copy_tail(a, 0, l * 500 + 260, l * 500 + 310, tid);
#pragma unroll 1
        for (int stage_ = 0; stage_ < 2; ++stage_) {
        const bool sample_now = ((stage_ == 0) == ((blockIdx.x & 1) != 0));
        if (!sample_now) {
        OPQ();
        PH(2) { const int per_ = (1536 + (int)gridDim.x - 1) / (int)gridDim.x; for (int i_ = 0; i_ < per_; ++i_) { const int it = (int)blockIdx.x * per_ + i_; if (it < 1536) attn_prompt_item(lds, z, og, lse, it, tid); } }
        } else {
        OPQ();
        PH(4) for (int it = blockIdx.x; it < 384; it += gridDim.x) {
            const int g = (it >> 2) % 3;
            attn_sample_item(lds, z, a.in[2 + 2 * g], a.in[3 + 2 * g], l, og, lse, it, tid);
        }
        OPQ();
        PH(5) for (int it = (blockIdx.x + gridDim.x / 2) % gridDim.x; it < 128; it += gridDim.x) ret_sample_item(lds, z, a.in[8] + (size_t)l * 128 * 32768, a.out + O_SRET + (size_t)l * 128 * 32768, oret, it, tid);
        }
        }
        OPQ();
        PH(7) p3_scan_combine<true, false>(a, l, tid);
        PH(6) win_copy(a, z, l, tid);
        if (!(blockIdx.x & 1)) cache_copy_tail(a, 0, l * 500 + 260, l * 500 + 310, tid);
        GSYNC();
        OPQ();
        if (blockIdx.x & 1) cache_copy_tail(a, 0, l * 500 + 310, l * 500 + 500, tid);
        PH(8) for (int it = blockIdx.x; it < 512; it += gridDim.x) ret_out_item(lds, z, Rp, oret, it, tid);
        PH(7) p3_scan_combine<false, true>(a, l, tid);
        if (!(blockIdx.x & 1)) cache_copy_tail(a, 0, l * 500 + 310, l * 500 + 500, tid);
        GSYNC();
        }
        PH(9) { pg8::Epi<pg8::E_RET> E{nullptr, DM, nullptr, tbuf, nullptr, nullptr, z + Z_GA, nullptr}; GEMM_PHASE(pg8::E_RET, oret, wl + WT_RET, MP, DM, DM, E); skinny_phase<pg8::E_RET>(lds, oret, (const bf16_t*)(wl + WT_RET), DM, E, tid); }
        PH(10) { pg8::Epi<pg8::E_ATT> E{merged, DM, nullptr, tbuf, nullptr, nullptr, z + Z_GB, nullptr}; GEMM_PHASE(pg8::E_ATT, oatt, wl + WT_ATT, MP, DM, 512, E); skinny_phase<pg8::E_ATT>(lds, oatt, (const bf16_t*)(wl + WT_ATT), 512, E, tid); }
        GSYNC();
        PH(11) { pg8::Epi<pg8::E_RES> E{xb_cur, DM, xb_cur, nullptr, nullptr, ssp, nullptr, (l == 0) ? a.in[0] : (const float*)nullptr}; GEMM_PHASE(pg8::E_RES, merged, wl + WT_OUT, MP, DM, DM, E);
          pg8::Epi<pg8::E_RES> Es{xb_cur, DM, xb_cur, nullptr, nullptr, ssp, nullptr, (l == 0) ? a.in[1] - (size_t)MP * DM : (const float*)nullptr}; skinny_phase<pg8::E_RES>(lds, merged, (const bf16_t*)(wl + WT_OUT), DM, Es, tid); }
        GSYNC();
#pragma unroll 1
        for (int rg_ = 0; rg_ < REP_G; ++rg_) {
        PH(12) { pg8::Epi<pg8::E_UP> E{ubuf, DFF, nullptr, nullptr, ssp, nullptr, nullptr, nullptr}; GEMM_PHASE(pg8::E_UP, xb_cur, wl + WT_UP, MT, DFF, DM, E); }
        if (rg_ + 1 < REP_G) GSYNC();
        }
        cache_copy_tail(a, 1040, l * 500 + 50, l * 500 + 190, tid);
        GSYNC();
        PH(13) { pg8::Epi<pg8::E_RES> E{xb_cur, DM, xb_cur, nullptr, nullptr, ssp, nullptr, nullptr}; GEMM_PHASE(pg8::E_RES, ubuf, wl + WT_DOWN, MP, DM, DFF, E); skinny_phase<pg8::E_RES>(lds, ubuf, (const bf16_t*)(wl + WT_DOWN), DFF, E, tid); }
        GSYNC();
        PH(14) { pg8::Epi<pg8::E_PLE> E{nullptr, DM, nullptr, tbuf, nullptr, nullptr, nullptr, nullptr}; GEMM_PHASE(pg8::E_PLE, ws + WS_PB + (size_t)l * MT * DPLE * 2, wl + WT_PLE, MP, DM, DPLE, E); skinny_phase<pg8::E_PLE>(lds, (const bf16_t*)(ws + WS_PB + (size_t)l * MT * DPLE * 2), (const bf16_t*)(wl + WT_PLE), DPLE, E, tid); }
        PH(15) { pg8::Epi<pg8::E_GATE> E{xb_nxt, DM, xb_cur, tbuf, nullptr, ssp, nullptr, nullptr}; GEMM_PHASE(pg8::E_GATE, xb_cur, wl + WT_GATE, MP, DM, DM, E); skinny_phase<pg8::E_GATE>(lds, xb_cur, (const bf16_t*)(wl + WT_GATE), DM, E, tid); }
        GSYNC();
    }
    {
        const int lane = tid & 63, gw = blockIdx.x * 8 + (tid >> 6), NGW = gridDim.x * 8;
        const float* nf = a.in[21];
        for (int m = gw; m < MT; m += NGW) {
            float sv = (lane < 16) ? ssp[(size_t)m * 16 + lane] : 0.f;
            sv = wave_sum(sv);
            const float rstd = 1.0f / sqrtf(sv * (1.0f / 1024.0f) + 1e-6f);
#pragma unroll
            for (int j = 0; j < 4; ++j) { const u32x2 xw_ = *(const u32x2*)((const bf16_t*)(ws + WS_XBA) + (size_t)m * DM + 4 * lane + 256 * j); const f32x4 v = {bflo(xw_.x), bfhi(xw_.x), bflo(xw_.y), bfhi(xw_.y)}; const f32x4 gn = *(const f32x4*)(nf + 4 * lane + 256 * j); *(f32x4*)(a.out + O_Y + (size_t)m * DM + 4 * lane + 256 * j) = v * rstd * gn; }
        }
    }
}

extern "C" void kernel_launch(void* const* d_in, const int* in_sizes, int n_in, void* d_out, int out_size, void* d_ws, size_t ws_size, hipStream_t stream) {
    static int grid = 0;
    if (grid == 0) {
        if (n_in != 22 || (size_t)out_size != O_END || ws_size < WS_END) { fprintf(stderr, "kernel_launch: unexpected shapes: n_in %d out %d (want %zu) ws %zu (need %zu)\n", n_in, out_size, (size_t)O_END, ws_size, (size_t)WS_END); grid = -1; return; }
        int dev = 0, cus = 0, per_cu = 0;
        if (hipGetDevice(&dev) != hipSuccess || hipDeviceGetAttribute(&cus, hipDeviceAttributeMultiprocessorCount, dev) != hipSuccess) { grid = -1; return; }
        if (hipFuncSetAttribute((const void*)mega_fwd, hipFuncAttributeMaxDynamicSharedMemorySize, LDS_BYTES) != hipSuccess) { fprintf(stderr, "kernel_launch: hipFuncSetAttribute failed\n"); grid = -1; return; }
        if (hipOccupancyMaxActiveBlocksPerMultiprocessor(&per_cu, (const void*)mega_fwd, 512, LDS_BYTES) != hipSuccess || per_cu < 1) { fprintf(stderr, "kernel_launch: occupancy query says %d\n", per_cu); per_cu = 1; }
        (void)hipGetLastError();
        grid = cus * 1;
    }
    if (grid < 0) return;
    Args a{};
    for (int i = 0; i < 22; ++i) a.in[i] = (const float*)d_in[i];
    a.out = (float*)d_out; a.ws = (unsigned char*)d_ws;
    void* args[] = {&a};
    hipError_t e = hipLaunchCooperativeKernel((const void*)mega_fwd, dim3(grid), dim3(512), args, LDS_BYTES, stream);
    if (e != hipSuccess) fprintf(stderr, "cooperative launch failed: %s (grid %d)\n", hipGetErrorString(e), grid);
}
```

```cpp
#include <hip/hip_runtime.h>
#include <hip/hip_cooperative_groups.h>
#include <cstdio>
#include <cstdint>
#include <cmath>
namespace cg = cooperative_groups;
namespace pg8 {
#define PG8_LAS __attribute__((address_space(3)))
typedef unsigned short bf16_t;
typedef short bf16x8 __attribute__((ext_vector_type(8)));
typedef float f32x4 __attribute__((ext_vector_type(4)));
typedef unsigned u32x4 __attribute__((ext_vector_type(4)));
constexpr int BM = 256, BK = 64, HALF = 128, HTB = HALF * BK * 2  , STAGE_BYTES = 8 * HTB, NXCD = 8, WGM = 8;

__host__ __device__ __forceinline__ int lds_byte(int r, int c) { const int st = (r >> 4) * 2 + (c >> 5), rr = r & 15, cc = c & 31, ob = rr * 64 + cc * 2; return st * 1024 + (ob ^ (((ob >> 9) & 1) << 5)); }
__host__ __device__ __forceinline__ void stage_rc(int b, int& R, int& C) { const int st = b / 1024, sb = b % 1024, swz = sb ^ (((sb >> 9) & 1) << 5); R = (st >> 1) * 16 + swz / 64; C = (st & 1) * 32 + (swz % 64) / 2; }
__host__ __device__ __forceinline__ int perm32(int rho) { const int n = rho >> 4, i = rho & 15; return 8 * (i >> 2) + 4 * n + (i & 3); }

struct Unit { int pm, pn; };
struct Gemm { const bf16_t* A; const bf16_t* Bt; int M, N, K; };

struct StaticOrder {
    int nM, nN, nwg, G, c;
    __host__ __device__ void init(int M, int N, int G_, int c_) { nM = M / BM; nN = N / BM; nwg = nM * nN; G = G_; c = c_; }
    __host__ __device__ bool next(int i, Unit& u) const {
        const long L = (long)i * G + c; if (L >= nwg) return false;
        int wgid = (int)L; { const int q = nwg / NXCD, r = nwg % NXCD, xcd = wgid % NXCD, off = wgid / NXCD; wgid = (xcd < r ? xcd * (q + 1) : r * (q + 1) + (xcd - r) * q) + off; }
        const int nig = WGM * nN, gid = wgid / nig, fm = gid * WGM, gsz = (nM - fm) < WGM ? (nM - fm) : WGM;
        u.pm = fm + ((wgid % nig) % gsz); u.pn = (wgid % nig) / gsz; return true;
    }
    __device__ __forceinline__ void a_ready(const Unit&) const {}
    __device__ __forceinline__ void done(const Unit&) const {}
};

__device__ __forceinline__ unsigned cvt_pk_bf16(float lo, float hi) { unsigned r; asm("v_cvt_pk_bf16_f32 %0, %1, %2" : "=v"(r) : "v"(lo), "v"(hi)); return r; }

typedef unsigned u32x2 __attribute__((ext_vector_type(2)));
__device__ __forceinline__ float bf2f(unsigned h) { return __uint_as_float(h << 16); }
__device__ __forceinline__ float sigmoidf_(float x) { return 1.0f / (1.0f + __expf(-x)); }
__device__ __forceinline__ f32x4 bf4_to_f32(u32x2 w) { f32x4 r; r[0] = bf2f(w.x & 0xffffu); r[1] = bf2f(w.x >> 16); r[2] = bf2f(w.y & 0xffffu); r[3] = bf2f(w.y >> 16); return r; }
__device__ __forceinline__ u32x2 f32_to_bf4(f32x4 v) { u32x2 w; w.x = cvt_pk_bf16(v[0], v[1]); w.y = cvt_pk_bf16(v[2], v[3]); return w; }
enum { E_Z = 0, E_UP = 1, E_RET = 2, E_ATT = 3, E_RES = 4, E_PLE = 5, E_GATE = 6 };
template <int MODE> struct Epi {
    static constexpr bool PERM = (MODE == E_Z || MODE == E_UP), AFTER_DRAIN = false;
    bf16_t* ob; int ldob; const bf16_t* xrb; bf16_t* t; const float* ssp_in; float* ssp_out; const bf16_t* gate; const float* xr;
    __device__ __forceinline__ float elem(int row, int col, const f32x4 a) const {
        const size_t off = (size_t)row * 1024 + col; float ssq = 0.f;
        if constexpr (MODE == E_RET || MODE == E_ATT) {
            const u32x2 gw = *(const u32x2*)(gate + (size_t)row * 9728 + col);
            f32x4 gv; gv[0] = sigmoidf_(bf2f(gw.x & 0xffffu)); gv[1] = sigmoidf_(bf2f(gw.x >> 16)); gv[2] = sigmoidf_(bf2f(gw.y & 0xffffu)); gv[3] = sigmoidf_(bf2f(gw.y >> 16));
            if constexpr (MODE == E_RET) { *(u32x2*)(t + off) = f32_to_bf4(gv * a); }
            else { const f32x4 tv = bf4_to_f32(*(const u32x2*)(t + off)); const f32x4 o = tv + gv * a; u32x2 w; w.x = cvt_pk_bf16(o[0], o[1]); w.y = cvt_pk_bf16(o[2], o[3]); *(u32x2*)(ob + off) = w; }
        } else if constexpr (MODE == E_PLE) {
            *(u32x2*)(t + off) = f32_to_bf4(a);
        } else if constexpr (MODE == E_RES || MODE == E_GATE) {
            f32x4 x = xr ? *(const f32x4*)(xr + off) : bf4_to_f32(*(const u32x2*)(xrb + off));
            if constexpr (MODE == E_GATE) { const f32x4 tv = bf4_to_f32(*(const u32x2*)(t + off)); f32x4 sg; sg[0] = sigmoidf_(a[0]); sg[1] = sigmoidf_(a[1]); sg[2] = sigmoidf_(a[2]); sg[3] = sigmoidf_(a[3]); x = x + tv * sg; }
            else x = x + a;
            u32x2 w; w.x = cvt_pk_bf16(x[0], x[1]); w.y = cvt_pk_bf16(x[2], x[3]); *(u32x2*)(ob + off) = w;
            ssq = (x[0] * x[0] + x[1] * x[1]) + (x[2] * x[2] + x[3] * x[3]);
        }
        return ssq;
    }
    __device__ __forceinline__ void operator()(const f32x4 (&acc)[2][2][4][2], const Unit& u, int wr, int wc, int fr, int fq) const {
        const int row0 = u.pm * BM + wr * 64 + fr;
        if constexpr (PERM) {
            const int col0 = u.pn * BM + wc * 32 + 8 * fq;
            f32x4 sp[2][4];
#pragma unroll
            for (int ai = 0; ai < 2; ++ai)
#pragma unroll
                for (int m = 0; m < 4; ++m) sp[ai][m] = *(const f32x4*)(ssp_in + (size_t)(row0 + ai * HALF + m * 16) * 16 + 4 * fq);
#pragma unroll
            for (int ai = 0; ai < 2; ++ai)
#pragma unroll
                for (int m = 0; m < 4; ++m) {
                    const int row = row0 + ai * HALF + m * 16;
                    float ss = (sp[ai][m][0] + sp[ai][m][1]) + (sp[ai][m][2] + sp[ai][m][3]);
                    ss += __shfl_xor(ss, 16); ss += __shfl_xor(ss, 32);
                    const float rstd = 1.0f / sqrtf(ss * (1.0f / 1024.0f) + 1e-6f);
                    bf16_t* rowp = ob + (size_t)row * ldob + col0;
#pragma unroll
                    for (int bj = 0; bj < 2; ++bj) {
                        f32x4 v0 = acc[ai][bj][m][0] * rstd, v1 = acc[ai][bj][m][1] * rstd;
                        if constexpr (MODE == E_UP) {
#pragma unroll
                            for (int e = 0; e < 4; ++e) { float a = fmaxf(v0[e], 0.f), b = fmaxf(v1[e], 0.f); v0[e] = a * a; v1[e] = b * b; }
                        }
                        u32x4 w; w.x = cvt_pk_bf16(v0[0], v0[1]); w.y = cvt_pk_bf16(v0[2], v0[3]); w.z = cvt_pk_bf16(v1[0], v1[1]); w.w = cvt_pk_bf16(v1[2], v1[3]);
                        *(u32x4*)(rowp + bj * HALF) = w;
                    }
                }
        } else {
            const int col0 = u.pn * BM + wc * 32 + 4 * fq;
            constexpr int MB = (MODE == E_GATE) ? 1 : 2;
#pragma unroll
            for (int aim = 0; aim < 8 / MB; ++aim) {
                const int ai = aim / (4 / MB), m0 = (aim % (4 / MB)) * MB;
                f32x4 xv[4][2][2]; u32x2 xw[4][2][2]; u32x2 tv[4][2][2]; u32x2 gw[4][2][2];
#pragma unroll
                for (int m = m0; m < m0 + MB; ++m)
#pragma unroll
                    for (int bj = 0; bj < 2; ++bj)
#pragma unroll
                        for (int n = 0; n < 2; ++n) {
                            const int row = row0 + ai * HALF + m * 16, col = col0 + bj * HALF + n * 16; const size_t off = (size_t)row * 1024 + col;
                            if constexpr (MODE == E_RES || MODE == E_GATE) { if (xr) xv[m][bj][n] = *(const f32x4*)(xr + off); else xw[m][bj][n] = *(const u32x2*)(xrb + off); }
                            if constexpr (MODE == E_ATT || MODE == E_GATE) tv[m][bj][n] = *(const u32x2*)(t + off);
                            if constexpr (MODE == E_RET || MODE == E_ATT) gw[m][bj][n] = *(const u32x2*)(gate + (size_t)row * 9728 + col);
                        }
#pragma unroll
                for (int m = m0; m < m0 + MB; ++m) {
                    const int row = row0 + ai * HALF + m * 16;
                    float ssq = 0.f;
#pragma unroll
                    for (int bj = 0; bj < 2; ++bj)
#pragma unroll
                        for (int n = 0; n < 2; ++n) {
                            const int col = col0 + bj * HALF + n * 16; const size_t off = (size_t)row * 1024 + col;
                            const f32x4 a = acc[ai][bj][m][n];
                            if constexpr (MODE == E_RET || MODE == E_ATT) {
                                const u32x2 g2 = gw[m][bj][n];
                                f32x4 gv; gv[0] = sigmoidf_(bf2f(g2.x & 0xffffu)); gv[1] = sigmoidf_(bf2f(g2.x >> 16)); gv[2] = sigmoidf_(bf2f(g2.y & 0xffffu)); gv[3] = sigmoidf_(bf2f(g2.y >> 16));
                                if constexpr (MODE == E_RET) { *(u32x2*)(t + off) = f32_to_bf4(gv * a); }
                                else { const f32x4 o = bf4_to_f32(tv[m][bj][n]) + gv * a; u32x2 w; w.x = cvt_pk_bf16(o[0], o[1]); w.y = cvt_pk_bf16(o[2], o[3]); *(u32x2*)(ob + off) = w; }
                            } else if constexpr (MODE == E_PLE) {
                                *(u32x2*)(t + off) = f32_to_bf4(a);
                            } else {
                                f32x4 x = xr ? xv[m][bj][n] : bf4_to_f32(xw[m][bj][n]);
                                if constexpr (MODE == E_GATE) { f32x4 sg; sg[0] = sigmoidf_(a[0]); sg[1] = sigmoidf_(a[1]); sg[2] = sigmoidf_(a[2]); sg[3] = sigmoidf_(a[3]); x = x + bf4_to_f32(tv[m][bj][n]) * sg; }
                                else x = x + a;
                                u32x2 w; w.x = cvt_pk_bf16(x[0], x[1]); w.y = cvt_pk_bf16(x[2], x[3]); *(u32x2*)(ob + off) = w;
                                ssq += (x[0] * x[0] + x[1] * x[1]) + (x[2] * x[2] + x[3] * x[3]);
                            }
                        }
                    if constexpr (MODE == E_RES || MODE == E_GATE) {
                        ssq += __shfl_xor(ssq, 16); ssq += __shfl_xor(ssq, 32);
                        if (fq == 0) ssp_out[(size_t)row * 16 + u.pn * 4 + wc] = ssq;
                    }
                }
            }
        }
    }
};
template <class Epi, class Sched, bool ALIGN_EPI = false, bool SP2 = false>
__device__ __forceinline__ void gemm_phase(PG8_LAS unsigned char* lds, const Gemm g, const Sched& S, const Epi& E) {
    int tid_ = threadIdx.x; asm volatile("" : "+v"(tid_));
    const int tid = tid_, wid = __builtin_amdgcn_readfirstlane(tid >> 6), lane = tid & 63, wr = wid >> 2, wc = wid & 3, fr = lane & 15, fq = lane >> 4;
    const int K = g.K, nt = K / BK;
    unsigned voffA[2], voffB[2];
#pragma unroll
    for (int i = 0; i < 2; ++i) { int R, C; stage_rc(tid * 16 + i * 8192, R, C); const int Rb = Epi::PERM ? ((R & ~31) + perm32(R & 31)) : R;
        voffA[i] = (unsigned)(R * K + C) * 2u; voffB[i] = (unsigned)(Rb * K + C) * 2u; }
    const size_t kstep = (size_t)(BK * 2);
    const size_t hstep = (size_t)HALF * K * 2;
    const size_t tstep = 2 * hstep;
    const unsigned ldsw = (unsigned)wid * 1024u;
    const int aoff = lds_byte(wr * 64 + fr, fq * 8), boff = lds_byte(wc * 32 + fr, fq * 8);
#define PG8_SA(b, h) (((b) * 2 + (h)) * HTB)
#define PG8_SB(b, h) ((4 + (b) * 2 + (h)) * HTB)
#define PG8_STAGE(bufoff, gbase, voff) do { _Pragma("unroll") for (int _i = 0; _i < 2; ++_i) \
        __builtin_amdgcn_global_load_lds((const unsigned*)((const char*)(gbase) + (voff)[_i]), (PG8_LAS unsigned*)(lds + (bufoff) + ldsw + _i * 8192), 16, 0, 0); } while (0)
#define PG8_LDA(dst, b, h) do { _Pragma("unroll") for (int m = 0; m < 4; ++m) _Pragma("unroll") for (int k = 0; k < 2; ++k) dst[m][k] = *(const PG8_LAS bf16x8*)(lds + PG8_SA(b, h) + aoff + m * 2048 + k * 1024); } while (0)
#define PG8_LDB(dst, b, h) do { _Pragma("unroll") for (int n = 0; n < 2; ++n) _Pragma("unroll") for (int k = 0; k < 2; ++k) dst[n][k] = *(const PG8_LAS bf16x8*)(lds + PG8_SB(b, h) + boff + n * 2048 + k * 1024); } while (0)
#define PG8_MMA(ai, bj, At, Bt) do { __builtin_amdgcn_s_setprio(1); _Pragma("unroll") for (int m = 0; m < 4; ++m) _Pragma("unroll") for (int n = 0; n < 2; ++n) _Pragma("unroll") for (int k = 0; k < 2; ++k) \
        acc[ai][bj][m][n] = __builtin_amdgcn_mfma_f32_16x16x32_bf16(Bt[n][k], At[m][k], acc[ai][bj][m][n], 0, 0, 0); __builtin_amdgcn_s_setprio(0); } while (0)
#define PG8_WAIT_V(n) asm volatile("s_waitcnt vmcnt(" #n ")" ::: "memory")
#define PG8_WAIT_L(n) asm volatile("s_waitcnt lgkmcnt(" #n ")" ::: "memory")
#define PG8_BAR __builtin_amdgcn_s_barrier()
#define PG8_SCHED __builtin_amdgcn_sched_barrier(0)
    Unit cur, nxt; int ui = 0;
    if (!S.next(0, cur)) return;
    f32x4 acc[2][2][4][2];
#pragma unroll
    for (int a = 0; a < 2; ++a)
#pragma unroll
        for (int b = 0; b < 2; ++b)
#pragma unroll
            for (int m = 0; m < 4; ++m)
#pragma unroll
                for (int n = 0; n < 2; ++n) acc[a][b][m][n] = (f32x4){0.f, 0.f, 0.f, 0.f};
    bf16x8 At[4][2], B0[2][2], B1[2][2];
    const char* cA = (const char*)g.A + (size_t)cur.pm * tstep; const char* cB = (const char*)g.Bt + (size_t)cur.pn * tstep;
    S.a_ready(cur);
    if constexpr (SP2) {
        PG8_STAGE(PG8_SB(0, 0), cB, voffB); PG8_STAGE(PG8_SB(0, 1), cB + hstep, voffB); PG8_STAGE(PG8_SA(0, 0), cA, voffA); PG8_STAGE(PG8_SA(0, 1), cA + hstep, voffA);
        if (wr == 1) PG8_BAR;
        PG8_WAIT_V(2); PG8_BAR;
        PG8_STAGE(PG8_SB(1, 0), cB + kstep, voffB); PG8_STAGE(PG8_SA(1, 0), cA + kstep, voffA); PG8_STAGE(PG8_SB(1, 1), cB + hstep + kstep, voffB);
        PG8_WAIT_V(6); PG8_BAR;
    } else {
        PG8_STAGE(PG8_SB(0, 0), cB, voffB); PG8_STAGE(PG8_SA(0, 0), cA, voffA); PG8_STAGE(PG8_SB(0, 1), cB + hstep, voffB); PG8_STAGE(PG8_SA(0, 1), cA + hstep, voffA);
        if (wr == 1) PG8_BAR;
        PG8_WAIT_V(4); PG8_BAR;
        PG8_STAGE(PG8_SB(1, 0), cB + kstep, voffB); PG8_STAGE(PG8_SA(1, 0), cA + kstep, voffA); PG8_STAGE(PG8_SB(1, 1), cB + hstep + kstep, voffB);
        PG8_WAIT_V(6); PG8_BAR;
    }
    for (;;) {
        const bool has_next = S.next(ui + 1, nxt);
        const char* nA = has_next ? (const char*)g.A + (size_t)nxt.pm * tstep : cA; const char* nB = has_next ? (const char*)g.Bt + (size_t)nxt.pn * tstep : cB;
        for (int t = 0; t < nt; t += 2) {
            const bool last = (t == nt - 2);
            const char* a1 = cA + (size_t)(t + 1) * kstep;
            const char* a2 = last ? nA : cA + (size_t)(t + 2) * kstep; const char* b2 = last ? nB : cB + (size_t)(t + 2) * kstep;
            const char* a3 = a2 + kstep; const char* b3 = b2 + kstep;
            if (last && has_next) S.a_ready(nxt);
            if constexpr (SP2) {
            PG8_LDB(B0, 0, 0); PG8_LDB(B1, 0, 1); PG8_SCHED; PG8_LDA(At, 0, 0); PG8_STAGE(PG8_SA(1, 1), a1 + hstep, voffA);
            PG8_WAIT_V(8); PG8_WAIT_L(0); PG8_BAR; PG8_MMA(0, 0, At, B0); PG8_MMA(0, 1, At, B1); PG8_BAR; PG8_SCHED;
            PG8_LDA(At, 0, 1); PG8_STAGE(PG8_SB(0, 0), b2, voffB); PG8_STAGE(PG8_SB(0, 1), b2 + hstep, voffB); PG8_STAGE(PG8_SA(0, 0), a2, voffA);
            PG8_WAIT_V(8); PG8_WAIT_L(0); PG8_BAR; PG8_MMA(1, 0, At, B0); PG8_MMA(1, 1, At, B1); PG8_BAR; PG8_SCHED;
            PG8_LDB(B0, 1, 0); PG8_LDB(B1, 1, 1); PG8_SCHED; PG8_LDA(At, 1, 0); PG8_STAGE(PG8_SA(0, 1), a2 + hstep, voffA);
            PG8_WAIT_V(8); PG8_WAIT_L(0); PG8_BAR; PG8_MMA(0, 0, At, B0); PG8_MMA(0, 1, At, B1); PG8_BAR; PG8_SCHED;
            PG8_LDA(At, 1, 1); PG8_STAGE(PG8_SB(1, 0), b3, voffB); PG8_STAGE(PG8_SB(1, 1), b3 + hstep, voffB); PG8_STAGE(PG8_SA(1, 0), a3, voffA);
            PG8_WAIT_V(8); PG8_WAIT_L(0); PG8_BAR; PG8_MMA(1, 0, At, B0); PG8_MMA(1, 1, At, B1); PG8_BAR; PG8_SCHED;
            } else {
            PG8_LDB(B0, 0, 0); PG8_SCHED; PG8_LDA(At, 0, 0); PG8_STAGE(PG8_SA(1, 1), a1 + hstep, voffA);
            PG8_WAIT_L(8); PG8_BAR; PG8_WAIT_L(0); PG8_MMA(0, 0, At, B0); PG8_BAR; PG8_SCHED;
            PG8_LDB(B1, 0, 1); PG8_STAGE(PG8_SB(0, 0), b2, voffB);
            PG8_BAR; PG8_WAIT_L(0); PG8_MMA(0, 1, At, B1); PG8_BAR;
            PG8_LDA(At, 0, 1); PG8_STAGE(PG8_SA(0, 0), a2, voffA);
            PG8_BAR; PG8_WAIT_L(0); PG8_MMA(1, 0, At, B0); PG8_BAR; PG8_SCHED;
            PG8_STAGE(PG8_SB(0, 1), b2 + hstep, voffB);
            PG8_WAIT_V(6); PG8_BAR; PG8_MMA(1, 1, At, B1); PG8_BAR;
            PG8_LDB(B0, 1, 0); PG8_SCHED; PG8_LDA(At, 1, 0); PG8_STAGE(PG8_SA(0, 1), a2 + hstep, voffA);
            PG8_WAIT_L(8); PG8_BAR; PG8_WAIT_L(0); PG8_MMA(0, 0, At, B0); PG8_BAR; PG8_SCHED;
            PG8_LDB(B1, 1, 1); PG8_STAGE(PG8_SB(1, 0), b3, voffB);
            PG8_BAR; PG8_WAIT_L(0); PG8_MMA(0, 1, At, B1); PG8_BAR;
            PG8_LDA(At, 1, 1); PG8_STAGE(PG8_SA(1, 0), a3, voffA);
            PG8_BAR; PG8_WAIT_L(0); PG8_MMA(1, 0, At, B0); PG8_BAR; PG8_SCHED;
            PG8_STAGE(PG8_SB(1, 1), b3 + hstep, voffB);
            PG8_WAIT_V(6); PG8_BAR; PG8_MMA(1, 1, At, B1); PG8_BAR;
            }
        }
        if constexpr (ALIGN_EPI) { if (wr == 0) PG8_BAR; }
        if constexpr (!Epi::AFTER_DRAIN) { E(acc, cur, wr, wc, fr, fq); S.done(cur); }
        if (!has_next) break;
#pragma unroll
        for (int a = 0; a < 2; ++a)
#pragma unroll
            for (int b = 0; b < 2; ++b)
#pragma unroll
                for (int m = 0; m < 4; ++m)
#pragma unroll
                    for (int n = 0; n < 2; ++n) acc[a][b][m][n] = (f32x4){0.f, 0.f, 0.f, 0.f};
        cur = nxt; cA = nA; cB = nB; ++ui;
        if constexpr (ALIGN_EPI) { if (wr == 1) PG8_BAR; }
    }
    PG8_WAIT_V(0);
    if constexpr (!ALIGN_EPI) { if (wr == 0) PG8_BAR; }
    PG8_BAR;
    if constexpr (Epi::AFTER_DRAIN) { E.fused(acc, cur, wr, wc, fr, fq, lds, wid, lane); S.done(cur); }
#undef PG8_SA
#undef PG8_SB
#undef PG8_STAGE
#undef PG8_LDA
#undef PG8_LDB
#undef PG8_MMA
#undef PG8_WAIT_V
#undef PG8_WAIT_L
#undef PG8_BAR
#undef PG8_SCHED
}
}

#define LAS __attribute__((address_space(3)))
typedef unsigned short bf16_t;
typedef short bf16x8 __attribute__((ext_vector_type(8)));
typedef short v4i16_t __attribute__((ext_vector_type(4)));
typedef float f32x4 __attribute__((ext_vector_type(4)));
typedef float f32x2 __attribute__((ext_vector_type(2)));
typedef unsigned u32x4 __attribute__((ext_vector_type(4)));
typedef unsigned u32x2 __attribute__((ext_vector_type(2)));

constexpr int MP = 16384, MS = 256, MT = MP + MS;
constexpr int DM = 1024, DIN = 9728, DFF = 4096, DPLE = 256, SEQ = 8192;
constexpr int Z_RQ = 0, Z_RK = 512, Z_RV = 1024, Z_RG = 2048, Z_AQ = 3072, Z_AK = 4608, Z_AV = 6144, Z_GA = 7680, Z_GB = 8704;
constexpr int LDS_BYTES = 147456;
constexpr float QK_SCALE = 0.08838834764831845f;

constexpr size_t WT_IN = 0, WT_RET = WT_IN + (size_t)DIN * DM * 2, WT_ATT = WT_RET + (size_t)DM * DM * 2, WT_OUT = WT_ATT + (size_t)DM * 512 * 2,
                 WT_UP = WT_OUT + (size_t)DM * DM * 2, WT_DOWN = WT_UP + (size_t)DFF * DM * 2, WT_PLE = WT_DOWN + (size_t)DFF * DM * 2,
                 WT_GATE = WT_PLE + (size_t)DM * DPLE * 2, WT_LAYER = WT_GATE + (size_t)DM * DM * 2;
constexpr size_t WS_WT = 0;
constexpr size_t WS_XF = WS_WT + 2 * WT_LAYER;
constexpr size_t WS_XBA = WS_XF + (size_t)MT * DM * 4;
constexpr size_t WS_XBB = WS_XBA + (size_t)MT * DM * 2;
constexpr size_t WS_SSP = WS_XBB + (size_t)MT * DM * 2;
constexpr size_t WS_PB = WS_SSP + (size_t)MT * 16 * 4;
constexpr size_t WS_Z = WS_PB + (size_t)2 * MT * DPLE * 2;
constexpr size_t WS_ORET = WS_Z + (size_t)MT * DIN * 2;
constexpr size_t WS_OATT = WS_ORET + (size_t)MT * DM * 2;
constexpr size_t WS_MERGED = WS_OATT + (size_t)MT * 512 * 2;
constexpr size_t WS_T = WS_MERGED + (size_t)MT * DM * 2;
constexpr size_t WS_OG = WS_T + (size_t)MT * DM * 4;
constexpr size_t WS_LSE = WS_OG + (size_t)3 * MT * 512 * 4;
constexpr size_t WS_U = WS_LSE + (size_t)3 * MT * 4 * 4;
constexpr size_t WS_RP = WS_U + (size_t)512 * 32768 * 4;
constexpr size_t WS_CTL = WS_RP + (size_t)512 * 32768 * 2;
constexpr size_t WS_END = WS_CTL + 16384;

constexpr size_t O_Y = 0;
constexpr size_t O_PWK0 = (size_t)MT * DM, O_PWV0 = O_PWK0 + 262144, O_PWK1 = O_PWV0 + 262144, O_PWV1 = O_PWK1 + 1048576, O_PWK2 = O_PWV1 + 1048576, O_PWV2 = O_PWK2 + 4194304;
constexpr size_t O_PRET = O_PWV2 + 4194304;
constexpr size_t O_SWK0 = O_PRET + 524288, O_SWV0 = O_SWK0 + 4194304, O_SWK1 = O_SWV0 + 4194304, O_SWV1 = O_SWK1 + 16777216, O_SWK2 = O_SWV1 + 16777216, O_SWV2 = O_SWK2 + 67108864;
constexpr size_t O_SRET = O_SWV2 + 67108864;
constexpr size_t O_END = O_SRET + 8388608;

struct Args { const float* in[22]; float* out; unsigned char* ws; };

__device__ __forceinline__ unsigned f2bf(float f) { unsigned u = __builtin_bit_cast(unsigned, f); return (u + 0x7fffu + ((u >> 16) & 1u)) >> 16; }
__device__ __forceinline__ unsigned pk2(float lo, float hi) { return f2bf(lo) | (f2bf(hi) << 16); }
__device__ __forceinline__ float bflo(unsigned w) { return __uint_as_float(w << 16); }
__device__ __forceinline__ float bfhi(unsigned w) { return __uint_as_float(w & 0xffff0000u); }
__device__ __forceinline__ float wave_sum(float v) {
#pragma unroll
    for (int o = 1; o < 64; o <<= 1) v += __shfl_xor(v, o);
    return v;
}
__device__ __forceinline__ float ret_lg(int h) { const float A = -3.4657359028f, B = -6.2383246250f; return log1pf(-expf(A + (B - A) * (float)h * (1.0f / 3.0f))); }
__device__ __forceinline__ v4i16_t tr4(LAS const unsigned char* p) { return __builtin_amdgcn_ds_read_tr16_b64_v4i16((LAS v4i16_t*)p); }
__device__ __forceinline__ bf16x8 cat8(v4i16_t a, v4i16_t b) { return __builtin_shufflevector(a, b, 0, 1, 2, 3, 4, 5, 6, 7); }
#define MFMA16(a, b, c) __builtin_amdgcn_mfma_f32_16x16x32_bf16((a), (b), (c), 0, 0, 0)

__device__ __forceinline__ void p0_transpose_item(const float* __restrict__ W, int K, int N, bf16_t* __restrict__ WT, const float* __restrict__ gain, bool is_in, LAS float* scr, int item, int lane) {
    const int nblk = N / 64, kb = item / nblk, nb = item % nblk, k0 = 64 * kb, n0 = 64 * nb;
    const int kr = lane >> 4, nc = 4 * (lane & 15);
#pragma unroll 8
    for (int i = 0; i < 16; ++i) { const int kk = 4 * i + kr; f32x4 v = __builtin_nontemporal_load((const f32x4*)(W + (size_t)(k0 + kk) * N + n0 + nc)); if (gain) v = v * gain[k0 + kk];
        LAS float* d = scr + kk * 65 + nc; d[0] = v[0]; d[1] = v[1]; d[2] = v[2]; d[3] = v[3]; }
    asm volatile("s_waitcnt lgkmcnt(0)" ::: "memory");
    const int c = lane & 7;
#pragma unroll
    for (int j = 0; j < 8; ++j) { const int n = (lane >> 3) + 8 * j; const LAS float* s = scr + (8 * c) * 65 + n; const int ng = n0 + n;
        const float sc = (is_in && ((ng >= Z_RK && ng < Z_RV) || (ng >= Z_AQ && ng < Z_AK))) ? QK_SCALE : 1.0f;
        u32x4 o; o.x = pk2(s[0 * 65] * sc, s[1 * 65] * sc); o.y = pk2(s[2 * 65] * sc, s[3 * 65] * sc); o.z = pk2(s[4 * 65] * sc, s[5 * 65] * sc); o.w = pk2(s[6 * 65] * sc, s[7 * 65] * sc);
        *(u32x4*)(WT + (size_t)ng * K + k0 + 8 * c) = o; }
    asm volatile("s_waitcnt lgkmcnt(0)" ::: "memory");
}

__device__ __forceinline__ void p0_prologue(const Args& a, LAS unsigned char* lds, int tid) {
    const int lane = tid & 63, wave = tid >> 6;
    const int gw = blockIdx.x * 8 + wave, NGW = gridDim.x * 8;
    LAS float* scr = (LAS float*)(lds + wave * 16640);
    constexpr int I_IN = 16 * 152, I_RET = 16 * 16, I_ATT = 8 * 16, I_OUT = 16 * 16, I_UP = 16 * 64, I_DOWN = 64 * 16, I_PLE = 4 * 16, I_GATE = 16 * 16;
    constexpr int I_LAYER = I_IN + I_RET + I_ATT + I_OUT + I_UP + I_DOWN + I_PLE + I_GATE;
    for (int it = gw; it < 2 * I_LAYER; it += NGW) {
        const int l = it / I_LAYER; int r = it % I_LAYER;
        unsigned char* wl = a.ws + WS_WT + (size_t)l * WT_LAYER;
        if (r < I_IN) { p0_transpose_item(a.in[12] + (size_t)l * DM * DIN, DM, DIN, (bf16_t*)(wl + WT_IN), a.in[11] + l * DM, true, scr, r, lane); continue; } r -= I_IN;
        if (r < I_RET) { p0_transpose_item(a.in[13] + (size_t)l * DM * DM, DM, DM, (bf16_t*)(wl + WT_RET), nullptr, false, scr, r, lane); continue; } r -= I_RET;
        if (r < I_ATT) { p0_transpose_item(a.in[14] + (size_t)l * 512 * DM, 512, DM, (bf16_t*)(wl + WT_ATT), nullptr, false, scr, r, lane); continue; } r -= I_ATT;
        if (r < I_OUT) { p0_transpose_item(a.in[15] + (size_t)l * DM * DM, DM, DM, (bf16_t*)(wl + WT_OUT), nullptr, false, scr, r, lane); continue; } r -= I_OUT;
        if (r < I_UP) { p0_transpose_item(a.in[17] + (size_t)l * DM * DFF, DM, DFF, (bf16_t*)(wl + WT_UP), a.in[16] + l * DM, false, scr, r, lane); continue; } r -= I_UP;
        if (r < I_DOWN) { p0_transpose_item(a.in[18] + (size_t)l * DFF * DM, DFF, DM, (bf16_t*)(wl + WT_DOWN), nullptr, false, scr, r, lane); continue; } r -= I_DOWN;
        if (r < I_PLE) { p0_transpose_item(a.in[19] + (size_t)l * DPLE * DM, DPLE, DM, (bf16_t*)(wl + WT_PLE), nullptr, false, scr, r, lane); continue; } r -= I_PLE;
        p0_transpose_item(a.in[20] + (size_t)l * DM * DM, DM, DM, (bf16_t*)(wl + WT_GATE), nullptr, false, scr, r, lane);
    }
    bf16_t* xb = (bf16_t*)(a.ws + WS_XBA); float* ssp = (float*)(a.ws + WS_SSP);
    for (int m = gw; m < MT; m += NGW) {
        const float* src = (m < MP) ? a.in[0] + (size_t)m * DM : a.in[1] + (size_t)(m - MP) * DM;
        f32x4 v[4]; float s = 0.f;
#pragma unroll
        for (int j = 0; j < 4; ++j) { v[j] = __builtin_nontemporal_load((const f32x4*)(src + 4 * lane + 256 * j)); s += (v[j][0] * v[j][0] + v[j][1] * v[j][1]) + (v[j][2] * v[j][2] + v[j][3] * v[j][3]); }
        s = wave_sum(s);
#pragma unroll
        for (int j = 0; j < 4; ++j) { u32x2 w; w.x = pk2(v[j][0], v[j][1]); w.y = pk2(v[j][2], v[j][3]); *(u32x2*)(xb + (size_t)m * DM + 4 * lane + 256 * j) = w; }
        if (lane < 16) ssp[(size_t)m * 16 + lane] = (lane == 0) ? s : 0.f;
    }
    bf16_t* pb = (bf16_t*)(a.ws + WS_PB);
    for (int q = gw; q < 2 * MT; q += NGW) {
        const int l = q / MT, m = q % MT;
        const float* src = (m < MP) ? a.in[9] + ((size_t)l * MP + m) * DPLE : a.in[10] + ((size_t)l * MS + (m - MP)) * DPLE;
        const f32x4 v = __builtin_nontemporal_load((const f32x4*)(src + 4 * lane));
        u32x2 w; w.x = pk2(v[0], v[1]); w.y = pk2(v[2], v[3]); *(u32x2*)(pb + (size_t)q * DPLE + 4 * lane) = w;
    }
}

constexpr size_t CC_TOTAL = 2 * 64 * 128 * (size_t)(120 + 504 + 2040);
__device__ __forceinline__ void cache_copy_range(const Args& a, size_t q0, size_t q1, int tid) {
    size_t base = 0;
#pragma unroll 1
    for (int kvg = 0; kvg < 6; ++kvg) {
        const int g = kvg >> 1, W = 128 << (2 * g);
        const size_t per = (size_t)(W - 8) * 128, n = 64 * per, full = (size_t)W * 128;
        const size_t lo = q0 > base ? q0 : base, hi = q1 < base + n ? q1 : base + n;
        if (lo < hi) {
            const f32x4* src = (const f32x4*)a.in[2 + kvg];
            const size_t ooff = (kvg == 0) ? O_SWK0 : (kvg == 1) ? O_SWV0 : (kvg == 2) ? O_SWK1 : (kvg == 3) ? O_SWV1 : (kvg == 4) ? O_SWK2 : O_SWV2;
            f32x4* dst = (f32x4*)(a.out + ooff);
            size_t p = lo - base; const size_t pe = hi - base;
#pragma unroll 1
            while (p < pe) {
                const size_t lb = p / per, rem = p - lb * per;
                const size_t c0 = per - rem, c1 = pe - p, cnt = c0 < c1 ? c0 : c1;
                const f32x4* s = src + lb * full + 1024 + rem; f32x4* d = dst + lb * full + rem;
#pragma unroll 1
                for (size_t i = tid; i < cnt; i += 512 * 16) {
                    f32x4 v[16];
#pragma unroll
                    for (int k = 0; k < 16; ++k) if (i + k * 512 < cnt) v[k] = __builtin_nontemporal_load(s + i + k * 512);
#pragma unroll
                    for (int k = 0; k < 16; ++k) if (i + k * 512 < cnt) __builtin_nontemporal_store(v[k], d + i + k * 512);
                }
                p += cnt;
            }
        }
        base += n;
    }
}
__device__ __forceinline__ void cache_copy_tail(const Args& a, int nwg, int f0, int f1, int tid) {
    const int G = gridDim.x, fi = nwg % G, c = blockIdx.x;
    if (c < fi) return;
    const size_t R0 = CC_TOTAL * (size_t)f0 / 1000, R1 = CC_TOTAL * (size_t)f1 / 1000, nidle = (size_t)(G - fi), idx = (size_t)(c - fi);
    cache_copy_range(a, R0 + (R1 - R0) * idx / nidle, R0 + (R1 - R0) * (idx + 1) / nidle, tid);
}

constexpr int KVS = 272;
constexpr int AT_VOFF = 256 * KVS;
__device__ __forceinline__ void attn_prompt_item(LAS unsigned char* lds, const bf16_t* __restrict__ z, bf16_t* __restrict__ og, float* __restrict__ lse, int item, int tid) {
    const int wid = __builtin_amdgcn_readfirstlane(tid >> 6), lane = tid & 63, fr = lane & 15, quad = lane >> 4;
    const int blk = item & 63; int rest = item >> 6; const int j = rest & 3; rest >>= 2; const int g = rest % 3, b = rest / 3;
    const int dsh = 2 * g, dil = 1 << dsh, r = blk >> (6 - dsh), qb = blk & ((64 >> dsh) - 1), hh = g * 4 + j;
    const float slope_d = exp2f(-8.0f * (float)(hh + 1) / 12.0f) * (float)dil;
    const bf16_t* zb = z + (size_t)b * SEQ * DIN;
#pragma unroll
    for (int it = 0; it < 8; ++it) {
        const int idx = tid + it * 512, kk = idx >> 4, ch = idx & 15, sp = 128 * qb - 128 + kk;
        u32x4 kv = {0u, 0u, 0u, 0u}, vv = {0u, 0u, 0u, 0u};
        if (sp >= 0) { const bf16_t* zr = zb + (size_t)(sp * dil + r) * DIN + hh * 128 + ch * 8; kv = *(const u32x4*)(zr + Z_AK); vv = *(const u32x4*)(zr + Z_AV); }
        *(LAS u32x4*)(lds + kk * KVS + ch * 16) = kv; *(LAS u32x4*)(lds + AT_VOFF + kk * KVS + ch * 16) = vv;
    }
    const int sq = 128 * qb + 16 * wid + fr;
    const size_t qrow = (size_t)b * SEQ + (size_t)(sq * dil + r);
    bf16x8 qf[4];
#pragma unroll
    for (int ks = 0; ks < 4; ++ks) qf[ks] = *(const bf16x8*)(z + qrow * DIN + Z_AQ + hh * 128 + ks * 32 + quad * 8);
    __syncthreads();
    f32x4 sc[9];
#pragma unroll
    for (int kt = 0; kt < 9; ++kt) {
        f32x4 acc = {0.f, 0.f, 0.f, 0.f};
#pragma unroll
        for (int ks = 0; ks < 4; ++ks) { const bf16x8 ka = *(LAS const bf16x8*)(lds + (16 * (wid + kt) + fr) * KVS + ks * 64 + quad * 16); acc = MFMA16(ka, qf[ks], acc); }
        sc[kt] = acc;
    }
    float mx = -INFINITY;
#pragma unroll
    for (int kt = 0; kt < 9; ++kt)
#pragma unroll
        for (int e = 0; e < 4; ++e) {
            const int dist = 128 - 16 * kt + fr - 4 * quad - e, keyrel = 16 * (wid + kt) + 4 * quad + e;
            const bool valid = (dist >= 0) && (dist <= 128) && (qb > 0 || keyrel >= 128);
            const float s = valid ? sc[kt][e] - slope_d * (float)dist : -INFINITY;
            sc[kt][e] = s; mx = fmaxf(mx, s);
        }
    mx = fmaxf(mx, __shfl_xor(mx, 16)); mx = fmaxf(mx, __shfl_xor(mx, 32));
    float den = 0.f;
#pragma unroll
    for (int kt = 0; kt < 9; ++kt)
#pragma unroll
        for (int e = 0; e < 4; ++e) { const float p = __expf(sc[kt][e] - mx); sc[kt][e] = p; den += p; }
    den += __shfl_xor(den, 16); den += __shfl_xor(den, 32);
    const float inv = 1.0f / den;
    f32x4 o[8];
#pragma unroll
    for (int dt = 0; dt < 8; ++dt) o[dt] = (f32x4){0.f, 0.f, 0.f, 0.f};
#pragma unroll
    for (int kp = 0; kp < 5; ++kp) {
        const int TA = wid + 2 * kp, TB = (2 * kp + 1 < 9) ? TA + 1 : TA;
        u32x4 pw; pw.x = pk2(sc[2 * kp][0] * inv, sc[2 * kp][1] * inv); pw.y = pk2(sc[2 * kp][2] * inv, sc[2 * kp][3] * inv);
        if (2 * kp + 1 < 9) { pw.z = pk2(sc[(2 * kp + 1) % 9][0] * inv, sc[(2 * kp + 1) % 9][1] * inv); pw.w = pk2(sc[(2 * kp + 1) % 9][2] * inv, sc[(2 * kp + 1) % 9][3] * inv); } else { pw.z = 0u; pw.w = 0u; }
        const bf16x8 p8 = __builtin_bit_cast(bf16x8, pw);
        LAS const unsigned char* bA = lds + AT_VOFF + (16 * TA + 4 * quad + (fr >> 2)) * KVS + (fr & 3) * 8;
        LAS const unsigned char* bB = lds + AT_VOFF + (16 * TB + 4 * quad + (fr >> 2)) * KVS + (fr & 3) * 8;
#pragma unroll
        for (int dt = 0; dt < 8; ++dt) { const v4i16_t va = tr4(bA + dt * 32), vb = tr4(bB + dt * 32); o[dt] = MFMA16(cat8(va, vb), p8, o[dt]); }
    }
    bf16_t* orow = og + ((size_t)g * MT + qrow) * 512 + j * 128 + 4 * quad;
#pragma unroll
    for (int dt = 0; dt < 8; ++dt) { u32x2 w; w.x = pk2(o[dt][0], o[dt][1]); w.y = pk2(o[dt][2], o[dt][3]); *(u32x2*)(orow + 16 * dt) = w; }
    if (quad == 0) lse[((size_t)g * MT + qrow) * 4 + j] = mx + __logf(den);
    __syncthreads();
}

constexpr int RVS = 528;
constexpr int RU_VOFF = 128 * KVS;
__device__ __forceinline__ void ret_u_item(LAS unsigned char* lds, const bf16_t* __restrict__ z, bf16_t* __restrict__ U, int item, int tid) {
    const int wid = __builtin_amdgcn_readfirstlane(tid >> 6), lane = tid & 63, fr = lane & 15, quad = lane >> 4;
    const int c = item & 63, bh = item >> 6, h = bh & 3, b = bh >> 2;
    const float lg = ret_lg(h);
    const bf16_t* z0 = z + ((size_t)b * SEQ + 128 * c) * DIN;
#pragma unroll
    for (int it = 0; it < 4; ++it) {
        const int idx = tid + it * 512, jj = idx >> 4, ch = idx & 15;
        const u32x4 kv = *(const u32x4*)(z0 + (size_t)jj * DIN + Z_RK + h * 128 + ch * 8);
        const float zeta = __expf(lg * (float)(127 - jj));
        u32x4 o; o.x = pk2(bflo(kv.x) * zeta, bfhi(kv.x) * zeta); o.y = pk2(bflo(kv.y) * zeta, bfhi(kv.y) * zeta); o.z = pk2(bflo(kv.z) * zeta, bfhi(kv.z) * zeta); o.w = pk2(bflo(kv.w) * zeta, bfhi(kv.w) * zeta);
        *(LAS u32x4*)(lds + jj * KVS + ch * 16) = o;
    }
#pragma unroll
    for (int it = 0; it < 8; ++it) {
        const int idx = tid + it * 512, jj = idx >> 5, ch = idx & 31;
        *(LAS u32x4*)(lds + RU_VOFF + jj * RVS + ch * 16) = *(const u32x4*)(z0 + (size_t)jj * DIN + Z_RV + h * 256 + ch * 8);
    }
    __syncthreads();
    f32x4 acc[2][8];
#pragma unroll
    for (int a = 0; a < 2; ++a)
#pragma unroll
        for (int d = 0; d < 8; ++d) acc[a][d] = (f32x4){0.f, 0.f, 0.f, 0.f};
#pragma unroll
    for (int ks = 0; ks < 4; ++ks) {
        const int jrow = 32 * ks + 8 * quad + (fr >> 2);
        bf16x8 A[2];
#pragma unroll
        for (int a = 0; a < 2; ++a) { LAS const unsigned char* p = lds + RU_VOFF + jrow * RVS + (16 * (2 * wid + a) + 4 * (fr & 3)) * 2; A[a] = cat8(tr4(p), tr4(p + 4 * RVS)); }
#pragma unroll
        for (int d = 0; d < 8; ++d) { LAS const unsigned char* p = lds + jrow * KVS + (16 * d + 4 * (fr & 3)) * 2; const bf16x8 B = cat8(tr4(p), tr4(p + 4 * KVS));
            acc[0][d] = MFMA16(B, A[0], acc[0][d]); acc[1][d] = MFMA16(B, A[1], acc[1][d]); }
    }
    bf16_t* Uo = U + (size_t)item * 32768;
#pragma unroll
    for (int a = 0; a < 2; ++a)
#pragma unroll
        for (int d = 0; d < 8; ++d) { u32x2 w; w.x = pk2(acc[a][d][0], acc[a][d][1]); w.y = pk2(acc[a][d][2], acc[a][d][3]); *(u32x2*)(Uo + (16 * (2 * wid + a) + fr) * 128 + 16 * d + 4 * quad) = w; }
    __syncthreads();
}

__device__ __forceinline__ void ret_sample_item(LAS unsigned char* lds, const bf16_t* __restrict__ z, const float* __restrict__ S0, float* __restrict__ Sout, bf16_t* __restrict__ oret, int item, int tid) {
    const int h = item & 3, b = item >> 2;
    const int lane = tid & 63, wave = tid >> 6;
    const float lg = ret_lg(h);
    LAS float* qs = (LAS float*)lds;
    LAS float* ksm = qs + 1024;
    LAS float* Pm = ksm + 1024;
    LAS float* red = Pm + 64;
    LAS float* ob = red + 4096;
    const bf16_t* z0 = z + (size_t)(MP + b * 8) * DIN;
    for (int idx = tid; idx < 1024; idx += 512) { const int i = idx >> 7, d = idx & 127; qs[idx] = __uint_as_float((unsigned)z0[(size_t)i * DIN + Z_RQ + h * 128 + d] << 16); ksm[idx] = __uint_as_float((unsigned)z0[(size_t)i * DIN + Z_RK + h * 128 + d] << 16); }
    const int v = tid & 255, half = tid >> 8;
    float vv[8], vz[8];
#pragma unroll
    for (int jj = 0; jj < 8; ++jj) { vv[jj] = __uint_as_float((unsigned)z0[(size_t)jj * DIN + Z_RV + h * 256 + v] << 16); vz[jj] = vv[jj] * __expf(lg * (float)(7 - jj)); }
    __syncthreads();
    if (tid < 64) { const int i = tid >> 3, jj = tid & 7; float s = 0.f; for (int d = 0; d < 128; ++d) s += qs[i * 128 + d] * ksm[jj * 128 + d]; Pm[tid] = (jj <= i) ? s * __expf(lg * (float)(i - jj)) : 0.f; }
    const float cd = __expf(lg * 8.0f);
    float cr[8];
#pragma unroll
    for (int i = 0; i < 8; ++i) cr[i] = 0.f;
    const float* Sp = S0 + (size_t)item * 32768 + v; float* So = Sout + (size_t)item * 32768 + v;
#pragma unroll 16
    for (int dd = 0; dd < 64; ++dd) {
        const int d = half * 64 + dd;
        const float s = __builtin_nontemporal_load(Sp + (size_t)d * 256);
        float nw = cd * s;
#pragma unroll
        for (int i = 0; i < 8; ++i) { cr[i] += qs[i * 128 + d] * s; nw += ksm[i * 128 + d] * vz[i]; }
        __builtin_nontemporal_store(nw, So + (size_t)d * 256);
    }
#pragma unroll
    for (int i = 0; i < 8; ++i) red[(half * 8 + i) * 256 + v] = cr[i];
    __syncthreads();
#pragma unroll
    for (int ii = 0; ii < 4; ++ii) {
        const int i = half * 4 + ii;
        float o = (red[i * 256 + v] + red[(8 + i) * 256 + v]) * __expf(lg * (float)(i + 1));
#pragma unroll
        for (int jj = 0; jj < 8; ++jj) o += Pm[i * 8 + jj] * vv[jj];
        ob[i * 256 + v] = o;
    }
    __syncthreads();
    {
        const int i = wave; float x[4]; float s = 0.f;
#pragma unroll
        for (int e = 0; e < 4; ++e) { x[e] = ob[i * 256 + 4 * lane + e]; s += x[e]; }
        const float mu = wave_sum(s) * (1.0f / 256.0f); float q = 0.f;
#pragma unroll
        for (int e = 0; e < 4; ++e) { x[e] -= mu; q += x[e] * x[e]; }
        const float rstd = 1.0f / sqrtf(wave_sum(q) * (1.0f / 256.0f) + 1e-6f);
        const u32x2 gw = *(const u32x2*)(z0 + (size_t)i * DIN + Z_RG + h * 256 + 4 * lane);
        float gq[4] = {bflo(gw.x), bfhi(gw.x), bflo(gw.y), bfhi(gw.y)};
#pragma unroll
        for (int e = 0; e < 4; ++e) x[e] = x[e] * rstd * gq[e] / (1.0f + __expf(-gq[e]));
        u32x2 w; w.x = pk2(x[0], x[1]); w.y = pk2(x[2], x[3]);
        *(u32x2*)(oret + (size_t)(MP + b * 8 + i) * DM + h * 256 + 4 * lane) = w;
    }
    __syncthreads();
}

__device__ __forceinline__ void attn_sample_item(LAS unsigned char* lds, const bf16_t* __restrict__ z, const float* __restrict__ ck, const float* __restrict__ cv, int l, bf16_t* __restrict__ og, float* __restrict__ lse, int item, int tid) {
    const int j = item & 3; int rest = item >> 2; const int g = rest % 3, b = rest / 3;
    const int lane = tid & 63, i = tid >> 6, dsh = 2 * g, dil = 1 << dsh, W = 128 << dsh, hh = g * 4 + j;
    const float slope_d = exp2f(-8.0f * (float)(hh + 1) / 12.0f) * (float)dil;
    LAS float* sc = (LAS float*)lds + i * 136;
    const size_t zrow = (size_t)MP + b * 8 + i;
    const bf16_t* zq = z + zrow * DIN + Z_AQ + hh * 128;
    const int c16 = lane & 15, rr = lane >> 4;
    float q[8];
    { const u32x2 a0 = *(const u32x2*)(zq + 4 * c16), a1 = *(const u32x2*)(zq + 64 + 4 * c16);
      q[0] = bflo(a0.x); q[1] = bfhi(a0.x); q[2] = bflo(a0.y); q[3] = bfhi(a0.y); q[4] = bflo(a1.x); q[5] = bfhi(a1.x); q[6] = bflo(a1.y); q[7] = bfhi(a1.y); }
    const float* ckb = ck + ((size_t)(l * 32 + b) * W) * 512 + j * 128 + 4 * c16;
    const float* cvb = cv + ((size_t)(l * 32 + b) * W) * 512 + j * 128 + 4 * c16;
    const bf16_t* znew = z + (size_t)(MP + b * 8) * DIN + hh * 128 + 4 * c16;
    const size_t rstride = (size_t)dil * 512 * 4;
    const float* kp0 = ckb + (size_t)(i + rr * dil) * 512;
#pragma unroll 1
    for (int bt = 0; bt < 2; ++bt) {
        f32x4 k0[15], k1[15];
#pragma unroll
        for (int t = 0; t < 15; ++t) { const float* p = kp0 + (size_t)(bt * 15 + t) * rstride; k0[t] = __builtin_nontemporal_load((const f32x4*)p); k1[t] = __builtin_nontemporal_load((const f32x4*)(p + 64)); }
#pragma unroll
        for (int t = 0; t < 15; ++t) {
            float s = (q[0] * k0[t][0] + q[1] * k0[t][1]) + (q[2] * k0[t][2] + q[3] * k0[t][3]) + (q[4] * k1[t][0] + q[5] * k1[t][1]) + (q[6] * k1[t][2] + q[7] * k1[t][3]);
            s += __shfl_xor(s, 1); s += __shfl_xor(s, 2); s += __shfl_xor(s, 4); s += __shfl_xor(s, 8);
            const int u = 4 * (bt * 15 + t) + rr;
            if (c16 == 0) sc[u] = s - slope_d * (float)(128 - u);
        }
    }
#pragma unroll
    for (int it = 30; it < 33; ++it) {
        const int u = 4 * it + rr; float s = 0.f;
        if (u <= 128) {
            const int index = i + u * dil;
            float k[8];
            if (index < W) { const f32x4 a0 = *(const f32x4*)(ckb + (size_t)index * 512), a1 = *(const f32x4*)(ckb + (size_t)index * 512 + 64);
                k[0] = a0[0]; k[1] = a0[1]; k[2] = a0[2]; k[3] = a0[3]; k[4] = a1[0]; k[5] = a1[1]; k[6] = a1[2]; k[7] = a1[3]; }
            else { const bf16_t* zk = znew + (size_t)(index - W) * DIN + Z_AK; const u32x2 a0 = *(const u32x2*)zk, a1 = *(const u32x2*)(zk + 64);
                k[0] = bflo(a0.x); k[1] = bfhi(a0.x); k[2] = bflo(a0.y); k[3] = bfhi(a0.y); k[4] = bflo(a1.x); k[5] = bfhi(a1.x); k[6] = bflo(a1.y); k[7] = bfhi(a1.y); }
#pragma unroll
            for (int e = 0; e < 8; ++e) s += q[e] * k[e];
        }
        s += __shfl_xor(s, 1); s += __shfl_xor(s, 2); s += __shfl_xor(s, 4); s += __shfl_xor(s, 8);
        if (c16 == 0 && u <= 128) sc[u] = s - slope_d * (float)(128 - u);
    }
    asm volatile("s_waitcnt lgkmcnt(0)" ::: "memory");
    __syncthreads();
    float s0 = sc[lane], s1 = sc[lane + 64], s2 = (lane == 0) ? sc[128] : -INFINITY;
    float mx = fmaxf(fmaxf(s0, s1), s2);
#pragma unroll
    for (int o = 1; o < 64; o <<= 1) mx = fmaxf(mx, __shfl_xor(mx, o));
    s0 = __expf(s0 - mx); s1 = __expf(s1 - mx); s2 = __expf(s2 - mx);
    const float den = wave_sum(s0 + s1 + s2), inv = 1.0f / den;
    __syncthreads();
    sc[lane] = s0 * inv; sc[lane + 64] = s1 * inv; if (lane == 0) sc[128] = s2 * inv;
    if (lane >= 1 && lane < 4) sc[128 + lane] = 0.f;
    asm volatile("s_waitcnt lgkmcnt(0)" ::: "memory");
    __syncthreads();
    float o[8];
#pragma unroll
    for (int e = 0; e < 8; ++e) o[e] = 0.f;
    const float* vp0 = cvb + (size_t)(i + rr * dil) * 512;
#pragma unroll 1
    for (int bt = 0; bt < 2; ++bt) {
        f32x4 v0[15], v1[15];
#pragma unroll
        for (int t = 0; t < 15; ++t) { const float* p = vp0 + (size_t)(bt * 15 + t) * rstride; v0[t] = __builtin_nontemporal_load((const f32x4*)p); v1[t] = __builtin_nontemporal_load((const f32x4*)(p + 64)); }
#pragma unroll
        for (int t = 0; t < 15; ++t) { const float p = sc[4 * (bt * 15 + t) + rr];
#pragma unroll
            for (int e = 0; e < 4; ++e) { o[e] += p * v0[t][e]; o[4 + e] += p * v1[t][e]; } }
    }
#pragma unroll
    for (int it = 30; it < 33; ++it) {
        const int u = 4 * it + rr;
        if (u <= 128) {
            const int index = i + u * dil; const float p = sc[u];
            float v[8];
            if (index < W) { const f32x4 a0 = *(const f32x4*)(cvb + (size_t)index * 512), a1 = *(const f32x4*)(cvb + (size_t)index * 512 + 64);
                v[0] = a0[0]; v[1] = a0[1]; v[2] = a0[2]; v[3] = a0[3]; v[4] = a1[0]; v[5] = a1[1]; v[6] = a1[2]; v[7] = a1[3]; }
            else { const bf16_t* zv = znew + (size_t)(index - W) * DIN + Z_AV; const u32x2 a0 = *(const u32x2*)zv, a1 = *(const u32x2*)(zv + 64);
                v[0] = bflo(a0.x); v[1] = bfhi(a0.x); v[2] = bflo(a0.y); v[3] = bfhi(a0.y); v[4] = bflo(a1.x); v[5] = bfhi(a1.x); v[6] = bflo(a1.y); v[7] = bfhi(a1.y); }
#pragma unroll
            for (int e = 0; e < 8; ++e) o[e] += p * v[e];
        }
    }
#pragma unroll
    for (int e = 0; e < 8; ++e) { o[e] += __shfl_xor(o[e], 16); o[e] += __shfl_xor(o[e], 32); }
    if (rr == 0) {
        bf16_t* op = og + ((size_t)g * MT + zrow) * 512 + j * 128 + 4 * c16;
        u32x2 w0, w1; w0.x = pk2(o[0], o[1]); w0.y = pk2(o[2], o[3]); w1.x = pk2(o[4], o[5]); w1.y = pk2(o[6], o[7]);
        *(u32x2*)op = w0; *(u32x2*)(op + 64) = w1;
    }
    if (lane == 0) lse[((size_t)g * MT + zrow) * 4 + j] = mx + __logf(den);
    __syncthreads();
}

__device__ __forceinline__ void win_copy(const Args& a, const bf16_t* __restrict__ z, int l, int tid) {
    const int lane = tid & 63, gw = blockIdx.x * 8 + (tid >> 6), NGW = gridDim.x * 8;
    for (int idx = gw; idx < 12288; idx += NGW) {
        const int kv = idx / 6144; int rem = idx % 6144;
        size_t zrow; int g; float* dst;
        if (rem < 5376) {
            int W, bw;
            if (rem < 256) { g = 0; W = 128; bw = rem; } else if (rem < 1280) { g = 1; W = 512; bw = rem - 256; } else { g = 2; W = 2048; bw = rem - 1280; }
            const int b = bw / W, w = bw % W;
            zrow = (size_t)b * SEQ + (SEQ - W) + w;
            const size_t ooff = (g == 0) ? (kv ? O_PWV0 : O_PWK0) : (g == 1) ? (kv ? O_PWV1 : O_PWK1) : (kv ? O_PWV2 : O_PWK2);
            dst = a.out + ooff + (((size_t)l * 2 + b) * W + w) * 512;
        } else {
            rem -= 5376; g = rem >> 8; const int b = (rem & 255) >> 3, i = rem & 7, W = 128 << (2 * g);
            zrow = (size_t)MP + b * 8 + i;
            const size_t ooff = (g == 0) ? (kv ? O_SWV0 : O_SWK0) : (g == 1) ? (kv ? O_SWV1 : O_SWK1) : (kv ? O_SWV2 : O_SWK2);
            dst = a.out + ooff + (((size_t)l * 32 + b) * W + (W - 8) + i) * 512;
        }
        const u32x4 w4 = *(const u32x4*)(z + zrow * DIN + (kv ? Z_AV : Z_AK) + g * 512 + 8 * lane);
        __builtin_nontemporal_store((f32x4){bflo(w4.x), bfhi(w4.x), bflo(w4.y), bfhi(w4.y)}, (f32x4*)(dst + 8 * lane));
        __builtin_nontemporal_store((f32x4){bflo(w4.z), bfhi(w4.z), bflo(w4.w), bfhi(w4.w)}, (f32x4*)(dst + 8 * lane + 4));
    }
}

template <bool DO_SCAN, bool DO_COMBINE>
__device__ __forceinline__ void p3_scan_combine(const Args& a, int l, int tid) {
    const bf16_t* U = (const bf16_t*)(a.ws + WS_U); bf16_t* Rp = (bf16_t*)(a.ws + WS_RP);
    const int gt = blockIdx.x * 512 + tid, GT = gridDim.x * 512;
    if constexpr (DO_SCAN) for (int e = gt; e < 131072; e += GT) {
        const int vd = e & 32767, bh0 = e >> 15, bh1 = bh0 + 4, h = bh0 & 3;
        const float cd = __expf(ret_lg(h) * 128.0f);
        float R0 = 0.f, R1 = 0.f;
        const bf16_t* up0 = U + (size_t)bh0 * 64 * 32768 + vd; bf16_t* rp0 = Rp + (size_t)bh0 * 64 * 32768 + vd;
        const bf16_t* up1 = U + (size_t)bh1 * 64 * 32768 + vd; bf16_t* rp1 = Rp + (size_t)bh1 * 64 * 32768 + vd;
#pragma unroll 1
        for (int c0 = 0; c0 < 64; c0 += 16) {
            float u0[16], u1[16];
#pragma unroll
            for (int k = 0; k < 16; ++k) { u0[k] = __uint_as_float((unsigned)up0[(size_t)(c0 + k) * 32768] << 16); u1[k] = __uint_as_float((unsigned)up1[(size_t)(c0 + k) * 32768] << 16); }
#pragma unroll
            for (int k = 0; k < 16; ++k) { rp0[(size_t)(c0 + k) * 32768] = (bf16_t)f2bf(R0); R0 = cd * R0 + u0[k]; rp1[(size_t)(c0 + k) * 32768] = (bf16_t)f2bf(R1); R1 = cd * R1 + u1[k]; }
        }
        const int v = vd >> 7, d = vd & 127;
        a.out[O_PRET + ((size_t)l * 8 + bh0) * 32768 + d * 256 + v] = R0;
        a.out[O_PRET + ((size_t)l * 8 + bh1) * 32768 + d * 256 + v] = R1;
    }
    const bf16_t* og = (const bf16_t*)(a.ws + WS_OG); const float* lse = (const float*)(a.ws + WS_LSE); bf16_t* oatt = (bf16_t*)(a.ws + WS_OATT);
    const int lane = tid & 63, gw = blockIdx.x * 8 + (tid >> 6), NGW = gridDim.x * 8;
    if constexpr (DO_COMBINE) for (int row0 = gw; row0 < MT; row0 += 2 * NGW) {
        const int j = lane >> 4;
        u32x4 q[2][3]; float ls[2][3];
#pragma unroll
        for (int rr = 0; rr < 2; ++rr) { const int row = (row0 + rr * NGW < MT) ? row0 + rr * NGW : row0;
#pragma unroll
            for (int g = 0; g < 3; ++g) { ls[rr][g] = lse[((size_t)g * MT + row) * 4 + j]; q[rr][g] = *(const u32x4*)(og + ((size_t)g * MT + row) * 512 + 8 * lane); } }
#pragma unroll
        for (int rr = 0; rr < 2; ++rr) {
            const int row = row0 + rr * NGW; if (row >= MT) break;
            const float mx = fmaxf(ls[rr][0], fmaxf(ls[rr][1], ls[rr][2]));
            float w0 = __expf(ls[rr][0] - mx), w1 = __expf(ls[rr][1] - mx), w2 = __expf(ls[rr][2] - mx);
            const float inv = 1.0f / (w0 + w1 + w2); w0 *= inv; w1 *= inv; w2 *= inv;
            const u32x4 q0 = q[rr][0], q1 = q[rr][1], q2 = q[rr][2];
            const f32x4 a0 = {bflo(q0.x), bfhi(q0.x), bflo(q0.y), bfhi(q0.y)}, a1 = {bflo(q0.z), bfhi(q0.z), bflo(q0.w), bfhi(q0.w)};
            const f32x4 b0 = {bflo(q1.x), bfhi(q1.x), bflo(q1.y), bfhi(q1.y)}, b1 = {bflo(q1.z), bfhi(q1.z), bflo(q1.w), bfhi(q1.w)};
            const f32x4 c0_ = {bflo(q2.x), bfhi(q2.x), bflo(q2.y), bfhi(q2.y)}, c1_ = {bflo(q2.z), bfhi(q2.z), bflo(q2.w), bfhi(q2.w)};
            const f32x4 r0 = a0 * w0 + b0 * w1 + c0_ * w2, r1 = a1 * w0 + b1 * w1 + c1_ * w2;
            u32x4 w; w.x = pk2(r0[0], r0[1]); w.y = pk2(r0[2], r0[3]); w.z = pk2(r1[0], r1[1]); w.w = pk2(r1[2], r1[3]);
            *(u32x4*)(oatt + (size_t)row * 512 + 8 * lane) = w;
        }
    }
}

constexpr int RO_VOFF = 128 * KVS, RO_ROFF = RO_VOFF + 128 * RVS;
__device__ __forceinline__ void ret_out_item(LAS unsigned char* lds, const bf16_t* __restrict__ z, const bf16_t* __restrict__ Rp, bf16_t* __restrict__ oret, int item, int tid) {
    const int wid = __builtin_amdgcn_readfirstlane(tid >> 6), lane = tid & 63, fr = lane & 15, quad = lane >> 4;
    const int c = item & 63, bh = item >> 6, h = bh & 3, b = bh >> 2;
    const float lg = ret_lg(h);
    const size_t zrow0 = (size_t)b * SEQ + 128 * c;
    const bf16_t* z0 = z + zrow0 * DIN;
    const bf16_t* R0 = Rp + (size_t)item * 32768;
#pragma unroll
    for (int it = 0; it < 4; ++it) {
        const int idx = tid + it * 512, jj = idx >> 4, ch = idx & 15;
        *(LAS u32x4*)(lds + jj * KVS + ch * 16) = *(const u32x4*)(z0 + (size_t)jj * DIN + Z_RK + h * 128 + ch * 8);
        *(LAS u32x4*)(lds + RO_ROFF + jj * KVS + ch * 16) = *(const u32x4*)(R0 + (size_t)jj * 128 + ch * 8);
    }
#pragma unroll
    for (int it = 0; it < 8; ++it) {
        const int idx = tid + it * 512, jj = idx >> 5, ch = idx & 31;
        *(LAS u32x4*)(lds + RO_VOFF + jj * RVS + ch * 16) = *(const u32x4*)(z0 + (size_t)jj * DIN + Z_RV + h * 256 + ch * 8);
    }
    const int iq = 16 * wid + fr;
    bf16x8 qf[4];
#pragma unroll
    for (int ks = 0; ks < 4; ++ks) qf[ks] = *(const bf16x8*)(z0 + (size_t)iq * DIN + Z_RQ + h * 128 + ks * 32 + quad * 8);
    __syncthreads();
    f32x4 o[16];
#pragma unroll
    for (int vt = 0; vt < 16; ++vt) o[vt] = (f32x4){0.f, 0.f, 0.f, 0.f};
#pragma unroll
    for (int vt = 0; vt < 8; ++vt)
#pragma unroll
        for (int ks = 0; ks < 4; ++ks) { const bf16x8 ra = *(LAS const bf16x8*)(lds + RO_ROFF + (16 * vt + fr) * KVS + ks * 64 + quad * 16); o[vt] = MFMA16(ra, qf[ks], o[vt]); }
    __syncthreads();
#pragma unroll
    for (int it = 0; it < 4; ++it) {
        const int idx = tid + it * 512, jj = idx >> 4, ch = idx & 15;
        *(LAS u32x4*)(lds + RO_ROFF + jj * KVS + ch * 16) = *(const u32x4*)(R0 + (size_t)(128 + jj) * 128 + ch * 8);
    }
    __syncthreads();
#pragma unroll
    for (int vt = 0; vt < 8; ++vt)
#pragma unroll
        for (int ks = 0; ks < 4; ++ks) { const bf16x8 ra = *(LAS const bf16x8*)(lds + RO_ROFF + (16 * vt + fr) * KVS + ks * 64 + quad * 16); o[8 + vt] = MFMA16(ra, qf[ks], o[8 + vt]); }
    const float xi = __expf(lg * (float)(iq + 1));
#pragma unroll
    for (int vt = 0; vt < 16; ++vt) o[vt] = o[vt] * xi;
#pragma unroll
    for (int kp = 0; kp < 4; ++kp) {
        if (2 * kp <= wid) {
            const bool hasB = (2 * kp + 1 <= wid);
            const int TA = 2 * kp, TB = hasB ? TA + 1 : TA;
            f32x4 sa = {0.f, 0.f, 0.f, 0.f}, sb = {0.f, 0.f, 0.f, 0.f};
#pragma unroll
            for (int ks = 0; ks < 4; ++ks) {
                const bf16x8 ka = *(LAS const bf16x8*)(lds + (16 * TA + fr) * KVS + ks * 64 + quad * 16); sa = MFMA16(ka, qf[ks], sa);
                const bf16x8 kb = *(LAS const bf16x8*)(lds + (16 * TB + fr) * KVS + ks * 64 + quad * 16); sb = MFMA16(kb, qf[ks], sb);
            }
#pragma unroll
            for (int e = 0; e < 4; ++e) {
                const int da = iq - (16 * TA + 4 * quad + e), db = iq - (16 * TB + 4 * quad + e);
                sa[e] = (da >= 0) ? sa[e] * __expf(lg * (float)da) : 0.f;
                sb[e] = (hasB && db >= 0) ? sb[e] * __expf(lg * (float)db) : 0.f;
            }
            u32x4 pw; pw.x = pk2(sa[0], sa[1]); pw.y = pk2(sa[2], sa[3]); pw.z = pk2(sb[0], sb[1]); pw.w = pk2(sb[2], sb[3]);
            const bf16x8 p8 = __builtin_bit_cast(bf16x8, pw);
            LAS const unsigned char* bA = lds + RO_VOFF + (16 * TA + 4 * quad + (fr >> 2)) * RVS + (fr & 3) * 8;
            LAS const unsigned char* bB = lds + RO_VOFF + (16 * TB + 4 * quad + (fr >> 2)) * RVS + (fr & 3) * 8;
#pragma unroll
            for (int vt = 0; vt < 16; ++vt) { const v4i16_t va = tr4(bA + vt * 32), vb = tr4(bB + vt * 32); o[vt] = MFMA16(cat8(va, vb), p8, o[vt]); }
        }
    }
    float s = 0.f;
#pragma unroll
    for (int vt = 0; vt < 16; ++vt) s += (o[vt][0] + o[vt][1]) + (o[vt][2] + o[vt][3]);
    s += __shfl_xor(s, 16); s += __shfl_xor(s, 32);
    const float mu = s * (1.0f / 256.0f); float qv = 0.f;
#pragma unroll
    for (int vt = 0; vt < 16; ++vt) { o[vt] = o[vt] - mu; qv += (o[vt][0] * o[vt][0] + o[vt][1] * o[vt][1]) + (o[vt][2] * o[vt][2] + o[vt][3] * o[vt][3]); }
    qv += __shfl_xor(qv, 16); qv += __shfl_xor(qv, 32);
    const float rstd = 1.0f / sqrtf(qv * (1.0f / 256.0f) + 1e-6f);
    const bf16_t* rgp = z0 + (size_t)iq * DIN + Z_RG + h * 256 + 4 * quad;
    bf16_t* op = oret + (zrow0 + iq) * DM + h * 256 + 4 * quad;
#pragma unroll
    for (int vt = 0; vt < 16; ++vt) {
        const u32x2 gw = *(const u32x2*)(rgp + 16 * vt);
        const float g0 = bflo(gw.x), g1 = bfhi(gw.x), g2 = bflo(gw.y), g3 = bfhi(gw.y);
        const float x0 = o[vt][0] * rstd * g0 / (1.0f + __expf(-g0)), x1 = o[vt][1] * rstd * g1 / (1.0f + __expf(-g1)), x2 = o[vt][2] * rstd * g2 / (1.0f + __expf(-g2)), x3 = o[vt][3] * rstd * g3 / (1.0f + __expf(-g3));
        u32x2 w; w.x = pk2(x0, x1); w.y = pk2(x2, x3);
        *(u32x2*)(op + 16 * vt) = w;
    }
    __syncthreads();
}

#define XB_TMO      128
#define XB_XCNT(j)  (256  + 64 * (j))
#define XB_XSUB(j)  (1280 + 64 * (j))
#define XB_XGEN(j)  (2304 + 64 * (j))
#define XB_TOP      3328
#define XB_TOPGEN   3392
#define XCD_BAR_WORDS 3456
#define XB_SPIN_CAP (1u << 18)

__device__ __forceinline__ unsigned xb_ld(unsigned* p)              { return __hip_atomic_load(p, __ATOMIC_RELAXED, __HIP_MEMORY_SCOPE_AGENT); }
__device__ __forceinline__ unsigned xb_add(unsigned* p, unsigned v) { return __hip_atomic_fetch_add(p, v, __ATOMIC_RELAXED, __HIP_MEMORY_SCOPE_AGENT); }
__device__ __forceinline__ unsigned xb_xcc_id() { return (unsigned)__builtin_amdgcn_s_getreg((3 << 11) | 20) & 0xFu; }
#define XB_SPIN(cond, bar) do { unsigned _sp = 0; while (cond) { __builtin_amdgcn_s_sleep(1); \
    if ((++_sp & 255u) == 0u) { if (xb_ld(&(bar)[XB_TMO])) break; if (_sp > XB_SPIN_CAP) { atomicAdd(&(bar)[XB_TMO], 1u); break; } } } } while (0)

struct XcdBarrier {
    unsigned* bar; unsigned x;
    volatile LAS unsigned* st;
};

__device__ __forceinline__ XcdBarrier xcd_barrier_post(unsigned* bar, volatile LAS unsigned* st) {
    XcdBarrier b; b.bar = bar; b.x = xb_xcc_id(); b.st = st;
    if (threadIdx.x == 0) (void)xb_add(&bar[XB_XCNT(b.x)], 1u);
    return b;
}
__device__ __forceinline__ void xcd_barrier_complete(unsigned* bar, unsigned x, unsigned& nloc, unsigned& nx) {
    const unsigned G = gridDim.x * gridDim.y * gridDim.z;
    unsigned sum, cnt, mine, sp = 0u;
    for (;;) {
        sum = 0u; cnt = 0u; mine = 0u;
#pragma unroll
        for (unsigned j = 0; j < 16; ++j) { const unsigned c = xb_ld(&bar[XB_XCNT(j)]); sum += c; cnt += (c > 0u) ? 1u : 0u; mine = (j == x) ? c : mine; }
        if (sum == G) break;
        __builtin_amdgcn_s_sleep(1);
        if ((++sp & 255u) == 0u) { if (xb_ld(&bar[XB_TMO])) break; if (sp > XB_SPIN_CAP) { atomicAdd(&bar[XB_TMO], 1u); break; } }
    }
    nloc = mine > 0u ? mine : 1u; nx = cnt > 0u ? cnt : 1u;
}

__device__ __forceinline__ void xcd_barrier(const XcdBarrier& b) {
    asm volatile("s_waitcnt vmcnt(0)" ::: "memory");
    __syncthreads();
    if (threadIdx.x == 0) {
        unsigned* bar = b.bar;
        __builtin_amdgcn_s_waitcnt(0);
        unsigned nloc = b.st[0], nx = b.st[1];
        if (nloc == 0u) { xcd_barrier_complete(bar, b.x, nloc, nx); b.st[0] = nloc; b.st[1] = nx; }
        const unsigned old = xb_add(&bar[XB_XSUB(b.x)], 1u);
        const unsigned gen = old / nloc;
        if (old + 1u == (gen + 1u) * nloc) {
            __builtin_amdgcn_fence(__ATOMIC_RELEASE, "agent");
            asm volatile("s_waitcnt vmcnt(0)" ::: "memory");
            const unsigned og = xb_add(&bar[XB_TOP], 1u);
            const unsigned tg = og / nx;
            if (og + 1u == (tg + 1u) * nx) xb_add(&bar[XB_TOPGEN], 1u);
            else XB_SPIN(xb_ld(&bar[XB_TOPGEN]) == tg, bar);
            __builtin_amdgcn_fence(__ATOMIC_ACQUIRE, "agent");
            xb_add(&bar[XB_XGEN(b.x)], 1u);
            asm volatile("s_waitcnt vmcnt(0)" ::: "memory");
        } else {
            XB_SPIN(xb_ld(&bar[XB_XGEN(b.x)]) == gen, bar);
            __builtin_amdgcn_fence(__ATOMIC_ACQUIRE, "agent");
            asm volatile("s_waitcnt vmcnt(0)" ::: "memory");
        }
    }
    __syncthreads();
}

template <int MODE>
__device__ __forceinline__ void skinny_phase(LAS unsigned char* lds, const bf16_t* __restrict__ A, const bf16_t* __restrict__ Wt, int K, const pg8::Epi<MODE>& E, int tid_in) {
    int tid = tid_in; asm volatile("" : "+v"(tid));
    const int wid = __builtin_amdgcn_readfirstlane(tid >> 6), lane = tid & 63, fr = lane & 15, quad = lane >> 4;
    LAS f32x4* red = (LAS f32x4*)lds;
    LAS float* ssq_l = (LAS float*)(lds + 32768);
#pragma unroll 1
    for (int slab = blockIdx.x; slab < 256; slab += gridDim.x) {
        const int rt = slab & 15, cs = slab >> 4;
        const bf16_t* arow = A + (size_t)(MP + 16 * rt + fr) * K + 8 * quad;
        const bf16_t* wrow = Wt + (size_t)(64 * cs + fr) * K + 8 * quad;
        f32x4 acc[4];
#pragma unroll
        for (int ct = 0; ct < 4; ++ct) acc[ct] = (f32x4){0.f, 0.f, 0.f, 0.f};
        const int nks = K >> 5;
#pragma unroll 4
        for (int ks = wid; ks < nks; ks += 8) {
            const bf16x8 b = *(const bf16x8*)(arow + 32 * ks);
#pragma unroll
            for (int ct = 0; ct < 4; ++ct) { const bf16x8 w = *(const bf16x8*)(wrow + (size_t)(16 * ct) * K + 32 * ks); acc[ct] = MFMA16(w, b, acc[ct]); }
        }
#pragma unroll
        for (int ct = 0; ct < 4; ++ct) red[(wid * 4 + ct) * 64 + lane] = acc[ct];
        __syncthreads();
        if (wid < 4) {
            f32x4 s = red[wid * 64 + lane];
#pragma unroll
            for (int w = 1; w < 8; ++w) s = s + red[(w * 4 + wid) * 64 + lane];
            float ssq = E.elem(MP + 16 * rt + fr, 64 * cs + 16 * wid + 4 * quad, s);
            if constexpr (MODE == pg8::E_RES || MODE == pg8::E_GATE) { ssq += __shfl_xor(ssq, 16); ssq += __shfl_xor(ssq, 32); if (quad == 0) ssq_l[wid * 16 + fr] = ssq; }
        }
        __syncthreads();
        if constexpr (MODE == pg8::E_RES || MODE == pg8::E_GATE) { if (tid < 16) E.ssp_out[(size_t)(MP + 16 * rt + tid) * 16 + cs] = (ssq_l[tid] + ssq_l[16 + tid]) + (ssq_l[32 + tid] + ssq_l[48 + tid]); }
        __syncthreads();
    }
}

#define GEMM_PHASE(MODE, Aptr, Bptr, Mm, Nn, Kk, EPI) do { int kk_ = (Kk); asm volatile("" : "+s"(kk_)); pg8::Gemm g_{(const pg8::bf16_t*)(Aptr), (const pg8::bf16_t*)(Bptr), (Mm), (Nn), kk_}; pg8::StaticOrder S_; S_.init((Mm), (Nn), (int)gridDim.x, (int)blockIdx.x); \
    pg8::gemm_phase<pg8::Epi<MODE>, pg8::StaticOrder, true, true>((PG8_LAS unsigned char*)lds, g_, S_, (EPI)); } while (0)

__global__ void __launch_bounds__(512, 2) mega_fwd(Args a) {
    extern __shared__ __attribute__((aligned(16))) unsigned char lds_raw[];
    LAS unsigned char* lds = (LAS unsigned char*)lds_raw;
    cg::grid_group grid = cg::this_grid();
    int tid = threadIdx.x;
#define OPQ() asm volatile("" : "+v"(tid))
    unsigned char* ws = a.ws;
    float* ssp = (float*)(ws + WS_SSP); bf16_t* tbuf = (bf16_t*)(ws + WS_T);
    bf16_t* z = (bf16_t*)(ws + WS_Z); bf16_t* ubuf = (bf16_t*)(ws + WS_Z);
    bf16_t* oret = (bf16_t*)(ws + WS_ORET); bf16_t* oatt = (bf16_t*)(ws + WS_OATT); bf16_t* merged = (bf16_t*)(ws + WS_MERGED);
    bf16_t* og = (bf16_t*)(ws + WS_OG); float* lse = (float*)(ws + WS_LSE); bf16_t* U = (bf16_t*)(ws + WS_U); bf16_t* Rp = (bf16_t*)(ws + WS_RP);

#ifndef PHMASK
#define PHMASK 0xFFFFF
#endif
#define PH(n) if constexpr ((PHMASK >> (n)) & 1)
    unsigned* barw = (unsigned*)(ws + WS_CTL);
    volatile LAS unsigned* MISC = (volatile LAS unsigned*)(lds + LDS_BYTES - 64);
    if (tid < 2) MISC[tid] = 0u;
    if (blockIdx.x == 0) for (int i = tid; i < XCD_BAR_WORDS; i += 512) __hip_atomic_store(barw + i, 0u, __ATOMIC_RELAXED, __HIP_MEMORY_SCOPE_AGENT);
    PH(0) p0_prologue(a, lds, tid);
    grid.sync();
    const XcdBarrier xbar = xcd_barrier_post(barw, MISC);
#define GSYNC() xcd_barrier(xbar)

#pragma unroll 1
    for (int l = 0; l < 2; ++l) {
        unsigned char* wl = ws + WS_WT + (size_t)l * WT_LAYER;
        bf16_t* xb_cur = (bf16_t*)(ws + (l == 0 ? WS_XBA : WS_XBB));
        bf16_t* xb_nxt = (bf16_t*)(ws + (l == 0 ? WS_XBB : WS_XBA));
#ifndef REP_G
#define REP_G 1
#endif
#pragma unroll 1
        for (int rg_ = 0; rg_ < REP_G; ++rg_) {
        PH(1) { pg8::Epi<pg8::E_Z> E{z, DIN, nullptr, nullptr, ssp, nullptr, nullptr, nullptr}; GEMM_PHASE(pg8::E_Z, xb_cur, wl + WT_IN, MT, DIN, DM, E); }
        if (rg_ + 1 < REP_G) GSYNC();
        }
        cache_copy_tail(a, 2470, l * 500 + 0, l * 500 + 50, tid);
        GSYNC();
#ifndef REP_MIX
#define REP_MIX 1
#endif
#pragma unroll 1
        for (int rep_ = 0; rep_ < REP_MIX; ++rep_) {
        OPQ();
        if (blockIdx.x & 1) cache_copy_tail(a, 0, l * 500 + 150, l * 500 + 220, tid);
        PH(3) for (int it = blockIdx.x; it < 512; it += gridDim.x) ret_u_item(lds, z, U, it, tid);
        if (!(blockIdx.x & 1)) cache_copy_tail(a, 0, l * 500 + 150, l * 500 + 220, tid);
        GSYNC();
        if (blockIdx.x & 1) cache_copy_tail(a, 0, l * 500 + 220, l * 500 + 270, tid);
#pragma unroll 1
        for (int stage_ = 0; stage_ < 2; ++stage_) {
        const bool sample_now = ((stage_ == 0) == ((blockIdx.x & 1) != 0));
        if (!sample_now) {
        OPQ();
        PH(2) { const int per_ = (1536 + (int)gridDim.x - 1) / (int)gridDim.x; for (int i_ = 0; i_ < per_; ++i_) { const int it = (int)blockIdx.x * per_ + i_; if (it < 1536) attn_prompt_item(lds, z, og, lse, it, tid); } }
        } else {
        OPQ();
        PH(4) for (int it = blockIdx.x; it < 384; it += gridDim.x) {
            const int g = (it >> 2) % 3;
            attn_sample_item(lds, z, a.in[2 + 2 * g], a.in[3 + 2 * g], l, og, lse, it, tid);
        }
        OPQ();
        PH(5) for (int it = (blockIdx.x + gridDim.x / 2) % gridDim.x; it < 128; it += gridDim.x) ret_sample_item(lds, z, a.in[8] + (size_t)l * 128 * 32768, a.out + O_SRET + (size_t)l * 128 * 32768, oret, it, tid);
        }
        }
        OPQ();
        PH(7) p3_scan_combine<true, false>(a, l, tid);
        PH(6) win_copy(a, z, l, tid);
        if (!(blockIdx.x & 1)) cache_copy_tail(a, 0, l * 500 + 220, l * 500 + 270, tid);
        GSYNC();
        OPQ();
        if (blockIdx.x & 1) cache_copy_tail(a, 0, l * 500 + 270, l * 500 + 500, tid);
        PH(8) for (int it = blockIdx.x; it < 512; it += gridDim.x) ret_out_item(lds, z, Rp, oret, it, tid);
        PH(7) p3_scan_combine<false, true>(a, l, tid);
        if (!(blockIdx.x & 1)) cache_copy_tail(a, 0, l * 500 + 270, l * 500 + 500, tid);
        GSYNC();
        }
        PH(9) { pg8::Epi<pg8::E_RET> E{nullptr, DM, nullptr, tbuf, nullptr, nullptr, z + Z_GA, nullptr}; GEMM_PHASE(pg8::E_RET, oret, wl + WT_RET, MP, DM, DM, E); skinny_phase<pg8::E_RET>(lds, oret, (const bf16_t*)(wl + WT_RET), DM, E, tid); }
        PH(10) { pg8::Epi<pg8::E_ATT> E{merged, DM, nullptr, tbuf, nullptr, nullptr, z + Z_GB, nullptr}; GEMM_PHASE(pg8::E_ATT, oatt, wl + WT_ATT, MP, DM, 512, E); skinny_phase<pg8::E_ATT>(lds, oatt, (const bf16_t*)(wl + WT_ATT), 512, E, tid); }
        GSYNC();
        PH(11) { pg8::Epi<pg8::E_RES> E{xb_cur, DM, xb_cur, nullptr, nullptr, ssp, nullptr, (l == 0) ? a.in[0] : (const float*)nullptr}; GEMM_PHASE(pg8::E_RES, merged, wl + WT_OUT, MP, DM, DM, E);
          pg8::Epi<pg8::E_RES> Es{xb_cur, DM, xb_cur, nullptr, nullptr, ssp, nullptr, (l == 0) ? a.in[1] - (size_t)MP * DM : (const float*)nullptr}; skinny_phase<pg8::E_RES>(lds, merged, (const bf16_t*)(wl + WT_OUT), DM, Es, tid); }
        GSYNC();
#pragma unroll 1
        for (int rg_ = 0; rg_ < REP_G; ++rg_) {
        PH(12) { pg8::Epi<pg8::E_UP> E{ubuf, DFF, nullptr, nullptr, ssp, nullptr, nullptr, nullptr}; GEMM_PHASE(pg8::E_UP, xb_cur, wl + WT_UP, MT, DFF, DM, E); }
        if (rg_ + 1 < REP_G) GSYNC();
        }
        cache_copy_tail(a, 1040, l * 500 + 50, l * 500 + 150, tid);
        GSYNC();
        PH(13) { pg8::Epi<pg8::E_RES> E{xb_cur, DM, xb_cur, nullptr, nullptr, ssp, nullptr, nullptr}; GEMM_PHASE(pg8::E_RES, ubuf, wl + WT_DOWN, MP, DM, DFF, E); skinny_phase<pg8::E_RES>(lds, ubuf, (const bf16_t*)(wl + WT_DOWN), DFF, E, tid); }
        GSYNC();
        PH(14) { pg8::Epi<pg8::E_PLE> E{nullptr, DM, nullptr, tbuf, nullptr, nullptr, nullptr, nullptr}; GEMM_PHASE(pg8::E_PLE, ws + WS_PB + (size_t)l * MT * DPLE * 2, wl + WT_PLE, MP, DM, DPLE, E); skinny_phase<pg8::E_PLE>(lds, (const bf16_t*)(ws + WS_PB + (size_t)l * MT * DPLE * 2), (const bf16_t*)(wl + WT_PLE), DPLE, E, tid); }
        PH(15) { pg8::Epi<pg8::E_GATE> E{xb_nxt, DM, xb_cur, tbuf, nullptr, ssp, nullptr, nullptr}; GEMM_PHASE(pg8::E_GATE, xb_cur, wl + WT_GATE, MP, DM, DM, E); skinny_phase<pg8::E_GATE>(lds, xb_cur, (const bf16_t*)(wl + WT_GATE), DM, E, tid); }
        GSYNC();
    }
    {
        const int lane = tid & 63, gw = blockIdx.x * 8 + (tid >> 6), NGW = gridDim.x * 8;
        const float* nf = a.in[21];
        for (int m = gw; m < MT; m += NGW) {
            float sv = (lane < 16) ? ssp[(size_t)m * 16 + lane] : 0.f;
            sv = wave_sum(sv);
            const float rstd = 1.0f / sqrtf(sv * (1.0f / 1024.0f) + 1e-6f);
#pragma unroll
            for (int j = 0; j < 4; ++j) { const u32x2 xw_ = *(const u32x2*)((const bf16_t*)(ws + WS_XBA) + (size_t)m * DM + 4 * lane + 256 * j); const f32x4 v = {bflo(xw_.x), bfhi(xw_.x), bflo(xw_.y), bfhi(xw_.y)}; const f32x4 gn = *(const f32x4*)(nf + 4 * lane + 256 * j); *(f32x4*)(a.out + O_Y + (size_t)m * DM + 4 * lane + 256 * j) = v * rstd * gn; }
        }
    }
}

extern "C" void kernel_launch(void* const* d_in, const int* in_sizes, int n_in, void* d_out, int out_size, void* d_ws, size_t ws_size, hipStream_t stream) {
    static int grid = 0;
    if (grid == 0) {
        if (n_in != 22 || (size_t)out_size != O_END || ws_size < WS_END) { fprintf(stderr, "kernel_launch: unexpected shapes: n_in %d out %d (want %zu) ws %zu (need %zu)\n", n_in, out_size, (size_t)O_END, ws_size, (size_t)WS_END); grid = -1; return; }
        int dev = 0, cus = 0, per_cu = 0;
        if (hipGetDevice(&dev) != hipSuccess || hipDeviceGetAttribute(&cus, hipDeviceAttributeMultiprocessorCount, dev) != hipSuccess) { grid = -1; return; }
        if (hipFuncSetAttribute((const void*)mega_fwd, hipFuncAttributeMaxDynamicSharedMemorySize, LDS_BYTES) != hipSuccess) { fprintf(stderr, "kernel_launch: hipFuncSetAttribute failed\n"); grid = -1; return; }
        if (hipOccupancyMaxActiveBlocksPerMultiprocessor(&per_cu, (const void*)mega_fwd, 512, LDS_BYTES) != hipSuccess || per_cu < 1) { fprintf(stderr, "kernel_launch: occupancy query says %d\n", per_cu); per_cu = 1; }
        (void)hipGetLastError();
        grid = cus * 1;
    }
    if (grid < 0) return;
    Args a{};
    for (int i = 0; i < 22; ++i) a.in[i] = (const float*)d_in[i];
    a.out = (float*)d_out; a.ws = (unsigned char*)d_ws;
    void* args[] = {&a};
    hipError_t e = hipLaunchCooperativeKernel((const void*)mega_fwd, dim3(grid), dim3(512), args, LDS_BYTES, stream);
    if (e != hipSuccess) fprintf(stderr, "cooperative launch failed: %s (grid %d)\n", hipGetErrorString(e), grid);
}
```

```cpp
#include <hip/hip_runtime.h>
#include <hip/hip_cooperative_groups.h>
#include <cstdio>
#include <cstdint>
#include <cmath>
namespace cg = cooperative_groups;
namespace pg8 {
#define PG8_LAS __attribute__((address_space(3)))
typedef unsigned short bf16_t;
typedef short bf16x8 __attribute__((ext_vector_type(8)));
typedef float f32x4 __attribute__((ext_vector_type(4)));
typedef unsigned u32x4 __attribute__((ext_vector_type(4)));
constexpr int BM = 256, BK = 64, HALF = 128, HTB = HALF * BK * 2  , STAGE_BYTES = 8 * HTB, NXCD = 8, WGM = 4;

__host__ __device__ __forceinline__ int lds_byte(int r, int c) { const int st = (r >> 4) * 2 + (c >> 5), rr = r & 15, cc = c & 31, ob = rr * 64 + cc * 2; return st * 1024 + (ob ^ (((ob >> 9) & 1) << 5)); }
__host__ __device__ __forceinline__ void stage_rc(int b, int& R, int& C) { const int st = b / 1024, sb = b % 1024, swz = sb ^ (((sb >> 9) & 1) << 5); R = (st >> 1) * 16 + swz / 64; C = (st & 1) * 32 + (swz % 64) / 2; }
__host__ __device__ __forceinline__ int perm32(int rho) { const int n = rho >> 4, i = rho & 15; return 8 * (i >> 2) + 4 * n + (i & 3); }

struct Unit { int pm, pn; };
struct Gemm { const bf16_t* A; const bf16_t* Bt; int M, N, K; };

struct StaticOrder {
    int nM, nN, nwg, G, c;
    __host__ __device__ void init(int M, int N, int G_, int c_) { nM = M / BM; nN = N / BM; nwg = nM * nN; G = G_; c = c_; }
    __host__ __device__ bool next(int i, Unit& u) const {
        const long L = (long)i * G + c; if (L >= nwg) return false;
        int wgid = (int)L; { const int q = nwg / NXCD, r = nwg % NXCD, xcd = wgid % NXCD, off = wgid / NXCD; wgid = (xcd < r ? xcd * (q + 1) : r * (q + 1) + (xcd - r) * q) + off; }
        const int nig = WGM * nN, gid = wgid / nig, fm = gid * WGM, gsz = (nM - fm) < WGM ? (nM - fm) : WGM;
        u.pm = fm + ((wgid % nig) % gsz); u.pn = (wgid % nig) / gsz; return true;
    }
    __device__ __forceinline__ void a_ready(const Unit&) const {}
    __device__ __forceinline__ void done(const Unit&) const {}
};

__device__ __forceinline__ unsigned cvt_pk_bf16(float lo, float hi) { unsigned r; asm("v_cvt_pk_bf16_f32 %0, %1, %2" : "=v"(r) : "v"(lo), "v"(hi)); return r; }

typedef unsigned u32x2 __attribute__((ext_vector_type(2)));
__device__ __forceinline__ float bf2f(unsigned h) { return __uint_as_float(h << 16); }
__device__ __forceinline__ float sigmoidf_(float x) { return 1.0f / (1.0f + __expf(-x)); }
__device__ __forceinline__ f32x4 bf4_to_f32(u32x2 w) { f32x4 r; r[0] = bf2f(w.x & 0xffffu); r[1] = bf2f(w.x >> 16); r[2] = bf2f(w.y & 0xffffu); r[3] = bf2f(w.y >> 16); return r; }
__device__ __forceinline__ u32x2 f32_to_bf4(f32x4 v) { u32x2 w; w.x = cvt_pk_bf16(v[0], v[1]); w.y = cvt_pk_bf16(v[2], v[3]); return w; }
enum { E_Z = 0, E_UP = 1, E_RET = 2, E_ATT = 3, E_RES = 4, E_PLE = 5, E_GATE = 6 };
template <int MODE> struct Epi {
    static constexpr bool PERM = (MODE == E_Z || MODE == E_UP), AFTER_DRAIN = false;
    bf16_t* ob; int ldob; const bf16_t* xrb; bf16_t* t; const float* ssp_in; float* ssp_out; const bf16_t* gate; const float* xr;
    __device__ __forceinline__ float elem(int row, int col, const f32x4 a) const {
        const size_t off = (size_t)row * 1024 + col; float ssq = 0.f;
        if constexpr (MODE == E_RET || MODE == E_ATT) {
            const u32x2 gw = *(const u32x2*)(gate + (size_t)row * 9728 + col);
            f32x4 gv; gv[0] = sigmoidf_(bf2f(gw.x & 0xffffu)); gv[1] = sigmoidf_(bf2f(gw.x >> 16)); gv[2] = sigmoidf_(bf2f(gw.y & 0xffffu)); gv[3] = sigmoidf_(bf2f(gw.y >> 16));
            if constexpr (MODE == E_RET) { *(u32x2*)(t + off) = f32_to_bf4(gv * a); }
            else { const f32x4 tv = bf4_to_f32(*(const u32x2*)(t + off)); const f32x4 o = tv + gv * a; u32x2 w; w.x = cvt_pk_bf16(o[0], o[1]); w.y = cvt_pk_bf16(o[2], o[3]); *(u32x2*)(ob + off) = w; }
        } else if constexpr (MODE == E_PLE) {
            *(u32x2*)(t + off) = f32_to_bf4(a);
        } else if constexpr (MODE == E_RES || MODE == E_GATE) {
            f32x4 x = xr ? *(const f32x4*)(xr + off) : bf4_to_f32(*(const u32x2*)(xrb + off));
            if constexpr (MODE == E_GATE) { const f32x4 tv = bf4_to_f32(*(const u32x2*)(t + off)); f32x4 sg; sg[0] = sigmoidf_(a[0]); sg[1] = sigmoidf_(a[1]); sg[2] = sigmoidf_(a[2]); sg[3] = sigmoidf_(a[3]); x = x + tv * sg; }
            else x = x + a;
            u32x2 w; w.x = cvt_pk_bf16(x[0], x[1]); w.y = cvt_pk_bf16(x[2], x[3]); *(u32x2*)(ob + off) = w;
            ssq = (x[0] * x[0] + x[1] * x[1]) + (x[2] * x[2] + x[3] * x[3]);
        }
        return ssq;
    }
    __device__ __forceinline__ void operator()(const f32x4 (&acc)[2][2][4][2], const Unit& u, int wr, int wc, int fr, int fq) const {
        const int row0 = u.pm * BM + wr * 64 + fr;
        if constexpr (PERM) {
            const int col0 = u.pn * BM + wc * 32 + 8 * fq;
            f32x4 sp[2][4];
#pragma unroll
            for (int ai = 0; ai < 2; ++ai)
#pragma unroll
                for (int m = 0; m < 4; ++m) sp[ai][m] = *(const f32x4*)(ssp_in + (size_t)(row0 + ai * HALF + m * 16) * 16 + 4 * fq);
#pragma unroll
            for (int ai = 0; ai < 2; ++ai)
#pragma unroll
                for (int m = 0; m < 4; ++m) {
                    const int row = row0 + ai * HALF + m * 16;
                    float ss = (sp[ai][m][0] + sp[ai][m][1]) + (sp[ai][m][2] + sp[ai][m][3]);
                    ss += __shfl_xor(ss, 16); ss += __shfl_xor(ss, 32);
                    const float rstd = 1.0f / sqrtf(ss * (1.0f / 1024.0f) + 1e-6f);
                    bf16_t* rowp = ob + (size_t)row * ldob + col0;
#pragma unroll
                    for (int bj = 0; bj < 2; ++bj) {
                        f32x4 v0 = acc[ai][bj][m][0] * rstd, v1 = acc[ai][bj][m][1] * rstd;
                        if constexpr (MODE == E_UP) {
#pragma unroll
                            for (int e = 0; e < 4; ++e) { float a = fmaxf(v0[e], 0.f), b = fmaxf(v1[e], 0.f); v0[e] = a * a; v1[e] = b * b; }
                        }
                        u32x4 w; w.x = cvt_pk_bf16(v0[0], v0[1]); w.y = cvt_pk_bf16(v0[2], v0[3]); w.z = cvt_pk_bf16(v1[0], v1[1]); w.w = cvt_pk_bf16(v1[2], v1[3]);
                        *(u32x4*)(rowp + bj * HALF) = w;
                    }
                }
        } else {
            const int col0 = u.pn * BM + wc * 32 + 4 * fq;
            constexpr int MB = (MODE == E_GATE) ? 1 : 2;
#pragma unroll
            for (int aim = 0; aim < 8 / MB; ++aim) {
                const int ai = aim / (4 / MB), m0 = (aim % (4 / MB)) * MB;
                f32x4 xv[4][2][2]; u32x2 xw[4][2][2]; u32x2 tv[4][2][2]; u32x2 gw[4][2][2];
#pragma unroll
                for (int m = m0; m < m0 + MB; ++m)
#pragma unroll
                    for (int bj = 0; bj < 2; ++bj)
#pragma unroll
                        for (int n = 0; n < 2; ++n) {
                            const int row = row0 + ai * HALF + m * 16, col = col0 + bj * HALF + n * 16; const size_t off = (size_t)row * 1024 + col;
                            if constexpr (MODE == E_RES || MODE == E_GATE) { if (xr) xv[m][bj][n] = *(const f32x4*)(xr + off); else xw[m][bj][n] = *(const u32x2*)(xrb + off); }
                            if constexpr (MODE == E_ATT || MODE == E_GATE) tv[m][bj][n] = *(const u32x2*)(t + off);
                            if constexpr (MODE == E_RET || MODE == E_ATT) gw[m][bj][n] = *(const u32x2*)(gate + (size_t)row * 9728 + col);
                        }
#pragma unroll
                for (int m = m0; m < m0 + MB; ++m) {
                    const int row = row0 + ai * HALF + m * 16;
                    float ssq = 0.f;
#pragma unroll
                    for (int bj = 0; bj < 2; ++bj)
#pragma unroll
                        for (int n = 0; n < 2; ++n) {
                            const int col = col0 + bj * HALF + n * 16; const size_t off = (size_t)row * 1024 + col;
                            const f32x4 a = acc[ai][bj][m][n];
                            if constexpr (MODE == E_RET || MODE == E_ATT) {
                                const u32x2 g2 = gw[m][bj][n];
                                f32x4 gv; gv[0] = sigmoidf_(bf2f(g2.x & 0xffffu)); gv[1] = sigmoidf_(bf2f(g2.x >> 16)); gv[2] = sigmoidf_(bf2f(g2.y & 0xffffu)); gv[3] = sigmoidf_(bf2f(g2.y >> 16));
                                if constexpr (MODE == E_RET) { *(u32x2*)(t + off) = f32_to_bf4(gv * a); }
                                else { const f32x4 o = bf4_to_f32(tv[m][bj][n]) + gv * a; u32x2 w; w.x = cvt_pk_bf16(o[0], o[1]); w.y = cvt_pk_bf16(o[2], o[3]); *(u32x2*)(ob + off) = w; }
                            } else if constexpr (MODE == E_PLE) {
                                *(u32x2*)(t + off) = f32_to_bf4(a);
                            } else {
                                f32x4 x = xr ? xv[m][bj][n] : bf4_to_f32(xw[m][bj][n]);
                                if constexpr (MODE == E_GATE) { f32x4 sg; sg[0] = sigmoidf_(a[0]); sg[1] = sigmoidf_(a[1]); sg[2] = sigmoidf_(a[2]); sg[3] = sigmoidf_(a[3]); x = x + bf4_to_f32(tv[m][bj][n]) * sg; }
                                else x = x + a;
                                u32x2 w; w.x = cvt_pk_bf16(x[0], x[1]); w.y = cvt_pk_bf16(x[2], x[3]); *(u32x2*)(ob + off) = w;
                                ssq += (x[0] * x[0] + x[1] * x[1]) + (x[2] * x[2] + x[3] * x[3]);
                            }
                        }
                    if constexpr (MODE == E_RES || MODE == E_GATE) {
                        ssq += __shfl_xor(ssq, 16); ssq += __shfl_xor(ssq, 32);
                        if (fq == 0) ssp_out[(size_t)row * 16 + u.pn * 4 + wc] = ssq;
                    }
                }
            }
        }
    }
};
template <class Epi, class Sched, bool ALIGN_EPI = false, bool SP2 = false>
__device__ __forceinline__ void gemm_phase(PG8_LAS unsigned char* lds, const Gemm g, const Sched& S, const Epi& E) {
    int tid_ = threadIdx.x; asm volatile("" : "+v"(tid_));
    const int tid = tid_, wid = __builtin_amdgcn_readfirstlane(tid >> 6), lane = tid & 63, wr = wid >> 2, wc = wid & 3, fr = lane & 15, fq = lane >> 4;
    const int K = g.K, nt = K / BK;
    unsigned voffA[2], voffB[2];
#pragma unroll
    for (int i = 0; i < 2; ++i) { int R, C; stage_rc(tid * 16 + i * 8192, R, C); const int Rb = Epi::PERM ? ((R & ~31) + perm32(R & 31)) : R;
        voffA[i] = (unsigned)(R * K + C) * 2u; voffB[i] = (unsigned)(Rb * K + C) * 2u; }
    const size_t kstep = (size_t)(BK * 2);
    const size_t hstep = (size_t)HALF * K * 2;
    const size_t tstep = 2 * hstep;
    const unsigned ldsw = (unsigned)wid * 1024u;
    const int aoff = lds_byte(wr * 64 + fr, fq * 8), boff = lds_byte(wc * 32 + fr, fq * 8);
#define PG8_SA(b, h) (((b) * 2 + (h)) * HTB)
#define PG8_SB(b, h) ((4 + (b) * 2 + (h)) * HTB)
#define PG8_STAGE(bufoff, gbase, voff) do { _Pragma("unroll") for (int _i = 0; _i < 2; ++_i) \
        __builtin_amdgcn_global_load_lds((const unsigned*)((const char*)(gbase) + (voff)[_i]), (PG8_LAS unsigned*)(lds + (bufoff) + ldsw + _i * 8192), 16, 0, 0); } while (0)
#define PG8_LDA(dst, b, h) do { _Pragma("unroll") for (int m = 0; m < 4; ++m) _Pragma("unroll") for (int k = 0; k < 2; ++k) dst[m][k] = *(const PG8_LAS bf16x8*)(lds + PG8_SA(b, h) + aoff + m * 2048 + k * 1024); } while (0)
#define PG8_LDB(dst, b, h) do { _Pragma("unroll") for (int n = 0; n < 2; ++n) _Pragma("unroll") for (int k = 0; k < 2; ++k) dst[n][k] = *(const PG8_LAS bf16x8*)(lds + PG8_SB(b, h) + boff + n * 2048 + k * 1024); } while (0)
#define PG8_MMA(ai, bj, At, Bt) do { __builtin_amdgcn_s_setprio(1); _Pragma("unroll") for (int m = 0; m < 4; ++m) _Pragma("unroll") for (int n = 0; n < 2; ++n) _Pragma("unroll") for (int k = 0; k < 2; ++k) \
        acc[ai][bj][m][n] = __builtin_amdgcn_mfma_f32_16x16x32_bf16(Bt[n][k], At[m][k], acc[ai][bj][m][n], 0, 0, 0); __builtin_amdgcn_s_setprio(0); } while (0)
#define PG8_WAIT_V(n) asm volatile("s_waitcnt vmcnt(" #n ")" ::: "memory")
#define PG8_WAIT_L(n) asm volatile("s_waitcnt lgkmcnt(" #n ")" ::: "memory")
#define PG8_BAR __builtin_amdgcn_s_barrier()
#define PG8_SCHED __builtin_amdgcn_sched_barrier(0)
    Unit cur, nxt; int ui = 0;
    if (!S.next(0, cur)) return;
    f32x4 acc[2][2][4][2];
#pragma unroll
    for (int a = 0; a < 2; ++a)
#pragma unroll
        for (int b = 0; b < 2; ++b)
#pragma unroll
            for (int m = 0; m < 4; ++m)
#pragma unroll
                for (int n = 0; n < 2; ++n) acc[a][b][m][n] = (f32x4){0.f, 0.f, 0.f, 0.f};
    bf16x8 At[4][2], B0[2][2], B1[2][2];
    const char* cA = (const char*)g.A + (size_t)cur.pm * tstep; const char* cB = (const char*)g.Bt + (size_t)cur.pn * tstep;
    S.a_ready(cur);
    if constexpr (SP2) {
        PG8_STAGE(PG8_SB(0, 0), cB, voffB); PG8_STAGE(PG8_SB(0, 1), cB + hstep, voffB); PG8_STAGE(PG8_SA(0, 0), cA, voffA); PG8_STAGE(PG8_SA(0, 1), cA + hstep, voffA);
        if (wr == 1) PG8_BAR;
        PG8_WAIT_V(2); PG8_BAR;
        PG8_STAGE(PG8_SB(1, 0), cB + kstep, voffB); PG8_STAGE(PG8_SA(1, 0), cA + kstep, voffA); PG8_STAGE(PG8_SB(1, 1), cB + hstep + kstep, voffB);
        PG8_WAIT_V(6); PG8_BAR;
    } else {
        PG8_STAGE(PG8_SB(0, 0), cB, voffB); PG8_STAGE(PG8_SA(0, 0), cA, voffA); PG8_STAGE(PG8_SB(0, 1), cB + hstep, voffB); PG8_STAGE(PG8_SA(0, 1), cA + hstep, voffA);
        if (wr == 1) PG8_BAR;
        PG8_WAIT_V(4); PG8_BAR;
        PG8_STAGE(PG8_SB(1, 0), cB + kstep, voffB); PG8_STAGE(PG8_SA(1, 0), cA + kstep, voffA); PG8_STAGE(PG8_SB(1, 1), cB + hstep + kstep, voffB);
        PG8_WAIT_V(6); PG8_BAR;
    }
    for (;;) {
        const bool has_next = S.next(ui + 1, nxt);
        const char* nA = has_next ? (const char*)g.A + (size_t)nxt.pm * tstep : cA; const char* nB = has_next ? (const char*)g.Bt + (size_t)nxt.pn * tstep : cB;
        for (int t = 0; t < nt; t += 2) {
            const bool last = (t == nt - 2);
            const char* a1 = cA + (size_t)(t + 1) * kstep;
            const char* a2 = last ? nA : cA + (size_t)(t + 2) * kstep; const char* b2 = last ? nB : cB + (size_t)(t + 2) * kstep;
            const char* a3 = a2 + kstep; const char* b3 = b2 + kstep;
            if (last && has_next) S.a_ready(nxt);
            if constexpr (SP2) {
            PG8_LDB(B0, 0, 0); PG8_LDB(B1, 0, 1); PG8_SCHED; PG8_LDA(At, 0, 0); PG8_STAGE(PG8_SA(1, 1), a1 + hstep, voffA);
            PG8_WAIT_V(8); PG8_WAIT_L(0); PG8_BAR; PG8_MMA(0, 0, At, B0); PG8_MMA(0, 1, At, B1); PG8_BAR; PG8_SCHED;
            PG8_LDA(At, 0, 1); PG8_STAGE(PG8_SB(0, 0), b2, voffB); PG8_STAGE(PG8_SB(0, 1), b2 + hstep, voffB); PG8_STAGE(PG8_SA(0, 0), a2, voffA);
            PG8_WAIT_V(8); PG8_WAIT_L(0); PG8_BAR; PG8_MMA(1, 0, At, B0); PG8_MMA(1, 1, At, B1); PG8_BAR; PG8_SCHED;
            PG8_LDB(B0, 1, 0); PG8_LDB(B1, 1, 1); PG8_SCHED; PG8_LDA(At, 1, 0); PG8_STAGE(PG8_SA(0, 1), a2 + hstep, voffA);
            PG8_WAIT_V(8); PG8_WAIT_L(0); PG8_BAR; PG8_MMA(0, 0, At, B0); PG8_MMA(0, 1, At, B1); PG8_BAR; PG8_SCHED;
            PG8_LDA(At, 1, 1); PG8_STAGE(PG8_SB(1, 0), b3, voffB); PG8_STAGE(PG8_SB(1, 1), b3 + hstep, voffB); PG8_STAGE(PG8_SA(1, 0), a3, voffA);
            PG8_WAIT_V(8); PG8_WAIT_L(0); PG8_BAR; PG8_MMA(1, 0, At, B0); PG8_MMA(1, 1, At, B1); PG8_BAR; PG8_SCHED;
            } else {
            PG8_LDB(B0, 0, 0); PG8_SCHED; PG8_LDA(At, 0, 0); PG8_STAGE(PG8_SA(1, 1), a1 + hstep, voffA);
            PG8_WAIT_L(8); PG8_BAR; PG8_WAIT_L(0); PG8_MMA(0, 0, At, B0); PG8_BAR; PG8_SCHED;
            PG8_LDB(B1, 0, 1); PG8_STAGE(PG8_SB(0, 0), b2, voffB);
            PG8_BAR; PG8_WAIT_L(0); PG8_MMA(0, 1, At, B1); PG8_BAR;
            PG8_LDA(At, 0, 1); PG8_STAGE(PG8_SA(0, 0), a2, voffA);
            PG8_BAR; PG8_WAIT_L(0); PG8_MMA(1, 0, At, B0); PG8_BAR; PG8_SCHED;
            PG8_STAGE(PG8_SB(0, 1), b2 + hstep, voffB);
            PG8_WAIT_V(6); PG8_BAR; PG8_MMA(1, 1, At, B1); PG8_BAR;
            PG8_LDB(B0, 1, 0); PG8_SCHED; PG8_LDA(At, 1, 0); PG8_STAGE(PG8_SA(0, 1), a2 + hstep, voffA);
            PG8_WAIT_L(8); PG8_BAR; PG8_WAIT_L(0); PG8_MMA(0, 0, At, B0); PG8_BAR; PG8_SCHED;
            PG8_LDB(B1, 1, 1); PG8_STAGE(PG8_SB(1, 0), b3, voffB);
            PG8_BAR; PG8_WAIT_L(0); PG8_MMA(0, 1, At, B1); PG8_BAR;
            PG8_LDA(At, 1, 1); PG8_STAGE(PG8_SA(1, 0), a3, voffA);
            PG8_BAR; PG8_WAIT_L(0); PG8_MMA(1, 0, At, B0); PG8_BAR; PG8_SCHED;
            PG8_STAGE(PG8_SB(1, 1), b3 + hstep, voffB);
            PG8_WAIT_V(6); PG8_BAR; PG8_MMA(1, 1, At, B1); PG8_BAR;
            }
        }
        if constexpr (ALIGN_EPI) { if (wr == 0) PG8_BAR; }
        if constexpr (!Epi::AFTER_DRAIN) { E(acc, cur, wr, wc, fr, fq); S.done(cur); }
        if (!has_next) break;
#pragma unroll
        for (int a = 0; a < 2; ++a)
#pragma unroll
            for (int b = 0; b < 2; ++b)
#pragma unroll
                for (int m = 0; m < 4; ++m)
#pragma unroll
                    for (int n = 0; n < 2; ++n) acc[a][b][m][n] = (f32x4){0.f, 0.f, 0.f, 0.f};
        cur = nxt; cA = nA; cB = nB; ++ui;
        if constexpr (ALIGN_EPI) { if (wr == 1) PG8_BAR; }
    }
    PG8_WAIT_V(0);
    if constexpr (!ALIGN_EPI) { if (wr == 0) PG8_BAR; }
    PG8_BAR;
    if constexpr (Epi::AFTER_DRAIN) { E.fused(acc, cur, wr, wc, fr, fq, lds, wid, lane); S.done(cur); }
#undef PG8_SA
#undef PG8_SB
#undef PG8_STAGE
#undef PG8_LDA
#undef PG8_LDB
#undef PG8_MMA
#undef PG8_WAIT_V
#undef PG8_WAIT_L
#undef PG8_BAR
#undef PG8_SCHED
}
}

#define LAS __attribute__((address_space(3)))
typedef unsigned short bf16_t;
typedef short bf16x8 __attribute__((ext_vector_type(8)));
typedef short v4i16_t __attribute__((ext_vector_type(4)));
typedef float f32x4 __attribute__((ext_vector_type(4)));
typedef float f32x2 __attribute__((ext_vector_type(2)));
typedef unsigned u32x4 __attribute__((ext_vector_type(4)));
typedef unsigned u32x2 __attribute__((ext_vector_type(2)));

constexpr int MP = 16384, MS = 256, MT = MP + MS;
constexpr int DM = 1024, DIN = 9728, DFF = 4096, DPLE = 256, SEQ = 8192;
constexpr int Z_RQ = 0, Z_RK = 512, Z_RV = 1024, Z_RG = 2048, Z_AQ = 3072, Z_AK = 4608, Z_AV = 6144, Z_GA = 7680, Z_GB = 8704;
constexpr int LDS_BYTES = 147456;
constexpr float QK_SCALE = 0.08838834764831845f;

constexpr size_t WT_IN = 0, WT_RET = WT_IN + (size_t)DIN * DM * 2, WT_ATT = WT_RET + (size_t)DM * DM * 2, WT_OUT = WT_ATT + (size_t)DM * 512 * 2,
                 WT_UP = WT_OUT + (size_t)DM * DM * 2, WT_DOWN = WT_UP + (size_t)DFF * DM * 2, WT_PLE = WT_DOWN + (size_t)DFF * DM * 2,
                 WT_GATE = WT_PLE + (size_t)DM * DPLE * 2, WT_LAYER = WT_GATE + (size_t)DM * DM * 2;
constexpr size_t WS_WT = 0;
constexpr size_t WS_XF = WS_WT + 2 * WT_LAYER;
constexpr size_t WS_XBA = WS_XF + (size_t)MT * DM * 4;
constexpr size_t WS_XBB = WS_XBA + (size_t)MT * DM * 2;
constexpr size_t WS_SSP = WS_XBB + (size_t)MT * DM * 2;
constexpr size_t WS_PB = WS_SSP + (size_t)MT * 16 * 4;
constexpr size_t WS_Z = WS_PB + (size_t)2 * MT * DPLE * 2;
constexpr size_t WS_ORET = WS_Z + (size_t)MT * DIN * 2;
constexpr size_t WS_OATT = WS_ORET + (size_t)MT * DM * 2;
constexpr size_t WS_MERGED = WS_OATT + (size_t)MT * 512 * 2;
constexpr size_t WS_T = WS_MERGED + (size_t)MT * DM * 2;
constexpr size_t WS_OG = WS_T + (size_t)MT * DM * 4;
constexpr size_t WS_LSE = WS_OG + (size_t)3 * MT * 512 * 4;
constexpr size_t WS_U = WS_LSE + (size_t)3 * MT * 4 * 4;
constexpr size_t WS_RP = WS_U + (size_t)512 * 32768 * 4;
constexpr size_t WS_CTL = WS_RP + (size_t)512 * 32768 * 2;
constexpr size_t WS_END = WS_CTL + 16384;

constexpr size_t O_Y = 0;
constexpr size_t O_PWK0 = (size_t)MT * DM, O_PWV0 = O_PWK0 + 262144, O_PWK1 = O_PWV0 + 262144, O_PWV1 = O_PWK1 + 1048576, O_PWK2 = O_PWV1 + 1048576, O_PWV2 = O_PWK2 + 4194304;
constexpr size_t O_PRET = O_PWV2 + 4194304;
constexpr size_t O_SWK0 = O_PRET + 524288, O_SWV0 = O_SWK0 + 4194304, O_SWK1 = O_SWV0 + 4194304, O_SWV1 = O_SWK1 + 16777216, O_SWK2 = O_SWV1 + 16777216, O_SWV2 = O_SWK2 + 67108864;
constexpr size_t O_SRET = O_SWV2 + 67108864;
constexpr size_t O_END = O_SRET + 8388608;

struct Args { const float* in[22]; float* out; unsigned char* ws; };

__device__ __forceinline__ unsigned f2bf(float f) { unsigned u = __builtin_bit_cast(unsigned, f); return (u + 0x7fffu + ((u >> 16) & 1u)) >> 16; }
__device__ __forceinline__ unsigned pk2(float lo, float hi) { return f2bf(lo) | (f2bf(hi) << 16); }
__device__ __forceinline__ float bflo(unsigned w) { return __uint_as_float(w << 16); }
__device__ __forceinline__ float bfhi(unsigned w) { return __uint_as_float(w & 0xffff0000u); }
__device__ __forceinline__ float wave_sum(float v) {
#pragma unroll
    for (int o = 1; o < 64; o <<= 1) v += __shfl_xor(v, o);
    return v;
}
__device__ __forceinline__ float ret_lg(int h) { const float A = -3.4657359028f, B = -6.2383246250f; return log1pf(-expf(A + (B - A) * (float)h * (1.0f / 3.0f))); }
__device__ __forceinline__ v4i16_t tr4(LAS const unsigned char* p) { return __builtin_amdgcn_ds_read_tr16_b64_v4i16((LAS v4i16_t*)p); }
__device__ __forceinline__ bf16x8 cat8(v4i16_t a, v4i16_t b) { return __builtin_shufflevector(a, b, 0, 1, 2, 3, 4, 5, 6, 7); }
#define MFMA16(a, b, c) __builtin_amdgcn_mfma_f32_16x16x32_bf16((a), (b), (c), 0, 0, 0)

__device__ __forceinline__ void p0_transpose_item(const float* __restrict__ W, int K, int N, bf16_t* __restrict__ WT, const float* __restrict__ gain, bool is_in, LAS float* scr, int item, int lane) {
    const int nblk = N / 64, kb = item / nblk, nb = item % nblk, k0 = 64 * kb, n0 = 64 * nb;
    const int kr = lane >> 4, nc = 4 * (lane & 15);
#pragma unroll 8
    for (int i = 0; i < 16; ++i) { const int kk = 4 * i + kr; f32x4 v = __builtin_nontemporal_load((const f32x4*)(W + (size_t)(k0 + kk) * N + n0 + nc)); if (gain) v = v * gain[k0 + kk];
        LAS float* d = scr + kk * 65 + nc; d[0] = v[0]; d[1] = v[1]; d[2] = v[2]; d[3] = v[3]; }
    asm volatile("s_waitcnt lgkmcnt(0)" ::: "memory");
    const int c = lane & 7;
#pragma unroll
    for (int j = 0; j < 8; ++j) { const int n = (lane >> 3) + 8 * j; const LAS float* s = scr + (8 * c) * 65 + n; const int ng = n0 + n;
        const float sc = (is_in && ((ng >= Z_RK && ng < Z_RV) || (ng >= Z_AQ && ng < Z_AK))) ? QK_SCALE : 1.0f;
        u32x4 o; o.x = pk2(s[0 * 65] * sc, s[1 * 65] * sc); o.y = pk2(s[2 * 65] * sc, s[3 * 65] * sc); o.z = pk2(s[4 * 65] * sc, s[5 * 65] * sc); o.w = pk2(s[6 * 65] * sc, s[7 * 65] * sc);
        *(u32x4*)(WT + (size_t)ng * K + k0 + 8 * c) = o; }
    asm volatile("s_waitcnt lgkmcnt(0)" ::: "memory");
}

__device__ __forceinline__ void p0_prologue(const Args& a, LAS unsigned char* lds, int tid) {
    const int lane = tid & 63, wave = tid >> 6;
    const int gw = blockIdx.x * 8 + wave, NGW = gridDim.x * 8;
    LAS float* scr = (LAS float*)(lds + wave * 16640);
    constexpr int I_IN = 16 * 152, I_RET = 16 * 16, I_ATT = 8 * 16, I_OUT = 16 * 16, I_UP = 16 * 64, I_DOWN = 64 * 16, I_PLE = 4 * 16, I_GATE = 16 * 16;
    constexpr int I_LAYER = I_IN + I_RET + I_ATT + I_OUT + I_UP + I_DOWN + I_PLE + I_GATE;
    for (int it = gw; it < 2 * I_LAYER; it += NGW) {
        const int l = it / I_LAYER; int r = it % I_LAYER;
        unsigned char* wl = a.ws + WS_WT + (size_t)l * WT_LAYER;
        if (r < I_IN) { p0_transpose_item(a.in[12] + (size_t)l * DM * DIN, DM, DIN, (bf16_t*)(wl + WT_IN), a.in[11] + l * DM, true, scr, r, lane); continue; } r -= I_IN;
        if (r < I_RET) { p0_transpose_item(a.in[13] + (size_t)l * DM * DM, DM, DM, (bf16_t*)(wl + WT_RET), nullptr, false, scr, r, lane); continue; } r -= I_RET;
        if (r < I_ATT) { p0_transpose_item(a.in[14] + (size_t)l * 512 * DM, 512, DM, (bf16_t*)(wl + WT_ATT), nullptr, false, scr, r, lane); continue; } r -= I_ATT;
        if (r < I_OUT) { p0_transpose_item(a.in[15] + (size_t)l * DM * DM, DM, DM, (bf16_t*)(wl + WT_OUT), nullptr, false, scr, r, lane); continue; } r -= I_OUT;
        if (r < I_UP) { p0_transpose_item(a.in[17] + (size_t)l * DM * DFF, DM, DFF, (bf16_t*)(wl + WT_UP), a.in[16] + l * DM, false, scr, r, lane); continue; } r -= I_UP;
        if (r < I_DOWN) { p0_transpose_item(a.in[18] + (size_t)l * DFF * DM, DFF, DM, (bf16_t*)(wl + WT_DOWN), nullptr, false, scr, r, lane); continue; } r -= I_DOWN;
        if (r < I_PLE) { p0_transpose_item(a.in[19] + (size_t)l * DPLE * DM, DPLE, DM, (bf16_t*)(wl + WT_PLE), nullptr, false, scr, r, lane); continue; } r -= I_PLE;
        p0_transpose_item(a.in[20] + (size_t)l * DM * DM, DM, DM, (bf16_t*)(wl + WT_GATE), nullptr, false, scr, r, lane);
    }
    bf16_t* xb = (bf16_t*)(a.ws + WS_XBA); float* ssp = (float*)(a.ws + WS_SSP);
    for (int m = gw; m < MT; m += NGW) {
        const float* src = (m < MP) ? a.in[0] + (size_t)m * DM : a.in[1] + (size_t)(m - MP) * DM;
        f32x4 v[4]; float s = 0.f;
#pragma unroll
        for (int j = 0; j < 4; ++j) { v[j] = __builtin_nontemporal_load((const f32x4*)(src + 4 * lane + 256 * j)); s += (v[j][0] * v[j][0] + v[j][1] * v[j][1]) + (v[j][2] * v[j][2] + v[j][3] * v[j][3]); }
        s = wave_sum(s);
#pragma unroll
        for (int j = 0; j < 4; ++j) { u32x2 w; w.x = pk2(v[j][0], v[j][1]); w.y = pk2(v[j][2], v[j][3]); *(u32x2*)(xb + (size_t)m * DM + 4 * lane + 256 * j) = w; }
        if (lane < 16) ssp[(size_t)m * 16 + lane] = (lane == 0) ? s : 0.f;
    }
    bf16_t* pb = (bf16_t*)(a.ws + WS_PB);
    for (int q = gw; q < 2 * MT; q += NGW) {
        const int l = q / MT, m = q % MT;
        const float* src = (m < MP) ? a.in[9] + ((size_t)l * MP + m) * DPLE : a.in[10] + ((size_t)l * MS + (m - MP)) * DPLE;
        const f32x4 v = __builtin_nontemporal_load((const f32x4*)(src + 4 * lane));
        u32x2 w; w.x = pk2(v[0], v[1]); w.y = pk2(v[2], v[3]); *(u32x2*)(pb + (size_t)q * DPLE + 4 * lane) = w;
    }
}

constexpr size_t CC_TOTAL = 2 * 64 * 128 * (size_t)(120 + 504 + 2040);
__device__ __forceinline__ void cache_copy_range(const Args& a, size_t q0, size_t q1, int tid) {
    size_t base = 0;
#pragma unroll 1
    for (int kvg = 0; kvg < 6; ++kvg) {
        const int g = kvg >> 1, W = 128 << (2 * g);
        const size_t per = (size_t)(W - 8) * 128, n = 64 * per, full = (size_t)W * 128;
        const size_t lo = q0 > base ? q0 : base, hi = q1 < base + n ? q1 : base + n;
        if (lo < hi) {
            const f32x4* src = (const f32x4*)a.in[2 + kvg];
            const size_t ooff = (kvg == 0) ? O_SWK0 : (kvg == 1) ? O_SWV0 : (kvg == 2) ? O_SWK1 : (kvg == 3) ? O_SWV1 : (kvg == 4) ? O_SWK2 : O_SWV2;
            f32x4* dst = (f32x4*)(a.out + ooff);
            size_t p = lo - base; const size_t pe = hi - base;
#pragma unroll 1
            while (p < pe) {
                const size_t lb = p / per, rem = p - lb * per;
                const size_t c0 = per - rem, c1 = pe - p, cnt = c0 < c1 ? c0 : c1;
                const f32x4* s = src + lb * full + 1024 + rem; f32x4* d = dst + lb * full + rem;
#pragma unroll 1
                for (size_t i = tid; i < cnt; i += 512 * 16) {
                    f32x4 v[16];
#pragma unroll
                    for (int k = 0; k < 16; ++k) if (i + k * 512 < cnt) v[k] = __builtin_nontemporal_load(s + i + k * 512);
#pragma unroll
                    for (int k = 0; k < 16; ++k) if (i + k * 512 < cnt) __builtin_nontemporal_store(v[k], d + i + k * 512);
                }
                p += cnt;
            }
        }
        base += n;
    }
}
__device__ __forceinline__ void cache_copy_tail(const Args& a, int nwg, int f0, int f1, int tid) {
    const int G = gridDim.x, fi = nwg % G, c = blockIdx.x;
    if (c < fi) return;
    const size_t R0 = CC_TOTAL * (size_t)f0 / 1000, R1 = CC_TOTAL * (size_t)f1 / 1000, nidle = (size_t)(G - fi), idx = (size_t)(c - fi);
    cache_copy_range(a, R0 + (R1 - R0) * idx / nidle, R0 + (R1 - R0) * (idx + 1) / nidle, tid);
}

constexpr int KVS = 272;
constexpr int AT_VOFF = 256 * KVS;
__device__ __forceinline__ void attn_prompt_item(LAS unsigned char* lds, const bf16_t* __restrict__ z, bf16_t* __restrict__ og, float* __restrict__ lse, int item, int tid) {
    const int wid = __builtin_amdgcn_readfirstlane(tid >> 6), lane = tid & 63, fr = lane & 15, quad = lane >> 4;
    const int blk = item & 63; int rest = item >> 6; const int j = rest & 3; rest >>= 2; const int g = rest % 3, b = rest / 3;
    const int dsh = 2 * g, dil = 1 << dsh, r = blk >> (6 - dsh), qb = blk & ((64 >> dsh) - 1), hh = g * 4 + j;
    const float slope_d = exp2f(-8.0f * (float)(hh + 1) / 12.0f) * (float)dil;
    const bf16_t* zb = z + (size_t)b * SEQ * DIN;
#pragma unroll
    for (int it = 0; it < 8; ++it) {
        const int idx = tid + it * 512, kk = idx >> 4, ch = idx & 15, sp = 128 * qb - 128 + kk;
        u32x4 kv = {0u, 0u, 0u, 0u}, vv = {0u, 0u, 0u, 0u};
        if (sp >= 0) { const bf16_t* zr = zb + (size_t)(sp * dil + r) * DIN + hh * 128 + ch * 8; kv = *(const u32x4*)(zr + Z_AK); vv = *(const u32x4*)(zr + Z_AV); }
        *(LAS u32x4*)(lds + kk * KVS + ch * 16) = kv; *(LAS u32x4*)(lds + AT_VOFF + kk * KVS + ch * 16) = vv;
    }
    const int sq = 128 * qb + 16 * wid + fr;
    const size_t qrow = (size_t)b * SEQ + (size_t)(sq * dil + r);
    bf16x8 qf[4];
#pragma unroll
    for (int ks = 0; ks < 4; ++ks) qf[ks] = *(const bf16x8*)(z + qrow * DIN + Z_AQ + hh * 128 + ks * 32 + quad * 8);
    __syncthreads();
    f32x4 sc[9];
#pragma unroll
    for (int kt = 0; kt < 9; ++kt) {
        f32x4 acc = {0.f, 0.f, 0.f, 0.f};
#pragma unroll
        for (int ks = 0; ks < 4; ++ks) { const bf16x8 ka = *(LAS const bf16x8*)(lds + (16 * (wid + kt) + fr) * KVS + ks * 64 + quad * 16); acc = MFMA16(ka, qf[ks], acc); }
        sc[kt] = acc;
    }
    float mx = -INFINITY;
#pragma unroll
    for (int kt = 0; kt < 9; ++kt)
#pragma unroll
        for (int e = 0; e < 4; ++e) {
            const int dist = 128 - 16 * kt + fr - 4 * quad - e, keyrel = 16 * (wid + kt) + 4 * quad + e;
            const bool valid = (dist >= 0) && (dist <= 128) && (qb > 0 || keyrel >= 128);
            const float s = valid ? sc[kt][e] - slope_d * (float)dist : -INFINITY;
            sc[kt][e] = s; mx = fmaxf(mx, s);
        }
    mx = fmaxf(mx, __shfl_xor(mx, 16)); mx = fmaxf(mx, __shfl_xor(mx, 32));
    float den = 0.f;
#pragma unroll
    for (int kt = 0; kt < 9; ++kt)
#pragma unroll
        for (int e = 0; e < 4; ++e) { const float p = __expf(sc[kt][e] - mx); sc[kt][e] = p; den += p; }
    den += __shfl_xor(den, 16); den += __shfl_xor(den, 32);
    const float inv = 1.0f / den;
    f32x4 o[8];
#pragma unroll
    for (int dt = 0; dt < 8; ++dt) o[dt] = (f32x4){0.f, 0.f, 0.f, 0.f};
#pragma unroll
    for (int kp = 0; kp < 5; ++kp) {
        const int TA = wid + 2 * kp, TB = (2 * kp + 1 < 9) ? TA + 1 : TA;
        u32x4 pw; pw.x = pk2(sc[2 * kp][0] * inv, sc[2 * kp][1] * inv); pw.y = pk2(sc[2 * kp][2] * inv, sc[2 * kp][3] * inv);
        if (2 * kp + 1 < 9) { pw.z = pk2(sc[(2 * kp + 1) % 9][0] * inv, sc[(2 * kp + 1) % 9][1] * inv); pw.w = pk2(sc[(2 * kp + 1) % 9][2] * inv, sc[(2 * kp + 1) % 9][3] * inv); } else { pw.z = 0u; pw.w = 0u; }
        const bf16x8 p8 = __builtin_bit_cast(bf16x8, pw);
        LAS const unsigned char* bA = lds + AT_VOFF + (16 * TA + 4 * quad + (fr >> 2)) * KVS + (fr & 3) * 8;
        LAS const unsigned char* bB = lds + AT_VOFF + (16 * TB + 4 * quad + (fr >> 2)) * KVS + (fr & 3) * 8;
#pragma unroll
        for (int dt = 0; dt < 8; ++dt) { const v4i16_t va = tr4(bA + dt * 32), vb = tr4(bB + dt * 32); o[dt] = MFMA16(cat8(va, vb), p8, o[dt]); }
    }
    bf16_t* orow = og + ((size_t)g * MT + qrow) * 512 + j * 128 + 4 * quad;
#pragma unroll
    for (int dt = 0; dt < 8; ++dt) { u32x2 w; w.x = pk2(o[dt][0], o[dt][1]); w.y = pk2(o[dt][2], o[dt][3]); *(u32x2*)(orow + 16 * dt) = w; }
    if (quad == 0) lse[((size_t)g * MT + qrow) * 4 + j] = mx + __logf(den);
    __syncthreads();
}

constexpr int RVS = 528;
constexpr int RU_VOFF = 128 * KVS;
__device__ __forceinline__ void ret_u_item(LAS unsigned char* lds, const bf16_t* __restrict__ z, bf16_t* __restrict__ U, int item, int tid) {
    const int wid = __builtin_amdgcn_readfirstlane(tid >> 6), lane = tid & 63, fr = lane & 15, quad = lane >> 4;
    const int c = item & 63, bh = item >> 6, h = bh & 3, b = bh >> 2;
    const float lg = ret_lg(h);
    const bf16_t* z0 = z + ((size_t)b * SEQ + 128 * c) * DIN;
#pragma unroll
    for (int it = 0; it < 4; ++it) {
        const int idx = tid + it * 512, jj = idx >> 4, ch = idx & 15;
        const u32x4 kv = *(const u32x4*)(z0 + (size_t)jj * DIN + Z_RK + h * 128 + ch * 8);
        const float zeta = __expf(lg * (float)(127 - jj));
        u32x4 o; o.x = pk2(bflo(kv.x) * zeta, bfhi(kv.x) * zeta); o.y = pk2(bflo(kv.y) * zeta, bfhi(kv.y) * zeta); o.z = pk2(bflo(kv.z) * zeta, bfhi(kv.z) * zeta); o.w = pk2(bflo(kv.w) * zeta, bfhi(kv.w) * zeta);
        *(LAS u32x4*)(lds + jj * KVS + ch * 16) = o;
    }
#pragma unroll
    for (int it = 0; it < 8; ++it) {
        const int idx = tid + it * 512, jj = idx >> 5, ch = idx & 31;
        *(LAS u32x4*)(lds + RU_VOFF + jj * RVS + ch * 16) = *(const u32x4*)(z0 + (size_t)jj * DIN + Z_RV + h * 256 + ch * 8);
    }
    __syncthreads();
    f32x4 acc[2][8];
#pragma unroll
    for (int a = 0; a < 2; ++a)
#pragma unroll
        for (int d = 0; d < 8; ++d) acc[a][d] = (f32x4){0.f, 0.f, 0.f, 0.f};
#pragma unroll
    for (int ks = 0; ks < 4; ++ks) {
        const int jrow = 32 * ks + 8 * quad + (fr >> 2);
        bf16x8 A[2];
#pragma unroll
        for (int a = 0; a < 2; ++a) { LAS const unsigned char* p = lds + RU_VOFF + jrow * RVS + (16 * (2 * wid + a) + 4 * (fr & 3)) * 2; A[a] = cat8(tr4(p), tr4(p + 4 * RVS)); }
#pragma unroll
        for (int d = 0; d < 8; ++d) { LAS const unsigned char* p = lds + jrow * KVS + (16 * d + 4 * (fr & 3)) * 2; const bf16x8 B = cat8(tr4(p), tr4(p + 4 * KVS));
            acc[0][d] = MFMA16(B, A[0], acc[0][d]); acc[1][d] = MFMA16(B, A[1], acc[1][d]); }
    }
    bf16_t* Uo = U + (size_t)item * 32768;
#pragma unroll
    for (int a = 0; a < 2; ++a)
#pragma unroll
        for (int d = 0; d < 8; ++d) { u32x2 w; w.x = pk2(acc[a][d][0], acc[a][d][1]); w.y = pk2(acc[a][d][2], acc[a][d][3]); *(u32x2*)(Uo + (16 * (2 * wid + a) + fr) * 128 + 16 * d + 4 * quad) = w; }
    __syncthreads();
}

__device__ __forceinline__ void ret_sample_item(LAS unsigned char* lds, const bf16_t* __restrict__ z, const float* __restrict__ S0, float* __restrict__ Sout, bf16_t* __restrict__ oret, int item, int tid) {
    const int h = item & 3, b = item >> 2;
    const int lane = tid & 63, wave = tid >> 6;
    const float lg = ret_lg(h);
    LAS float* qs = (LAS float*)lds;
    LAS float* ksm = qs + 1024;
    LAS float* Pm = ksm + 1024;
    LAS float* red = Pm + 64;
    LAS float* ob = red + 4096;
    const bf16_t* z0 = z + (size_t)(MP + b * 8) * DIN;
    for (int idx = tid; idx < 1024; idx += 512) { const int i = idx >> 7, d = idx & 127; qs[idx] = __uint_as_float((unsigned)z0[(size_t)i * DIN + Z_RQ + h * 128 + d] << 16); ksm[idx] = __uint_as_float((unsigned)z0[(size_t)i * DIN + Z_RK + h * 128 + d] << 16); }
    const int v = tid & 255, half = tid >> 8;
    float vv[8], vz[8];
#pragma unroll
    for (int jj = 0; jj < 8; ++jj) { vv[jj] = __uint_as_float((unsigned)z0[(size_t)jj * DIN + Z_RV + h * 256 + v] << 16); vz[jj] = vv[jj] * __expf(lg * (float)(7 - jj)); }
    __syncthreads();
    if (tid < 64) { const int i = tid >> 3, jj = tid & 7; float s = 0.f; for (int d = 0; d < 128; ++d) s += qs[i * 128 + d] * ksm[jj * 128 + d]; Pm[tid] = (jj <= i) ? s * __expf(lg * (float)(i - jj)) : 0.f; }
    const float cd = __expf(lg * 8.0f);
    float cr[8];
#pragma unroll
    for (int i = 0; i < 8; ++i) cr[i] = 0.f;
    const float* Sp = S0 + (size_t)item * 32768 + v; float* So = Sout + (size_t)item * 32768 + v;
#pragma unroll 16
    for (int dd = 0; dd < 64; ++dd) {
        const int d = half * 64 + dd;
        const float s = __builtin_nontemporal_load(Sp + (size_t)d * 256);
        float nw = cd * s;
#pragma unroll
        for (int i = 0; i < 8; ++i) { cr[i] += qs[i * 128 + d] * s; nw += ksm[i * 128 + d] * vz[i]; }
        __builtin_nontemporal_store(nw, So + (size_t)d * 256);
    }
#pragma unroll
    for (int i = 0; i < 8; ++i) red[(half * 8 + i) * 256 + v] = cr[i];
    __syncthreads();
#pragma unroll
    for (int ii = 0; ii < 4; ++ii) {
        const int i = half * 4 + ii;
        float o = (red[i * 256 + v] + red[(8 + i) * 256 + v]) * __expf(lg * (float)(i + 1));
#pragma unroll
        for (int jj = 0; jj < 8; ++jj) o += Pm[i * 8 + jj] * vv[jj];
        ob[i * 256 + v] = o;
    }
    __syncthreads();
    {
        const int i = wave; float x[4]; float s = 0.f;
#pragma unroll
        for (int e = 0; e < 4; ++e) { x[e] = ob[i * 256 + 4 * lane + e]; s += x[e]; }
        const float mu = wave_sum(s) * (1.0f / 256.0f); float q = 0.f;
#pragma unroll
        for (int e = 0; e < 4; ++e) { x[e] -= mu; q += x[e] * x[e]; }
        const float rstd = 1.0f / sqrtf(wave_sum(q) * (1.0f / 256.0f) + 1e-6f);
        const u32x2 gw = *(const u32x2*)(z0 + (size_t)i * DIN + Z_RG + h * 256 + 4 * lane);
        float gq[4] = {bflo(gw.x), bfhi(gw.x), bflo(gw.y), bfhi(gw.y)};
#pragma unroll
        for (int e = 0; e < 4; ++e) x[e] = x[e] * rstd * gq[e] / (1.0f + __expf(-gq[e]));
        u32x2 w; w.x = pk2(x[0], x[1]); w.y = pk2(x[2], x[3]);
        *(u32x2*)(oret + (size_t)(MP + b * 8 + i) * DM + h * 256 + 4 * lane) = w;
    }
    __syncthreads();
}

__device__ __forceinline__ void attn_sample_item(LAS unsigned char* lds, const bf16_t* __restrict__ z, const float* __restrict__ ck, const float* __restrict__ cv, int l, bf16_t* __restrict__ og, float* __restrict__ lse, int item, int tid) {
    const int j = item & 3; int rest = item >> 2; const int g = rest % 3, b = rest / 3;
    const int lane = tid & 63, i = tid >> 6, dsh = 2 * g, dil = 1 << dsh, W = 128 << dsh, hh = g * 4 + j;
    const float slope_d = exp2f(-8.0f * (float)(hh + 1) / 12.0f) * (float)dil;
    LAS float* sc = (LAS float*)lds + i * 136;
    const size_t zrow = (size_t)MP + b * 8 + i;
    const bf16_t* zq = z + zrow * DIN + Z_AQ + hh * 128;
    const int c16 = lane & 15, rr = lane >> 4;
    float q[8];
    { const u32x2 a0 = *(const u32x2*)(zq + 4 * c16), a1 = *(const u32x2*)(zq + 64 + 4 * c16);
      q[0] = bflo(a0.x); q[1] = bfhi(a0.x); q[2] = bflo(a0.y); q[3] = bfhi(a0.y); q[4] = bflo(a1.x); q[5] = bfhi(a1.x); q[6] = bflo(a1.y); q[7] = bfhi(a1.y); }
    const float* ckb = ck + ((size_t)(l * 32 + b) * W) * 512 + j * 128 + 4 * c16;
    const float* cvb = cv + ((size_t)(l * 32 + b) * W) * 512 + j * 128 + 4 * c16;
    const bf16_t* znew = z + (size_t)(MP + b * 8) * DIN + hh * 128 + 4 * c16;
    const size_t rstride = (size_t)dil * 512 * 4;
    const float* kp0 = ckb + (size_t)(i + rr * dil) * 512;
#pragma unroll 1
    for (int bt = 0; bt < 2; ++bt) {
        f32x4 k0[15], k1[15];
#pragma unroll
        for (int t = 0; t < 15; ++t) { const float* p = kp0 + (size_t)(bt * 15 + t) * rstride; k0[t] = __builtin_nontemporal_load((const f32x4*)p); k1[t] = __builtin_nontemporal_load((const f32x4*)(p + 64)); }
#pragma unroll
        for (int t = 0; t < 15; ++t) {
            float s = (q[0] * k0[t][0] + q[1] * k0[t][1]) + (q[2] * k0[t][2] + q[3] * k0[t][3]) + (q[4] * k1[t][0] + q[5] * k1[t][1]) + (q[6] * k1[t][2] + q[7] * k1[t][3]);
            s += __shfl_xor(s, 1); s += __shfl_xor(s, 2); s += __shfl_xor(s, 4); s += __shfl_xor(s, 8);
            const int u = 4 * (bt * 15 + t) + rr;
            if (c16 == 0) sc[u] = s - slope_d * (float)(128 - u);
        }
    }
#pragma unroll
    for (int it = 30; it < 33; ++it) {
        const int u = 4 * it + rr; float s = 0.f;
        if (u <= 128) {
            const int index = i + u * dil;
            float k[8];
            if (index < W) { const f32x4 a0 = *(const f32x4*)(ckb + (size_t)index * 512), a1 = *(const f32x4*)(ckb + (size_t)index * 512 + 64);
                k[0] = a0[0]; k[1] = a0[1]; k[2] = a0[2]; k[3] = a0[3]; k[4] = a1[0]; k[5] = a1[1]; k[6] = a1[2]; k[7] = a1[3]; }
            else { const bf16_t* zk = znew + (size_t)(index - W) * DIN + Z_AK; const u32x2 a0 = *(const u32x2*)zk, a1 = *(const u32x2*)(zk + 64);
                k[0] = bflo(a0.x); k[1] = bfhi(a0.x); k[2] = bflo(a0.y); k[3] = bfhi(a0.y); k[4] = bflo(a1.x); k[5] = bfhi(a1.x); k[6] = bflo(a1.y); k[7] = bfhi(a1.y); }
#pragma unroll
            for (int e = 0; e < 8; ++e) s += q[e] * k[e];
        }
        s += __shfl_xor(s, 1); s += __shfl_xor(s, 2); s += __shfl_xor(s, 4); s += __shfl_xor(s, 8);
        if (c16 == 0 && u <= 128) sc[u] = s - slope_d * (float)(128 - u);
    }
    asm volatile("s_waitcnt lgkmcnt(0)" ::: "memory");
    __syncthreads();
    float s0 = sc[lane], s1 = sc[lane + 64], s2 = (lane == 0) ? sc[128] : -INFINITY;
    float mx = fmaxf(fmaxf(s0, s1), s2);
#pragma unroll
    for (int o = 1; o < 64; o <<= 1) mx = fmaxf(mx, __shfl_xor(mx, o));
    s0 = __expf(s0 - mx); s1 = __expf(s1 - mx); s2 = __expf(s2 - mx);
    const float den = wave_sum(s0 + s1 + s2), inv = 1.0f / den;
    __syncthreads();
    sc[lane] = s0 * inv; sc[lane + 64] = s1 * inv; if (lane == 0) sc[128] = s2 * inv;
    if (lane >= 1 && lane < 4) sc[128 + lane] = 0.f;
    asm volatile("s_waitcnt lgkmcnt(0)" ::: "memory");
    __syncthreads();
    float o[8];
#pragma unroll
    for (int e = 0; e < 8; ++e) o[e] = 0.f;
    const float* vp0 = cvb + (size_t)(i + rr * dil) * 512;
#pragma unroll 1
    for (int bt = 0; bt < 2; ++bt) {
        f32x4 v0[15], v1[15];
#pragma unroll
        for (int t = 0; t < 15; ++t) { const float* p = vp0 + (size_t)(bt * 15 + t) * rstride; v0[t] = __builtin_nontemporal_load((const f32x4*)p); v1[t] = __builtin_nontemporal_load((const f32x4*)(p + 64)); }
#pragma unroll
        for (int t = 0; t < 15; ++t) { const float p = sc[4 * (bt * 15 + t) + rr];
#pragma unroll
            for (int e = 0; e < 4; ++e) { o[e] += p * v0[t][e]; o[4 + e] += p * v1[t][e]; } }
    }
#pragma unroll
    for (int it = 30; it < 33; ++it) {
        const int u = 4 * it + rr;
        if (u <= 128) {
            const int index = i + u * dil; const float p = sc[u];
            float v[8];
            if (index < W) { const f32x4 a0 = *(const f32x4*)(cvb + (size_t)index * 512), a1 = *(const f32x4*)(cvb + (size_t)index * 512 + 64);
                v[0] = a0[0]; v[1] = a0[1]; v[2] = a0[2]; v[3] = a0[3]; v[4] = a1[0]; v[5] = a1[1]; v[6] = a1[2]; v[7] = a1[3]; }
            else { const bf16_t* zv = znew + (size_t)(index - W) * DIN + Z_AV; const u32x2 a0 = *(const u32x2*)zv, a1 = *(const u32x2*)(zv + 64);
                v[0] = bflo(a0.x); v[1] = bfhi(a0.x); v[2] = bflo(a0.y); v[3] = bfhi(a0.y); v[4] = bflo(a1.x); v[5] = bfhi(a1.x); v[6] = bflo(a1.y); v[7] = bfhi(a1.y); }
#pragma unroll
            for (int e = 0; e < 8; ++e) o[e] += p * v[e];
        }
    }
#pragma unroll
    for (int e = 0; e < 8; ++e) { o[e] += __shfl_xor(o[e], 16); o[e] += __shfl_xor(o[e], 32); }
    if (rr == 0) {
        bf16_t* op = og + ((size_t)g * MT + zrow) * 512 + j * 128 + 4 * c16;
        u32x2 w0, w1; w0.x = pk2(o[0], o[1]); w0.y = pk2(o[2], o[3]); w1.x = pk2(o[4], o[5]); w1.y = pk2(o[6], o[7]);
        *(u32x2*)op = w0; *(u32x2*)(op + 64) = w1;
    }
    if (lane == 0) lse[((size_t)g * MT + zrow) * 4 + j] = mx + __logf(den);
    __syncthreads();
}

__device__ __forceinline__ void win_copy(const Args& a, const bf16_t* __restrict__ z, int l, int tid) {
    const int lane = tid & 63, gw = blockIdx.x * 8 + (tid >> 6), NGW = gridDim.x * 8;
    for (int idx = gw; idx < 12288; idx += NGW) {
        const int kv = idx / 6144; int rem = idx % 6144;
        size_t zrow; int g; float* dst;
        if (rem < 5376) {
            int W, bw;
            if (rem < 256) { g = 0; W = 128; bw = rem; } else if (rem < 1280) { g = 1; W = 512; bw = rem - 256; } else { g = 2; W = 2048; bw = rem - 1280; }
            const int b = bw / W, w = bw % W;
            zrow = (size_t)b * SEQ + (SEQ - W) + w;
            const size_t ooff = (g == 0) ? (kv ? O_PWV0 : O_PWK0) : (g == 1) ? (kv ? O_PWV1 : O_PWK1) : (kv ? O_PWV2 : O_PWK2);
            dst = a.out + ooff + (((size_t)l * 2 + b) * W + w) * 512;
        } else {
            rem -= 5376; g = rem >> 8; const int b = (rem & 255) >> 3, i = rem & 7, W = 128 << (2 * g);
            zrow = (size_t)MP + b * 8 + i;
            const size_t ooff = (g == 0) ? (kv ? O_SWV0 : O_SWK0) : (g == 1) ? (kv ? O_SWV1 : O_SWK1) : (kv ? O_SWV2 : O_SWK2);
            dst = a.out + ooff + (((size_t)l * 32 + b) * W + (W - 8) + i) * 512;
        }
        const u32x4 w4 = *(const u32x4*)(z + zrow * DIN + (kv ? Z_AV : Z_AK) + g * 512 + 8 * lane);
        __builtin_nontemporal_store((f32x4){bflo(w4.x), bfhi(w4.x), bflo(w4.y), bfhi(w4.y)}, (f32x4*)(dst + 8 * lane));
        __builtin_nontemporal_store((f32x4){bflo(w4.z), bfhi(w4.z), bflo(w4.w), bfhi(w4.w)}, (f32x4*)(dst + 8 * lane + 4));
    }
}

template <bool DO_SCAN, bool DO_COMBINE>
__device__ __forceinline__ void p3_scan_combine(const Args& a, int l, int tid) {
    const bf16_t* U = (const bf16_t*)(a.ws + WS_U); bf16_t* Rp = (bf16_t*)(a.ws + WS_RP);
    const int gt = blockIdx.x * 512 + tid, GT = gridDim.x * 512;
    if constexpr (DO_SCAN) for (int e = gt; e < 131072; e += GT) {
        const int vd = e & 32767, bh0 = e >> 15, bh1 = bh0 + 4, h = bh0 & 3;
        const float cd = __expf(ret_lg(h) * 128.0f);
        float R0 = 0.f, R1 = 0.f;
        const bf16_t* up0 = U + (size_t)bh0 * 64 * 32768 + vd; bf16_t* rp0 = Rp + (size_t)bh0 * 64 * 32768 + vd;
        const bf16_t* up1 = U + (size_t)bh1 * 64 * 32768 + vd; bf16_t* rp1 = Rp + (size_t)bh1 * 64 * 32768 + vd;
#pragma unroll 1
        for (int c0 = 0; c0 < 64; c0 += 16) {
            float u0[16], u1[16];
#pragma unroll
            for (int k = 0; k < 16; ++k) { u0[k] = __uint_as_float((unsigned)up0[(size_t)(c0 + k) * 32768] << 16); u1[k] = __uint_as_float((unsigned)up1[(size_t)(c0 + k) * 32768] << 16); }
#pragma unroll
            for (int k = 0; k < 16; ++k) { rp0[(size_t)(c0 + k) * 32768] = (bf16_t)f2bf(R0); R0 = cd * R0 + u0[k]; rp1[(size_t)(c0 + k) * 32768] = (bf16_t)f2bf(R1); R1 = cd * R1 + u1[k]; }
        }
        const int v = vd >> 7, d = vd & 127;
        a.out[O_PRET + ((size_t)l * 8 + bh0) * 32768 + d * 256 + v] = R0;
        a.out[O_PRET + ((size_t)l * 8 + bh1) * 32768 + d * 256 + v] = R1;
    }
    const bf16_t* og = (const bf16_t*)(a.ws + WS_OG); const float* lse = (const float*)(a.ws + WS_LSE); bf16_t* oatt = (bf16_t*)(a.ws + WS_OATT);
    const int lane = tid & 63, gw = blockIdx.x * 8 + (tid >> 6), NGW = gridDim.x * 8;
    if constexpr (DO_COMBINE) for (int row0 = gw; row0 < MT; row0 += 2 * NGW) {
        const int j = lane >> 4;
        u32x4 q[2][3]; float ls[2][3];
#pragma unroll
        for (int rr = 0; rr < 2; ++rr) { const int row = (row0 + rr * NGW < MT) ? row0 + rr * NGW : row0;
#pragma unroll
            for (int g = 0; g < 3; ++g) { ls[rr][g] = lse[((size_t)g * MT + row) * 4 + j]; q[rr][g] = *(const u32x4*)(og + ((size_t)g * MT + row) * 512 + 8 * lane); } }
#pragma unroll
        for (int rr = 0; rr < 2; ++rr) {
            const int row = row0 + rr * NGW; if (row >= MT) break;
            const float mx = fmaxf(ls[rr][0], fmaxf(ls[rr][1], ls[rr][2]));
            float w0 = __expf(ls[rr][0] - mx), w1 = __expf(ls[rr][1] - mx), w2 = __expf(ls[rr][2] - mx);
            const float inv = 1.0f / (w0 + w1 + w2); w0 *= inv; w1 *= inv; w2 *= inv;
            const u32x4 q0 = q[rr][0], q1 = q[rr][1], q2 = q[rr][2];
            const f32x4 a0 = {bflo(q0.x), bfhi(q0.x), bflo(q0.y), bfhi(q0.y)}, a1 = {bflo(q0.z), bfhi(q0.z), bflo(q0.w), bfhi(q0.w)};
            const f32x4 b0 = {bflo(q1.x), bfhi(q1.x), bflo(q1.y), bfhi(q1.y)}, b1 = {bflo(q1.z), bfhi(q1.z), bflo(q1.w), bfhi(q1.w)};
            const f32x4 c0_ = {bflo(q2.x), bfhi(q2.x), bflo(q2.y), bfhi(q2.y)}, c1_ = {bflo(q2.z), bfhi(q2.z), bflo(q2.w), bfhi(q2.w)};
            const f32x4 r0 = a0 * w0 + b0 * w1 + c0_ * w2, r1 = a1 * w0 + b1 * w1 + c1_ * w2;
            u32x4 w; w.x = pk2(r0[0], r0[1]); w.y = pk2(r0[2], r0[3]); w.z = pk2(r1[0], r1[1]); w.w = pk2(r1[2], r1[3]);
            *(u32x4*)(oatt + (size_t)row * 512 + 8 * lane) = w;
        }
    }
}

constexpr int RO_VOFF = 128 * KVS, RO_ROFF = RO_VOFF + 128 * RVS;
__device__ __forceinline__ void ret_out_item(LAS unsigned char* lds, const bf16_t* __restrict__ z, const bf16_t* __restrict__ Rp, bf16_t* __restrict__ oret, int item, int tid) {
    const int wid = __builtin_amdgcn_readfirstlane(tid >> 6), lane = tid & 63, fr = lane & 15, quad = lane >> 4;
    const int c = item & 63, bh = item >> 6, h = bh & 3, b = bh >> 2;
    const float lg = ret_lg(h);
    const size_t zrow0 = (size_t)b * SEQ + 128 * c;
    const bf16_t* z0 = z + zrow0 * DIN;
    const bf16_t* R0 = Rp + (size_t)item * 32768;
#pragma unroll
    for (int it = 0; it < 4; ++it) {
        const int idx = tid + it * 512, jj = idx >> 4, ch = idx & 15;
        *(LAS u32x4*)(lds + jj * KVS + ch * 16) = *(const u32x4*)(z0 + (size_t)jj * DIN + Z_RK + h * 128 + ch * 8);
        *(LAS u32x4*)(lds + RO_ROFF + jj * KVS + ch * 16) = *(const u32x4*)(R0 + (size_t)jj * 128 + ch * 8);
    }
#pragma unroll
    for (int it = 0; it < 8; ++it) {
        const int idx = tid + it * 512, jj = idx >> 5, ch = idx & 31;
        *(LAS u32x4*)(lds + RO_VOFF + jj * RVS + ch * 16) = *(const u32x4*)(z0 + (size_t)jj * DIN + Z_RV + h * 256 + ch * 8);
    }
    const int iq = 16 * wid + fr;
    bf16x8 qf[4];
#pragma unroll
    for (int ks = 0; ks < 4; ++ks) qf[ks] = *(const bf16x8*)(z0 + (size_t)iq * DIN + Z_RQ + h * 128 + ks * 32 + quad * 8);
    __syncthreads();
    f32x4 o[16];
#pragma unroll
    for (int vt = 0; vt < 16; ++vt) o[vt] = (f32x4){0.f, 0.f, 0.f, 0.f};
#pragma unroll
    for (int vt = 0; vt < 8; ++vt)
#pragma unroll
        for (int ks = 0; ks < 4; ++ks) { const bf16x8 ra = *(LAS const bf16x8*)(lds + RO_ROFF + (16 * vt + fr) * KVS + ks * 64 + quad * 16); o[vt] = MFMA16(ra, qf[ks], o[vt]); }
    __syncthreads();
#pragma unroll
    for (int it = 0; it < 4; ++it) {
        const int idx = tid + it * 512, jj = idx >> 4, ch = idx & 15;
        *(LAS u32x4*)(lds + RO_ROFF + jj * KVS + ch * 16) = *(const u32x4*)(R0 + (size_t)(128 + jj) * 128 + ch * 8);
    }
    __syncthreads();
#pragma unroll
    for (int vt = 0; vt < 8; ++vt)
#pragma unroll
        for (int ks = 0; ks < 4; ++ks) { const bf16x8 ra = *(LAS const bf16x8*)(lds + RO_ROFF + (16 * vt + fr) * KVS + ks * 64 + quad * 16); o[8 + vt] = MFMA16(ra, qf[ks], o[8 + vt]); }
    const float xi = __expf(lg * (float)(iq + 1));
#pragma unroll
    for (int vt = 0; vt < 16; ++vt) o[vt] = o[vt] * xi;
#pragma unroll
    for (int kp = 0; kp < 4; ++kp) {
        if (2 * kp <= wid) {
            const bool hasB = (2 * kp + 1 <= wid);
            const int TA = 2 * kp, TB = hasB ? TA + 1 : TA;
            f32x4 sa = {0.f, 0.f, 0.f, 0.f}, sb = {0.f, 0.f, 0.f, 0.f};
#pragma unroll
            for (int ks = 0; ks < 4; ++ks) {
                const bf16x8 ka = *(LAS const bf16x8*)(lds + (16 * TA + fr) * KVS + ks * 64 + quad * 16); sa = MFMA16(ka, qf[ks], sa);
                const bf16x8 kb = *(LAS const bf16x8*)(lds + (16 * TB + fr) * KVS + ks * 64 + quad * 16); sb = MFMA16(kb, qf[ks], sb);
            }
#pragma unroll
            for (int e = 0; e < 4; ++e) {
                const int da = iq - (16 * TA + 4 * quad + e), db = iq - (16 * TB + 4 * quad + e);
                sa[e] = (da >= 0) ? sa[e] * __expf(lg * (float)da) : 0.f;
                sb[e] = (hasB && db >= 0) ? sb[e] * __expf(lg * (float)db) : 0.f;
            }
            u32x4 pw; pw.x = pk2(sa[0], sa[1]); pw.y = pk2(sa[2], sa[3]); pw.z = pk2(sb[0], sb[1]); pw.w = pk2(sb[2], sb[3]);
            const bf16x8 p8 = __builtin_bit_cast(bf16x8, pw);
            LAS const unsigned char* bA = lds + RO_VOFF + (16 * TA + 4 * quad + (fr >> 2)) * RVS + (fr & 3) * 8;
            LAS const unsigned char* bB = lds + RO_VOFF + (16 * TB + 4 * quad + (fr >> 2)) * RVS + (fr & 3) * 8;
#pragma unroll
            for (int vt = 0; vt < 16; ++vt) { const v4i16_t va = tr4(bA + vt * 32), vb = tr4(bB + vt * 32); o[vt] = MFMA16(cat8(va, vb), p8, o[vt]); }
        }
    }
    float s = 0.f;
#pragma unroll
    for (int vt = 0; vt < 16; ++vt) s += (o[vt][0] + o[vt][1]) + (o[vt][2] + o[vt][3]);
    s += __shfl_xor(s, 16); s += __shfl_xor(s, 32);
    const float mu = s * (1.0f / 256.0f); float qv = 0.f;
#pragma unroll
    for (int vt = 0; vt < 16; ++vt) { o[vt] = o[vt] - mu; qv += (o[vt][0] * o[vt][0] + o[vt][1] * o[vt][1]) + (o[vt][2] * o[vt][2] + o[vt][3] * o[vt][3]); }
    qv += __shfl_xor(qv, 16); qv += __shfl_xor(qv, 32);
    const float rstd = 1.0f / sqrtf(qv * (1.0f / 256.0f) + 1e-6f);
    const bf16_t* rgp = z0 + (size_t)iq * DIN + Z_RG + h * 256 + 4 * quad;
    bf16_t* op = oret + (zrow0 + iq) * DM + h * 256 + 4 * quad;
#pragma unroll
    for (int vt = 0; vt < 16; ++vt) {
        const u32x2 gw = *(const u32x2*)(rgp + 16 * vt);
        const float g0 = bflo(gw.x), g1 = bfhi(gw.x), g2 = bflo(gw.y), g3 = bfhi(gw.y);
        const float x0 = o[vt][0] * rstd * g0 / (1.0f + __expf(-g0)), x1 = o[vt][1] * rstd * g1 / (1.0f + __expf(-g1)), x2 = o[vt][2] * rstd * g2 / (1.0f + __expf(-g2)), x3 = o[vt][3] * rstd * g3 / (1.0f + __expf(-g3));
        u32x2 w; w.x = pk2(x0, x1); w.y = pk2(x2, x3);
        *(u32x2*)(op + 16 * vt) = w;
    }
    __syncthreads();
}

#define XB_TMO      128
#define XB_XCNT(j)  (256  + 64 * (j))
#define XB_XSUB(j)  (1280 + 64 * (j))
#define XB_XGEN(j)  (2304 + 64 * (j))
#define XB_TOP      3328
#define XB_TOPGEN   3392
#define XCD_BAR_WORDS 3456
#define XB_SPIN_CAP (1u << 18)

__device__ __forceinline__ unsigned xb_ld(unsigned* p)              { return __hip_atomic_load(p, __ATOMIC_RELAXED, __HIP_MEMORY_SCOPE_AGENT); }
__device__ __forceinline__ unsigned xb_add(unsigned* p, unsigned v) { return __hip_atomic_fetch_add(p, v, __ATOMIC_RELAXED, __HIP_MEMORY_SCOPE_AGENT); }
__device__ __forceinline__ unsigned xb_xcc_id() { return (unsigned)__builtin_amdgcn_s_getreg((3 << 11) | 20) & 0xFu; }
#define XB_SPIN(cond, bar) do { unsigned _sp = 0; while (cond) { __builtin_amdgcn_s_sleep(1); \
    if ((++_sp & 255u) == 0u) { if (xb_ld(&(bar)[XB_TMO])) break; if (_sp > XB_SPIN_CAP) { atomicAdd(&(bar)[XB_TMO], 1u); break; } } } } while (0)

struct XcdBarrier {
    unsigned* bar; unsigned x;
    volatile LAS unsigned* st;
};

__device__ __forceinline__ XcdBarrier xcd_barrier_post(unsigned* bar, volatile LAS unsigned* st) {
    XcdBarrier b; b.bar = bar; b.x = xb_xcc_id(); b.st = st;
    if (threadIdx.x == 0) (void)xb_add(&bar[XB_XCNT(b.x)], 1u);
    return b;
}
__device__ __forceinline__ void xcd_barrier_complete(unsigned* bar, unsigned x, unsigned& nloc, unsigned& nx) {
    const unsigned G = gridDim.x * gridDim.y * gridDim.z;
    unsigned sum, cnt, mine, sp = 0u;
    for (;;) {
        sum = 0u; cnt = 0u; mine = 0u;
#pragma unroll
        for (unsigned j = 0; j < 16; ++j) { const unsigned c = xb_ld(&bar[XB_XCNT(j)]); sum += c; cnt += (c > 0u) ? 1u : 0u; mine = (j == x) ? c : mine; }
        if (sum == G) break;
        __builtin_amdgcn_s_sleep(1);
        if ((++sp & 255u) == 0u) { if (xb_ld(&bar[XB_TMO])) break; if (sp > XB_SPIN_CAP) { atomicAdd(&bar[XB_TMO], 1u); break; } }
    }
    nloc = mine > 0u ? mine : 1u; nx = cnt > 0u ? cnt : 1u;
}

__device__ __forceinline__ void xcd_barrier(const XcdBarrier& b) {
    asm volatile("s_waitcnt vmcnt(0)" ::: "memory");
    __syncthreads();
    if (threadIdx.x == 0) {
        unsigned* bar = b.bar;
        __builtin_amdgcn_s_waitcnt(0);
        unsigned nloc = b.st[0], nx = b.st[1];
        if (nloc == 0u) { xcd_barrier_complete(bar, b.x, nloc, nx); b.st[0] = nloc; b.st[1] = nx; }
        const unsigned old = xb_add(&bar[XB_XSUB(b.x)], 1u);
        const unsigned gen = old / nloc;
        if (old + 1u == (gen + 1u) * nloc) {
            __builtin_amdgcn_fence(__ATOMIC_RELEASE, "agent");
            asm volatile("s_waitcnt vmcnt(0)" ::: "memory");
            const unsigned og = xb_add(&bar[XB_TOP], 1u);
            const unsigned tg = og / nx;
            if (og + 1u == (tg + 1u) * nx) xb_add(&bar[XB_TOPGEN], 1u);
            else XB_SPIN(xb_ld(&bar[XB_TOPGEN]) == tg, bar);
            __builtin_amdgcn_fence(__ATOMIC_ACQUIRE, "agent");
            xb_add(&bar[XB_XGEN(b.x)], 1u);
            asm volatile("s_waitcnt vmcnt(0)" ::: "memory");
        } else {
            XB_SPIN(xb_ld(&bar[XB_XGEN(b.x)]) == gen, bar);
            __builtin_amdgcn_fence(__ATOMIC_ACQUIRE, "agent");
            asm volatile("s_waitcnt vmcnt(0)" ::: "memory");
        }
    }
    __syncthreads();
}

template <int MODE>
__device__ __forceinline__ void skinny_phase(LAS unsigned char* lds, const bf16_t* __restrict__ A, const bf16_t* __restrict__ Wt, int K, const pg8::Epi<MODE>& E, int tid_in) {
    int tid = tid_in; asm volatile("" : "+v"(tid));
    const int wid = __builtin_amdgcn_readfirstlane(tid >> 6), lane = tid & 63, fr = lane & 15, quad = lane >> 4;
    LAS f32x4* red = (LAS f32x4*)lds;
    LAS float* ssq_l = (LAS float*)(lds + 32768);
#pragma unroll 1
    for (int slab = blockIdx.x; slab < 256; slab += gridDim.x) {
        const int rt = slab & 15, cs = slab >> 4;
        const bf16_t* arow = A + (size_t)(MP + 16 * rt + fr) * K + 8 * quad;
        const bf16_t* wrow = Wt + (size_t)(64 * cs + fr) * K + 8 * quad;
        f32x4 acc[4];
#pragma unroll
        for (int ct = 0; ct < 4; ++ct) acc[ct] = (f32x4){0.f, 0.f, 0.f, 0.f};
        const int nks = K >> 5;
#pragma unroll 4
        for (int ks = wid; ks < nks; ks += 8) {
            const bf16x8 b = *(const bf16x8*)(arow + 32 * ks);
#pragma unroll
            for (int ct = 0; ct < 4; ++ct) { const bf16x8 w = *(const bf16x8*)(wrow + (size_t)(16 * ct) * K + 32 * ks); acc[ct] = MFMA16(w, b, acc[ct]); }
        }
#pragma unroll
        for (int ct = 0; ct < 4; ++ct) red[(wid * 4 + ct) * 64 + lane] = acc[ct];
        __syncthreads();
        if (wid < 4) {
            f32x4 s = red[wid * 64 + lane];
#pragma unroll
            for (int w = 1; w < 8; ++w) s = s + red[(w * 4 + wid) * 64 + lane];
            float ssq = E.elem(MP + 16 * rt + fr, 64 * cs + 16 * wid + 4 * quad, s);
            if constexpr (MODE == pg8::E_RES || MODE == pg8::E_GATE) { ssq += __shfl_xor(ssq, 16); ssq += __shfl_xor(ssq, 32); if (quad == 0) ssq_l[wid * 16 + fr] = ssq; }
        }
        __syncthreads();
        if constexpr (MODE == pg8::E_RES || MODE == pg8::E_GATE) { if (tid < 16) E.ssp_out[(size_t)(MP + 16 * rt + tid) * 16 + cs] = (ssq_l[tid] + ssq_l[16 + tid]) + (ssq_l[32 + tid] + ssq_l[48 + tid]); }
        __syncthreads();
    }
}

#define GEMM_PHASE(MODE, Aptr, Bptr, Mm, Nn, Kk, EPI) do { int kk_ = (Kk); asm volatile("" : "+s"(kk_)); pg8::Gemm g_{(const pg8::bf16_t*)(Aptr), (const pg8::bf16_t*)(Bptr), (Mm), (Nn), kk_}; pg8::StaticOrder S_; S_.init((Mm), (Nn), (int)gridDim.x, (int)blockIdx.x); \
    pg8::gemm_phase<pg8::Epi<MODE>, pg8::StaticOrder, true, true>((PG8_LAS unsigned char*)lds, g_, S_, (EPI)); } while (0)

__global__ void __launch_bounds__(512, 2) mega_fwd(Args a) {
    extern __shared__ __attribute__((aligned(16))) unsigned char lds_raw[];
    LAS unsigned char* lds = (LAS unsigned char*)lds_raw;
    cg::grid_group grid = cg::this_grid();
    int tid = threadIdx.x;
#define OPQ() asm volatile("" : "+v"(tid))
    unsigned char* ws = a.ws;
    float* ssp = (float*)(ws + WS_SSP); bf16_t* tbuf = (bf16_t*)(ws + WS_T);
    bf16_t* z = (bf16_t*)(ws + WS_Z); bf16_t* ubuf = (bf16_t*)(ws + WS_Z);
    bf16_t* oret = (bf16_t*)(ws + WS_ORET); bf16_t* oatt = (bf16_t*)(ws + WS_OATT); bf16_t* merged = (bf16_t*)(ws + WS_MERGED);
    bf16_t* og = (bf16_t*)(ws + WS_OG); float* lse = (float*)(ws + WS_LSE); bf16_t* U = (bf16_t*)(ws + WS_U); bf16_t* Rp = (bf16_t*)(ws + WS_RP);

#ifndef PHMASK
#define PHMASK 0xFFFFF
#endif
#define PH(n) if constexpr ((PHMASK >> (n)) & 1)
    unsigned* barw = (unsigned*)(ws + WS_CTL);
    volatile LAS unsigned* MISC = (volatile LAS unsigned*)(lds + LDS_BYTES - 64);
    if (tid < 2) MISC[tid] = 0u;
    if (blockIdx.x == 0) for (int i = tid; i < XCD_BAR_WORDS; i += 512) __hip_atomic_store(barw + i, 0u, __ATOMIC_RELAXED, __HIP_MEMORY_SCOPE_AGENT);
    PH(0) p0_prologue(a, lds, tid);
    grid.sync();
    const XcdBarrier xbar = xcd_barrier_post(barw, MISC);
#define GSYNC() xcd_barrier(xbar)

#pragma unroll 1
    for (int l = 0; l < 2; ++l) {
        unsigned char* wl = ws + WS_WT + (size_t)l * WT_LAYER;
        bf16_t* xb_cur = (bf16_t*)(ws + (l == 0 ? WS_XBA : WS_XBB));
        bf16_t* xb_nxt = (bf16_t*)(ws + (l == 0 ? WS_XBB : WS_XBA));
#ifndef REP_G
#define REP_G 1
#endif
#pragma unroll 1
        for (int rg_ = 0; rg_ < REP_G; ++rg_) {
        PH(1) { pg8::Epi<pg8::E_Z> E{z, DIN, nullptr, nullptr, ssp, nullptr, nullptr, nullptr}; GEMM_PHASE(pg8::E_Z, xb_cur, wl + WT_IN, MT, DIN, DM, E); }
        if (rg_ + 1 < REP_G) GSYNC();
        }
        cache_copy_tail(a, 2470, l * 500 + 0, l * 500 + 50, tid);
        GSYNC();
#ifndef REP_MIX
#define REP_MIX 1
#endif
#pragma unroll 1
        for (int rep_ = 0; rep_ < REP_MIX; ++rep_) {
        OPQ();
        if (blockIdx.x & 1) cache_copy_tail(a, 0, l * 500 + 150, l * 500 + 220, tid);
        PH(3) for (int it = blockIdx.x; it < 512; it += gridDim.x) ret_u_item(lds, z, U, it, tid);
        if (!(blockIdx.x & 1)) cache_copy_tail(a, 0, l * 500 + 150, l * 500 + 220, tid);
        GSYNC();
        if (blockIdx.x & 1) cache_copy_tail(a, 0, l * 500 + 220, l * 500 + 270, tid);
#pragma unroll 1
        for (int stage_ = 0; stage_ < 2; ++stage_) {
        const bool sample_now = ((stage_ == 0) == ((blockIdx.x & 1) != 0));
        if (!sample_now) {
        OPQ();
        PH(2) { const int per_ = (1536 + (int)gridDim.x - 1) / (int)gridDim.x; for (int i_ = 0; i_ < per_; ++i_) { const int it = (int)blockIdx.x * per_ + i_; if (it < 1536) attn_prompt_item(lds, z, og, lse, it, tid); } }
        } else {
        OPQ();
        PH(4) for (int it = blockIdx.x; it < 384; it += gridDim.x) {
            const int g = (it >> 2) % 3;
            attn_sample_item(lds, z, a.in[2 + 2 * g], a.in[3 + 2 * g], l, og, lse, it, tid);
        }
        OPQ();
        PH(5) for (int it = (blockIdx.x + gridDim.x / 2) % gridDim.x; it < 128; it += gridDim.x) ret_sample_item(lds, z, a.in[8] + (size_t)l * 128 * 32768, a.out + O_SRET + (size_t)l * 128 * 32768, oret, it, tid);
        }
        }
        OPQ();
        PH(7) p3_scan_combine<true, false>(a, l, tid);
        PH(6) win_copy(a, z, l, tid);
        if (!(blockIdx.x & 1)) cache_copy_tail(a, 0, l * 500 + 220, l * 500 + 270, tid);
        GSYNC();
        OPQ();
        if (blockIdx.x & 1) cache_copy_tail(a, 0, l * 500 + 270, l * 500 + 500, tid);
        PH(8) for (int it = blockIdx.x; it < 512; it += gridDim.x) ret_out_item(lds, z, Rp, oret, it, tid);
        PH(7) p3_scan_combine<false, true>(a, l, tid);
        if (!(blockIdx.x & 1)) cache_copy_tail(a, 0, l * 500 + 270, l * 500 + 500, tid);
        GSYNC();
        }
        PH(9) { pg8::Epi<pg8::E_RET> E{nullptr, DM, nullptr, tbuf, nullptr, nullptr, z + Z_GA, nullptr}; GEMM_PHASE(pg8::E_RET, oret, wl + WT_RET, MP, DM, DM, E); skinny_phase<pg8::E_RET>(lds, oret, (const bf16_t*)(wl + WT_RET), DM, E, tid); }
        PH(10) { pg8::Epi<pg8::E_ATT> E{merged, DM, nullptr, tbuf, nullptr, nullptr, z + Z_GB, nullptr}; GEMM_PHASE(pg8::E_ATT, oatt, wl + WT_ATT, MP, DM, 512, E); skinny_phase<pg8::E_ATT>(lds, oatt, (const bf16_t*)(wl + WT_ATT), 512, E, tid); }
        GSYNC();
        PH(11) { pg8::Epi<pg8::E_RES> E{xb_cur, DM, xb_cur, nullptr, nullptr, ssp, nullptr, (l == 0) ? a.in[0] : (const float*)nullptr}; GEMM_PHASE(pg8::E_RES, merged, wl + WT_OUT, MP, DM, DM, E);
          pg8::Epi<pg8::E_RES> Es{xb_cur, DM, xb_cur, nullptr, nullptr, ssp, nullptr, (l == 0) ? a.in[1] - (size_t)MP * DM : (const float*)nullptr}; skinny_phase<pg8::E_RES>(lds, merged, (const bf16_t*)(wl + WT_OUT), DM, Es, tid); }
        GSYNC();
#pragma unroll 1
        for (int rg_ = 0; rg_ < REP_G; ++rg_) {
        PH(12) { pg8::Epi<pg8::E_UP> E{ubuf, DFF, nullptr, nullptr, ssp, nullptr, nullptr, nullptr}; GEMM_PHASE(pg8::E_UP, xb_cur, wl + WT_UP, MT, DFF, DM, E); }
        if (rg_ + 1 < REP_G) GSYNC();
        }
        cache_copy_tail(a, 1040, l * 500 + 50, l * 500 + 150, tid);
        GSYNC();
        PH(13) { pg8::Epi<pg8::E_RES> E{xb_cur, DM, xb_cur, nullptr, nullptr, ssp, nullptr, nullptr}; GEMM_PHASE(pg8::E_RES, ubuf, wl + WT_DOWN, MP, DM, DFF, E); skinny_phase<pg8::E_RES>(lds, ubuf, (const bf16_t*)(wl + WT_DOWN), DFF, E, tid); }
        GSYNC();
        PH(14) { pg8::Epi<pg8::E_PLE> E{nullptr, DM, nullptr, tbuf, nullptr, nullptr, nullptr, nullptr}; GEMM_PHASE(pg8::E_PLE, ws + WS_PB + (size_t)l * MT * DPLE * 2, wl + WT_PLE, MP, DM, DPLE, E); skinny_phase<pg8::E_PLE>(lds, (const bf16_t*)(ws + WS_PB + (size_t)l * MT * DPLE * 2), (const bf16_t*)(wl + WT_PLE), DPLE, E, tid); }
        PH(15) { pg8::Epi<pg8::E_GATE> E{xb_nxt, DM, xb_cur, tbuf, nullptr, ssp, nullptr, nullptr}; GEMM_PHASE(pg8::E_GATE, xb_cur, wl + WT_GATE, MP, DM, DM, E); skinny_phase<pg8::E_GATE>(lds, xb_cur, (const bf16_t*)(wl + WT_GATE), DM, E, tid); }
        GSYNC();
    }
    {
        const int lane = tid & 63, gw = blockIdx.x * 8 + (tid >> 6), NGW = gridDim.x * 8;
        const float* nf = a.in[21];
        for (int m = gw; m < MT; m += NGW) {
            float sv = (lane < 16) ? ssp[(size_t)m * 16 + lane] : 0.f;
            sv = wave_sum(sv);
            const float rstd = 1.0f / sqrtf(sv * (1.0f / 1024.0f) + 1e-6f);
#pragma unroll
            for (int j = 0; j < 4; ++j) { const u32x2 xw_ = *(const u32x2*)((const bf16_t*)(ws + WS_XBA) + (size_t)m * DM + 4 * lane + 256 * j); const f32x4 v = {bflo(xw_.x), bfhi(xw_.x), bflo(xw_.y), bfhi(xw_.y)}; const f32x4 gn = *(const f32x4*)(nf + 4 * lane + 256 * j); *(f32x4*)(a.out + O_Y + (size_t)m * DM + 4 * lane + 256 * j) = v * rstd * gn; }
        }
    }
}

extern "C" void kernel_launch(void* const* d_in, const int* in_sizes, int n_in, void* d_out, int out_size, void* d_ws, size_t ws_size, hipStream_t stream) {
    static int grid = 0;
    if (grid == 0) {
        if (n_in != 22 || (size_t)out_size != O_END || ws_size < WS_END) { fprintf(stderr, "kernel_launch: unexpected shapes: n_in %d out %d (want %zu) ws %zu (need %zu)\n", n_in, out_size, (size_t)O_END, ws_size, (size_t)WS_END); grid = -1; return; }
        int dev = 0, cus = 0, per_cu = 0;
        if (hipGetDevice(&dev) != hipSuccess || hipDeviceGetAttribute(&cus, hipDeviceAttributeMultiprocessorCount, dev) != hipSuccess) { grid = -1; return; }
        if (hipFuncSetAttribute((const void*)mega_fwd, hipFuncAttributeMaxDynamicSharedMemorySize, LDS_BYTES) != hipSuccess) { fprintf(stderr, "kernel_launch: hipFuncSetAttribute failed\n"); grid = -1; return; }
        if (hipOccupancyMaxActiveBlocksPerMultiprocessor(&per_cu, (const void*)mega_fwd, 512, LDS_BYTES) != hipSuccess || per_cu < 1) { fprintf(stderr, "kernel_launch: occupancy query says %d\n", per_cu); per_cu = 1; }
        (void)hipGetLastError();
        grid = cus * 1;
    }
    if (grid < 0) return;
    Args a{};
    for (int i = 0; i < 22; ++i) a.in[i] = (const float*)d_in[i];
    a.out = (float*)d_out; a.ws = (unsigned char*)d_ws;
    void* args[] = {&a};
    hipError_t e = hipLaunchCooperativeKernel((const void*)mega_fwd, dim3(grid), dim3(512), args, LDS_BYTES, stream);
    if (e != hipSuccess) fprintf(stderr, "cooperative launch failed: %s (grid %d)\n", hipGetErrorString(e), grid);
}
```
